# Optimizing an MI355X kernel written in HIP

```python
import math
import jax, jax.numpy as jnp
from jax import lax
import numpy as np

D_MODEL = 1024
BATCH = 8
SEQ = 2048
DEPTH = 2

GRID_W = 64
NA_HEADS = 8
NA_HEAD_DIM = 64
NA_WIDTH = NA_HEADS * NA_HEAD_DIM
NA_KH = 8
NA_KW = 16
NA_QB = 16
NA_KB = NA_QB + NA_KW
NA_NCB = GRID_W // NA_QB
HY_WIDTH = D_MODEL - NA_WIDTH
D_MIX = NA_WIDTH + HY_WIDTH
SHORT_CONV = 3
FILTER_EMB = 33
FILTER_ORDER = 64
DECAY_TARGET = 1e-2
FAST_DECAY_PCT = 0.3
SLOW_DECAY_PCT = 1.5
MAX_DECAY = math.log(DECAY_TARGET) / FAST_DECAY_PCT
MIN_DECAY = math.log(DECAY_TARGET) / SLOW_DECAY_PCT
D_FF = 2816
PLE_DIM = 256
EPS = 1e-6

kernel_name = 'hybrid_na_hyena_macaron_block'


def _rms(x):
    xf = x.astype(jnp.float32)
    return (xf * lax.rsqrt(jnp.mean(xf * xf, axis=-1, keepdims=True) + EPS)).astype(x.dtype)


def rmsnorm(x, g):
    return _rms(x) * g


def swiglu(h, w_gate, w_up, w_down):
    return (jax.nn.silu(h @ w_gate) * (h @ w_up)) @ w_down


def neighbourhood_attention(q, k, v, rpb):
    B, L, H, dh = q.shape
    rows = L // GRID_W
    kh = min(NA_KH, rows)
    nk = kh * NA_KB
    r = jnp.arange(rows)
    row_start = jnp.clip(r - kh // 2, 0, rows - kh)
    key_rows = row_start[:, None] + jnp.arange(kh)[None, :]
    qcol = jnp.arange(NA_NCB)[:, None] * NA_QB + jnp.arange(NA_QB)[None, :]
    band_c0 = jnp.clip(jnp.arange(NA_NCB) * NA_QB - NA_KW // 2, 0, GRID_W - NA_KB)
    key_cols = band_c0[:, None] + jnp.arange(NA_KB)[None, :]
    key_idx = (key_rows[:, None, :, None] * GRID_W + key_cols[None, :, None, :]).reshape(rows, NA_NCB, nk)
    kg = k[:, key_idx]
    vg = v[:, key_idx]
    qb = q.reshape(B, rows, NA_NCB, NA_QB, H, dh)
    s = jnp.einsum('brjqhd,brjkhd->bhrjqk', qb, kg).astype(jnp.float32) * (dh ** -0.5)
    krow = jnp.broadcast_to(key_rows[:, :, None], (rows, kh, NA_KB)).reshape(rows, nk)
    kcol = jnp.broadcast_to(key_cols[:, None, :], (NA_NCB, kh, NA_KB)).reshape(NA_NCB, nk)
    dr = krow - r[:, None]
    dc = kcol[:, None, :] - qcol[:, :, None]
    qcs = jnp.clip(qcol - NA_KW // 2, 0, GRID_W - NA_KW)
    mask = (kcol[:, None, :] >= qcs[..., None]) & (kcol[:, None, :] < qcs[..., None] + NA_KW)
    dr_idx = (dr + NA_KH - 1)[:, None, None, :]
    dc_idx = jnp.clip(dc + NA_KW - 1, 0, 2 * NA_KW - 2)[None]
    bias = rpb[:, dr_idx, dc_idx].astype(jnp.float32)
    s = jnp.where(mask[None, None, None], s + bias[None], -jnp.inf)
    prob = jax.nn.softmax(s, axis=-1).astype(vg.dtype)
    o = jnp.einsum('bhrjqk,brjkhd->brjqhd', prob, vg)
    return o.reshape(B, L, H * dh)


def short_conv(u, w, b):
    up = jnp.pad(u, ((0, 0), (1, 1), (0, 0)))
    return up[:, :-2] * w[0] + up[:, 1:-1] * w[1] + up[:, 2:] * w[2] + b


def implicit_filter(L, w_f1, b_f1, w_f2, b_f2, w_f3, b_f3, w_f4, freq):
    bands = (FILTER_EMB - 1) // 2
    t = jnp.linspace(0.0, 1.0, L, dtype=jnp.float32)[:, None]
    w = 2.0 * math.pi * jnp.arange(L, dtype=jnp.float32)[:, None] / L
    f = jnp.linspace(1e-4, bands - 1, bands, dtype=jnp.float32)[None, :]
    z = jnp.concatenate([t, jnp.cos(f * w), -jnp.sin(f * w)], axis=-1)
    h = jnp.sin(freq * (z @ w_f1 + b_f1))
    h = jnp.sin(freq * (h @ w_f2 + b_f2))
    h = jnp.sin(freq * (h @ w_f3 + b_f3))
    h = (h @ w_f4).astype(jnp.float32)
    deltas = jnp.abs(jnp.linspace(MIN_DECAY, MAX_DECAY, HY_WIDTH, dtype=jnp.float32))
    decay = jnp.exp(-t * deltas[None, :])
    h = h.reshape(L, 2, HY_WIDTH) * decay[:, None, :]
    h_fwd, h_bwd = h[:, 0], h[:, 1]
    k = jnp.concatenate([h_fwd[:1] + h_bwd[:1], h_fwd[1:], jnp.zeros((1, HY_WIDTH), jnp.float32),
                         h_bwd[1:][::-1]], axis=0)
    return k / jnp.sum(jnp.abs(k), axis=0, keepdims=True)


def long_conv(u, k, bias):
    L = u.shape[1]
    n = 2 * L
    u_f = jnp.fft.rfft(u.astype(jnp.float32), n=n, axis=1)
    k_f = jnp.fft.rfft(k, n=n, axis=0)
    y = jnp.fft.irfft(u_f * k_f[None], n=n, axis=1)[:, :L]
    return y.astype(u.dtype) + u * bias


def setup_inputs(seed: int = 0) -> dict:
    key = jax.random.key(seed)
    ks = iter(jax.random.split(key, 40))

    def nrm(shape, scale):
        return jax.random.normal(next(ks), shape, jnp.float32) * scale

    def gain(shape):
        return 1.0 + nrm(shape, 0.02)

    D = DEPTH
    return {
        'x': nrm((BATCH, SEQ, D_MODEL), 1.0),
        'p': nrm((DEPTH, BATCH, SEQ, PLE_DIM), 1.0),
        'g_ffa': gain((D, D_MODEL)),
        'w_ffa_gate': nrm((D, D_MODEL, D_FF), D_MODEL ** -0.5),
        'w_ffa_up': nrm((D, D_MODEL, D_FF), D_MODEL ** -0.5),
        'w_ffa_down': nrm((D, D_FF, D_MODEL), D_FF ** -0.5),
        'g_mix': gain((D, D_MODEL)),
        'w_in': nrm((D, D_MODEL, 3 * NA_WIDTH + 3 * HY_WIDTH), D_MODEL ** -0.5),
        'na_rpb': nrm((D, NA_HEADS, 2 * NA_KH - 1, 2 * NA_KW - 1), 0.02),
        'w_sc': nrm((D, SHORT_CONV, 3 * HY_WIDTH), SHORT_CONV ** -0.5),
        'b_sc': nrm((D, 3 * HY_WIDTH), 0.02),
        'w_f1': nrm((D, FILTER_EMB, FILTER_ORDER), FILTER_EMB ** -0.5),
        'b_f1': nrm((D, FILTER_ORDER), 0.02),
        'w_f2': nrm((D, FILTER_ORDER, FILTER_ORDER), FILTER_ORDER ** -0.5),
        'b_f2': nrm((D, FILTER_ORDER), 0.02),
        'w_f3': nrm((D, FILTER_ORDER, FILTER_ORDER), FILTER_ORDER ** -0.5),
        'b_f3': nrm((D, FILTER_ORDER), 0.02),
        'w_f4': nrm((D, FILTER_ORDER, 2 * HY_WIDTH), FILTER_ORDER ** -0.5),
        'filt_freq': gain((D, FILTER_ORDER)),
        'hy_bias': nrm((D, HY_WIDTH), 1.0),
        'g_out': gain((D, D_MIX)),
        'w_out': nrm((D, D_MIX, D_MODEL), D_MIX ** -0.5),
        'g_ffb': gain((D, D_MODEL)),
        'w_ffb_gate': nrm((D, D_MODEL, D_FF), D_MODEL ** -0.5),
        'w_ffb_up': nrm((D, D_MODEL, D_FF), D_MODEL ** -0.5),
        'w_ffb_down': nrm((D, D_FF, D_MODEL), D_FF ** -0.5),
        'g_ple': gain((D, D_MODEL)),
        'w_ple_gate': nrm((D, D_MODEL, D_MODEL), D_MODEL ** -0.5),
        'w_ple_proj': nrm((D, PLE_DIM, D_MODEL), PLE_DIM ** -0.5),
        'g_final': gain((D_MODEL,)),
    }


def reference(x, p, g_ffa, w_ffa_gate, w_ffa_up, w_ffa_down, g_mix, w_in, na_rpb, w_sc, b_sc,
              w_f1, b_f1, w_f2, b_f2, w_f3, b_f3, w_f4, filt_freq, hy_bias, g_out, w_out,
              g_ffb, w_ffb_gate, w_ffb_up, w_ffb_down, g_ple, w_ple_gate, w_ple_proj, g_final):
    B, L, _ = x.shape
    for i in range(DEPTH):
        x = x + 0.5 * swiglu(rmsnorm(x, g_ffa[i]), w_ffa_gate[i], w_ffa_up[i], w_ffa_down[i])
        u = rmsnorm(x, g_mix[i]) @ w_in[i]
        q, k, v, hy = jnp.split(u, [NA_WIDTH, 2 * NA_WIDTH, 3 * NA_WIDTH], axis=-1)
        hs = (B, L, NA_HEADS, NA_HEAD_DIM)
        y_na = neighbourhood_attention(q.reshape(hs), k.reshape(hs), v.reshape(hs), na_rpb[i])
        hy = short_conv(hy, w_sc[i], b_sc[i])
        x0, x1, hv = jnp.split(hy, 3, axis=-1)
        filt = implicit_filter(L, w_f1[i], b_f1[i], w_f2[i], b_f2[i], w_f3[i], b_f3[i], w_f4[i], filt_freq[i])
        y_hy = x0 * long_conv(hv * x1, filt, hy_bias[i])
        y = jnp.concatenate([_rms(y_na), _rms(y_hy)], axis=-1) * g_out[i]
        x = x + y @ w_out[i]
        x = x + 0.5 * swiglu(rmsnorm(x, g_ffb[i]), w_ffb_gate[i], w_ffb_up[i], w_ffb_down[i])
        x = x + jax.nn.sigmoid(rmsnorm(x, g_ple[i]) @ w_ple_gate[i]) * (p[i] @ w_ple_proj[i])
    return rmsnorm(x, g_final)
```

```cpp
#include <hip/hip_runtime.h>
#include <hip/hip_cooperative_groups.h>
#include <cstdio>
#include <cstdint>
namespace cg = cooperative_groups;
namespace pg8 {
#define PG8_LAS __attribute__((address_space(3)))
typedef unsigned short bf16_t;
typedef short bf16x8 __attribute__((ext_vector_type(8)));
typedef float f32x4 __attribute__((ext_vector_type(4)));
typedef unsigned u32x4 __attribute__((ext_vector_type(4)));
constexpr int BM = 256, BK = 64, HALF = 128, HTB = HALF * BK * 2  , STAGE_BYTES = 8 * HTB, NXCD = 8, WGM = 8;

__host__ __device__ __forceinline__ int lds_byte(int r, int c) { const int st = (r >> 4) * 2 + (c >> 5), rr = r & 15, cc = c & 31, ob = rr * 64 + cc * 2; return st * 1024 + (ob ^ (((ob >> 9) & 1) << 5)); }
__host__ __device__ __forceinline__ void stage_rc(int b, int& R, int& C) { const int st = b / 1024, sb = b % 1024, swz = sb ^ (((sb >> 9) & 1) << 5); R = (st >> 1) * 16 + swz / 64; C = (st & 1) * 32 + (swz % 64) / 2; }
__host__ __device__ __forceinline__ int perm32(int rho) { const int n = rho >> 4, i = rho & 15; return 8 * (i >> 2) + 4 * n + (i & 3); }

struct Unit { int pm, pn; };
struct Gemm { const bf16_t* A; const bf16_t* Bt; int M, N, K; };

struct StaticOrder {
    int nM, nN, nwg, G, c;
    __host__ __device__ void init(int M, int N, int G_, int c_) { nM = M / BM; nN = N / BM; nwg = nM * nN; G = G_; c = c_; }
    __host__ __device__ bool next(int i, Unit& u) const {
        const long L = (long)i * G + c; if (L >= nwg) return false;
        int wgid = (int)L; { const int q = nwg / NXCD, r = nwg % NXCD, xcd = wgid % NXCD, off = wgid / NXCD; wgid = (xcd < r ? xcd * (q + 1) : r * (q + 1) + (xcd - r) * q) + off; }
        const int nig = WGM * nN, gid = wgid / nig, fm = gid * WGM, gsz = (nM - fm) < WGM ? (nM - fm) : WGM;
        u.pm = fm + ((wgid % nig) % gsz); u.pn = (wgid % nig) / gsz; return true;
    }
    __device__ __forceinline__ void a_ready(const Unit&) const {}
    __device__ __forceinline__ void done(const Unit&) const {}
};

template <class Epi, class Sched, bool ALIGN_EPI = false, bool SP2 = false>
__device__ __forceinline__ void gemm_phase(PG8_LAS unsigned char* lds, const Gemm g, const Sched& S, const Epi& E, int tid_in) {
    int tid_ = tid_in; asm volatile("" : "+v"(tid_)); const int tid = tid_, wid = __builtin_amdgcn_readfirstlane(tid >> 6), lane = tid & 63, wr = wid >> 2, wc = wid & 3, fr = lane & 15, fq = lane >> 4;
    const int K = g.K, nt = K / BK;
    unsigned voffA[2], voffB[2];
#pragma unroll
    for (int i = 0; i < 2; ++i) { int R, C; stage_rc(tid * 16 + i * 8192, R, C); const int Rb = Epi::PERM ? ((R & ~31) + perm32(R & 31)) : R;
        voffA[i] = (unsigned)(R * K + C) * 2u; voffB[i] = (unsigned)(Rb * K + C) * 2u; }
    const size_t kstep = (size_t)(BK * 2);
    const size_t hstep = (size_t)HALF * K * 2;
    const size_t tstep = 2 * hstep;
    const unsigned ldsw = (unsigned)wid * 1024u;
    const int aoff = lds_byte(wr * 64 + fr, fq * 8), boff = lds_byte(wc * 32 + fr, fq * 8);
#define PG8_SA(b, h) (((b) * 2 + (h)) * HTB)
#define PG8_SB(b, h) ((4 + (b) * 2 + (h)) * HTB)
#define PG8_STAGE(bufoff, gbase, voff) do { _Pragma("unroll") for (int _i = 0; _i < 2; ++_i) \
        __builtin_amdgcn_global_load_lds((const unsigned*)((const char*)(gbase) + (voff)[_i]), (PG8_LAS unsigned*)(lds + (bufoff) + ldsw + _i * 8192), 16, 0, 0); } while (0)
#define PG8_LDA(dst, b, h) do { _Pragma("unroll") for (int m = 0; m < 4; ++m) _Pragma("unroll") for (int k = 0; k < 2; ++k) dst[m][k] = *(const PG8_LAS bf16x8*)(lds + PG8_SA(b, h) + aoff + m * 2048 + k * 1024); } while (0)
#define PG8_LDB(dst, b, h) do { _Pragma("unroll") for (int n = 0; n < 2; ++n) _Pragma("unroll") for (int k = 0; k < 2; ++k) dst[n][k] = *(const PG8_LAS bf16x8*)(lds + PG8_SB(b, h) + boff + n * 2048 + k * 1024); } while (0)
#define PG8_MMA(ai, bj, At, Bt) do { __builtin_amdgcn_s_setprio(1); _Pragma("unroll") for (int m = 0; m < 4; ++m) _Pragma("unroll") for (int n = 0; n < 2; ++n) _Pragma("unroll") for (int k = 0; k < 2; ++k) \
        acc[ai][bj][m][n] = __builtin_amdgcn_mfma_f32_16x16x32_bf16(Bt[n][k], At[m][k], acc[ai][bj][m][n], 0, 0, 0); __builtin_amdgcn_s_setprio(0); } while (0)
#define PG8_WAIT_V(n) asm volatile("s_waitcnt vmcnt(" #n ")" ::: "memory")
#define PG8_WAIT_L(n) asm volatile("s_waitcnt lgkmcnt(" #n ")" ::: "memory")
#define PG8_BAR __builtin_amdgcn_s_barrier()
#define PG8_SCHED __builtin_amdgcn_sched_barrier(0)
    Unit cur, nxt; int ui = 0;
    if (!S.next(0, cur)) return;
    f32x4 acc[2][2][4][2];
#pragma unroll
    for (int a = 0; a < 2; ++a)
#pragma unroll
        for (int b = 0; b < 2; ++b)
#pragma unroll
            for (int m = 0; m < 4; ++m)
#pragma unroll
                for (int n = 0; n < 2; ++n) acc[a][b][m][n] = (f32x4){0.f, 0.f, 0.f, 0.f};
    bf16x8 At[4][2], B0[2][2], B1[2][2];
    const char* cA = (const char*)g.A + (size_t)cur.pm * tstep; const char* cB = (const char*)g.Bt + (size_t)cur.pn * tstep;
    S.a_ready(cur);
    if constexpr (SP2) {
        PG8_STAGE(PG8_SB(0, 0), cB, voffB); PG8_STAGE(PG8_SB(0, 1), cB + hstep, voffB); PG8_STAGE(PG8_SA(0, 0), cA, voffA); PG8_STAGE(PG8_SA(0, 1), cA + hstep, voffA);
        if (wr == 1) PG8_BAR;
        PG8_WAIT_V(2); PG8_BAR;
        PG8_STAGE(PG8_SB(1, 0), cB + kstep, voffB); PG8_STAGE(PG8_SA(1, 0), cA + kstep, voffA); PG8_STAGE(PG8_SB(1, 1), cB + hstep + kstep, voffB);
        PG8_WAIT_V(6); PG8_BAR;
    } else {
        PG8_STAGE(PG8_SB(0, 0), cB, voffB); PG8_STAGE(PG8_SA(0, 0), cA, voffA); PG8_STAGE(PG8_SB(0, 1), cB + hstep, voffB); PG8_STAGE(PG8_SA(0, 1), cA + hstep, voffA);
        if (wr == 1) PG8_BAR;
        PG8_WAIT_V(4); PG8_BAR;
        PG8_STAGE(PG8_SB(1, 0), cB + kstep, voffB); PG8_STAGE(PG8_SA(1, 0), cA + kstep, voffA); PG8_STAGE(PG8_SB(1, 1), cB + hstep + kstep, voffB);
        PG8_WAIT_V(6); PG8_BAR;
    }
    for (;;) {
        const bool has_next = S.next(ui + 1, nxt);
        const char* nA = has_next ? (const char*)g.A + (size_t)nxt.pm * tstep : cA; const char* nB = has_next ? (const char*)g.Bt + (size_t)nxt.pn * tstep : cB;
        for (int t = 0; t < nt; t += 2) {
            const bool last = (t == nt - 2);
            const char* a1 = cA + (size_t)(t + 1) * kstep;
            const char* a2 = last ? nA : cA + (size_t)(t + 2) * kstep; const char* b2 = last ? nB : cB + (size_t)(t + 2) * kstep;
            const char* a3 = a2 + kstep; const char* b3 = b2 + kstep;
            if (last && has_next) S.a_ready(nxt);
            if constexpr (SP2) {
            PG8_LDB(B0, 0, 0); PG8_LDB(B1, 0, 1); PG8_SCHED; PG8_LDA(At, 0, 0); PG8_STAGE(PG8_SA(1, 1), a1 + hstep, voffA);
            PG8_WAIT_V(8); PG8_WAIT_L(0); PG8_BAR; PG8_MMA(0, 0, At, B0); PG8_MMA(0, 1, At, B1); PG8_BAR; PG8_SCHED;
            PG8_LDA(At, 0, 1); PG8_STAGE(PG8_SB(0, 0), b2, voffB); PG8_STAGE(PG8_SB(0, 1), b2 + hstep, voffB); PG8_STAGE(PG8_SA(0, 0), a2, voffA);
            PG8_WAIT_V(8); PG8_WAIT_L(0); PG8_BAR; PG8_MMA(1, 0, At, B0); PG8_MMA(1, 1, At, B1); PG8_BAR; PG8_SCHED;
            PG8_LDB(B0, 1, 0); PG8_LDB(B1, 1, 1); PG8_SCHED; PG8_LDA(At, 1, 0); PG8_STAGE(PG8_SA(0, 1), a2 + hstep, voffA);
            PG8_WAIT_V(8); PG8_WAIT_L(0); PG8_BAR; PG8_MMA(0, 0, At, B0); PG8_MMA(0, 1, At, B1); PG8_BAR; PG8_SCHED;
            PG8_LDA(At, 1, 1); PG8_STAGE(PG8_SB(1, 0), b3, voffB); PG8_STAGE(PG8_SB(1, 1), b3 + hstep, voffB); PG8_STAGE(PG8_SA(1, 0), a3, voffA);
            PG8_WAIT_V(8); PG8_WAIT_L(0); PG8_BAR; PG8_MMA(1, 0, At, B0); PG8_MMA(1, 1, At, B1); PG8_BAR; PG8_SCHED;
            } else {
            PG8_LDB(B0, 0, 0); PG8_SCHED; PG8_LDA(At, 0, 0); PG8_STAGE(PG8_SA(1, 1), a1 + hstep, voffA);
            PG8_WAIT_L(8); PG8_BAR; PG8_WAIT_L(0); PG8_MMA(0, 0, At, B0); PG8_BAR; PG8_SCHED;
            PG8_LDB(B1, 0, 1); PG8_STAGE(PG8_SB(0, 0), b2, voffB);
            PG8_BAR; PG8_WAIT_L(0); PG8_MMA(0, 1, At, B1); PG8_BAR;
            PG8_LDA(At, 0, 1); PG8_STAGE(PG8_SA(0, 0), a2, voffA);
            PG8_BAR; PG8_WAIT_L(0); PG8_MMA(1, 0, At, B0); PG8_BAR; PG8_SCHED;
            PG8_STAGE(PG8_SB(0, 1), b2 + hstep, voffB);
            PG8_WAIT_V(6); PG8_BAR; PG8_MMA(1, 1, At, B1); PG8_BAR;
            PG8_LDB(B0, 1, 0); PG8_SCHED; PG8_LDA(At, 1, 0); PG8_STAGE(PG8_SA(0, 1), a2 + hstep, voffA);
            PG8_WAIT_L(8); PG8_BAR; PG8_WAIT_L(0); PG8_MMA(0, 0, At, B0); PG8_BAR; PG8_SCHED;
            PG8_LDB(B1, 1, 1); PG8_STAGE(PG8_SB(1, 0), b3, voffB);
            PG8_BAR; PG8_WAIT_L(0); PG8_MMA(0, 1, At, B1); PG8_BAR;
            PG8_LDA(At, 1, 1); PG8_STAGE(PG8_SA(1, 0), a3, voffA);
            PG8_BAR; PG8_WAIT_L(0); PG8_MMA(1, 0, At, B0); PG8_BAR; PG8_SCHED;
            PG8_STAGE(PG8_SB(1, 1), b3 + hstep, voffB);
            PG8_WAIT_V(6); PG8_BAR; PG8_MMA(1, 1, At, B1); PG8_BAR;
            }
        }
        if constexpr (ALIGN_EPI) { if (wr == 0) PG8_BAR; }
        if constexpr (!Epi::AFTER_DRAIN) { E(acc, cur, wr, wc, fr, fq); S.done(cur); }
        if (!has_next) break;
#pragma unroll
        for (int a = 0; a < 2; ++a)
#pragma unroll
            for (int b = 0; b < 2; ++b)
#pragma unroll
                for (int m = 0; m < 4; ++m)
#pragma unroll
                    for (int n = 0; n < 2; ++n) acc[a][b][m][n] = (f32x4){0.f, 0.f, 0.f, 0.f};
        cur = nxt; cA = nA; cB = nB; ++ui;
        if constexpr (ALIGN_EPI) { if (wr == 1) PG8_BAR; }
    }
    PG8_WAIT_V(0);
    if constexpr (!ALIGN_EPI) { if (wr == 0) PG8_BAR; }
    PG8_BAR;
    if constexpr (Epi::AFTER_DRAIN) { E.fused(acc, cur, wr, wc, fr, fq, lds, wid, lane); S.done(cur); }
#undef PG8_SA
#undef PG8_SB
#undef PG8_STAGE
#undef PG8_LDA
#undef PG8_LDB
#undef PG8_MMA
#undef PG8_WAIT_V
#undef PG8_WAIT_L
#undef PG8_BAR
#undef PG8_SCHED
}
}
using pg8::bf16_t; using pg8::bf16x8; using pg8::f32x4; using pg8::u32x4; using pg8::Unit; using pg8::Gemm; using pg8::StaticOrder;
typedef float f32x2 __attribute__((ext_vector_type(2)));
typedef unsigned u32x2 __attribute__((ext_vector_type(2)));
#define LAS __attribute__((address_space(3)))

#ifndef NAIVE_GEMM
#define NAIVE_GEMM 0
#endif

constexpr int M = 16384, D = 1024, FF = 2816, SEQ = 2048, HC = 512, PLE = 256;
constexpr float EPS = 1e-6f;
constexpr size_t MiB = 1u << 20;
constexpr size_t WS_CTL = 0, WS_W = 1 * MiB, WS_FT = 45 * MiB, WS_PB = 53 * MiB, WS_XB = 69 * MiB, WS_R1 = 101 * MiB, WS_R2 = 197 * MiB, WS_END = 261 * MiB;
constexpr size_t W_GUA = 0, W_DA = 11 * MiB, W_IN = W_DA + 5767168, W_OUT = W_IN + 6 * MiB, W_GUB = W_OUT + 2 * MiB, W_DB = W_GUB + 11 * MiB, W_PG = W_DB + 5767168, W_PP = W_PG + 2 * MiB;
static_assert(W_PP + 512 * 1024 <= 44 * MiB, "weights");
constexpr int LDS_BYTES = 131072 + 4096;

struct KP { const float* in[30]; float* out; unsigned char* ws; };
typedef const __attribute__((address_space(4))) KP* KPC;
#define KPARAMS() ({ KPC q_ = (KPC)__builtin_amdgcn_kernarg_segment_ptr(); asm volatile("" : "+s"(q_)); q_; })

__device__ __forceinline__ unsigned cvt_pk_bf16(float lo, float hi) { unsigned r; asm volatile("v_cvt_pk_bf16_f32 %0, %1, %2" : "=v"(r) : "v"(lo), "v"(hi)); return r; }
__device__ __forceinline__ float bf_lo(unsigned w) { return __uint_as_float(w << 16); }
__device__ __forceinline__ float bf_hi(unsigned w) { return __uint_as_float(w & 0xffff0000u); }
__device__ __forceinline__ float bf2f(bf16_t b) { return __uint_as_float(((unsigned)b) << 16); }
__device__ __forceinline__ float wave_sum(float v) {
#pragma unroll
    for (int o = 1; o < 64; o <<= 1) v += __shfl_xor(v, o);
    return v;
}
__device__ __forceinline__ int fresh_tid(int wv) {
    int l; asm volatile("v_mbcnt_lo_u32_b32 %0, -1, 0\n\tv_mbcnt_hi_u32_b32 %0, -1, %0" : "=v"(l));
    return wv * 64 + l;
}
__device__ __forceinline__ int fresh_bx() { int b = blockIdx.x; asm volatile("" : "+s"(b)); return b; }
__device__ __forceinline__ float rstd_of(float ss, float invn) { return rsqrtf(ss * invn + EPS); }

struct EpiSwiGLU {
    static constexpr bool PERM = true, AFTER_DRAIN = false;
    bf16_t* H; const float* ss;
    __device__ __forceinline__ void operator()(const f32x4 (&acc)[2][2][4][2], const Unit& u, int wr, int wc, int fr, int fq) const {
        const int row0 = u.pm * 256 + wr * 64 + fr, col0 = u.pn * 128 + wc * 32 + 8 * fq;
#pragma unroll
        for (int ai = 0; ai < 2; ++ai)
#pragma unroll
            for (int m = 0; m < 4; ++m) {
                const int row = row0 + ai * 128 + m * 16;
                const float rs = rstd_of(ss[row], 1.0f / D);
                unsigned w[4];
#pragma unroll
                for (int n = 0; n < 2; ++n) {
                    float hv[4];
#pragma unroll
                    for (int e = 0; e < 4; ++e) {
                        const float g = acc[ai][0][m][n][e] * rs, uu = acc[ai][1][m][n][e] * rs;
                        hv[e] = g * __builtin_amdgcn_rcpf(1.0f + __expf(-g)) * uu;
                    }
                    w[2 * n] = cvt_pk_bf16(hv[0], hv[1]); w[2 * n + 1] = cvt_pk_bf16(hv[2], hv[3]);
                }
                *(u32x4*)(H + (size_t)row * FF + col0) = (u32x4){w[0], w[1], w[2], w[3]};
            }
    }
};
struct EpiResid {
    static constexpr bool PERM = false, AFTER_DRAIN = false;
    const float* base; float* X; bf16_t* xb; float* ssn; float alpha;
    __device__ __forceinline__ void operator()(const f32x4 (&acc)[2][2][4][2], const Unit& u, int wr, int wc, int fr, int fq) const {
        const int row0 = u.pm * 256 + wr * 64 + fr, col0 = u.pn * 256 + wc * 32 + 4 * fq;
#pragma unroll
        for (int ai = 0; ai < 2; ++ai)
#pragma unroll
            for (int m = 0; m < 4; ++m) {
                const int row = row0 + ai * 128 + m * 16; float sq = 0.f;
#pragma unroll
                for (int bj = 0; bj < 2; ++bj)
#pragma unroll
                    for (int n = 0; n < 2; ++n) {
                        const size_t off = (size_t)row * D + col0 + bj * 128 + n * 16;
                        const f32x4 bs = *(const f32x4*)(base + off);
                        const f32x4 o = bs + acc[ai][bj][m][n] * alpha;
                        *(f32x4*)(X + off) = o;
                        *(u32x2*)(xb + off) = (u32x2){cvt_pk_bf16(o[0], o[1]), cvt_pk_bf16(o[2], o[3])};
                        sq += (o[0] * o[0] + o[1] * o[1]) + (o[2] * o[2] + o[3] * o[3]);
                    }
                sq += __shfl_xor(sq, 16); sq += __shfl_xor(sq, 32);
                if (fq == 0) unsafeAtomicAdd(ssn + row, sq);
                asm volatile("" ::: "memory");
            }
    }
};
struct EpiPle {
    static constexpr bool PERM = false, AFTER_DRAIN = false;
    float* X; const float* PP; const float* ss; bf16_t* xb; float* ssn;
    __device__ __forceinline__ void operator()(const f32x4 (&acc)[2][2][4][2], const Unit& u, int wr, int wc, int fr, int fq) const {
        const int row0 = u.pm * 256 + wr * 64 + fr, col0 = u.pn * 256 + wc * 32 + 4 * fq;
#pragma unroll
        for (int ai = 0; ai < 2; ++ai)
#pragma unroll
            for (int m = 0; m < 4; ++m) {
                const int row = row0 + ai * 128 + m * 16; float sq = 0.f;
                const float rs = rstd_of(ss[row], 1.0f / D);
#pragma unroll
                for (int bj = 0; bj < 2; ++bj)
#pragma unroll
                    for (int n = 0; n < 2; ++n) {
                        const size_t off = (size_t)row * D + col0 + bj * 128 + n * 16;
                        const f32x4 bs = *(const f32x4*)(X + off);
                        const f32x4 pp = *(const f32x4*)(PP + off);
                        f32x4 o;
#pragma unroll
                        for (int e = 0; e < 4; ++e) { const float a = acc[ai][bj][m][n][e] * rs; o[e] = bs[e] + __builtin_amdgcn_rcpf(1.0f + __expf(-a)) * pp[e]; }
                        *(f32x4*)(X + off) = o;
                        *(u32x2*)(xb + off) = (u32x2){cvt_pk_bf16(o[0], o[1]), cvt_pk_bf16(o[2], o[3])};
                        sq += (o[0] * o[0] + o[1] * o[1]) + (o[2] * o[2] + o[3] * o[3]);
                    }
                sq += __shfl_xor(sq, 16); sq += __shfl_xor(sq, 32);
                if (fq == 0) unsafeAtomicAdd(ssn + row, sq);
                asm volatile("" ::: "memory");
            }
    }
};
struct EpiScaleRow {
    static constexpr bool PERM = true, AFTER_DRAIN = false;
    bf16_t* O; int ldc; const float* ss;
    __device__ __forceinline__ void operator()(const f32x4 (&acc)[2][2][4][2], const Unit& u, int wr, int wc, int fr, int fq) const {
        const int row0 = u.pm * 256 + wr * 64 + fr, col0 = u.pn * 256 + wc * 32 + 8 * fq;
#pragma unroll
        for (int ai = 0; ai < 2; ++ai)
#pragma unroll
            for (int m = 0; m < 4; ++m) {
                const int row = row0 + ai * 128 + m * 16;
                const float rs = rstd_of(ss[row], 1.0f / D);
#pragma unroll
                for (int bj = 0; bj < 2; ++bj) {
                    const f32x4 v0 = acc[ai][bj][m][0] * rs, v1 = acc[ai][bj][m][1] * rs;
                    *(u32x4*)(O + (size_t)row * ldc + col0 + bj * 128) = (u32x4){cvt_pk_bf16(v0[0], v0[1]), cvt_pk_bf16(v0[2], v0[3]), cvt_pk_bf16(v1[0], v1[1]), cvt_pk_bf16(v1[2], v1[3])};
                }
            }
    }
};
struct EpiScaleCol {
    static constexpr bool PERM = true, AFTER_DRAIN = false;
    bf16_t* O; int ldc; const float* ss;
    __device__ __forceinline__ void operator()(const f32x4 (&acc)[2][2][4][2], const Unit& u, int wr, int wc, int fr, int fq) const {
        const int row0 = u.pm * 256 + wr * 64 + fr, col0 = u.pn * 256 + wc * 32 + 8 * fq;
#pragma unroll
        for (int bj = 0; bj < 2; ++bj) {
            float rs[8];
            {
                const f32x4 a = *(const f32x4*)(ss + col0 + bj * 128), b = *(const f32x4*)(ss + col0 + bj * 128 + 4);
#pragma unroll
                for (int e = 0; e < 4; ++e) { rs[e] = rstd_of(a[e], 1.0f / D); rs[4 + e] = rstd_of(b[e], 1.0f / D); }
            }
#pragma unroll
            for (int ai = 0; ai < 2; ++ai)
#pragma unroll
                for (int m = 0; m < 4; ++m) {
                    const int row = row0 + ai * 128 + m * 16;
                    const f32x4 v0 = acc[ai][bj][m][0], v1 = acc[ai][bj][m][1];
                    *(u32x4*)(O + (size_t)row * ldc + col0 + bj * 128) = (u32x4){cvt_pk_bf16(v0[0] * rs[0], v0[1] * rs[1]), cvt_pk_bf16(v0[2] * rs[2], v0[3] * rs[3]),
                                                                                  cvt_pk_bf16(v1[0] * rs[4], v1[1] * rs[5]), cvt_pk_bf16(v1[2] * rs[6], v1[3] * rs[7])};
                }
        }
    }
};
struct EpiStoreF32 {
    static constexpr bool PERM = false, AFTER_DRAIN = false;
    float* O; int ldc;
    __device__ __forceinline__ void operator()(const f32x4 (&acc)[2][2][4][2], const Unit& u, int wr, int wc, int fr, int fq) const {
        const int row0 = u.pm * 256 + wr * 64 + fr, col0 = u.pn * 256 + wc * 32 + 4 * fq;
#pragma unroll
        for (int ai = 0; ai < 2; ++ai)
#pragma unroll
            for (int m = 0; m < 4; ++m)
#pragma unroll
                for (int bj = 0; bj < 2; ++bj)
#pragma unroll
                    for (int n = 0; n < 2; ++n) *(f32x4*)(O + (size_t)(row0 + ai * 128 + m * 16) * ldc + col0 + bj * 128 + n * 16) = acc[ai][bj][m][n];
    }
};

template <class Epi>
__device__ __forceinline__ void gemm_naive(int wv, const Gemm g, const StaticOrder& S, const Epi& E) {
    const int tid = fresh_tid(wv), wid = tid >> 6, lane = tid & 63, wr = wid >> 2, wc = wid & 3, fr = lane & 15, fq = lane >> 4;
    Unit u;
    for (int ui = 0; S.next(ui, u); ++ui) {
        f32x4 acc[2][2][4][2];
#pragma unroll
        for (int a = 0; a < 2; ++a)
#pragma unroll
            for (int b = 0; b < 2; ++b)
#pragma unroll
                for (int m = 0; m < 4; ++m)
#pragma unroll
                    for (int n = 0; n < 2; ++n) acc[a][b][m][n] = (f32x4){0.f, 0.f, 0.f, 0.f};
        for (int k0 = 0; k0 < g.K; k0 += 32) {
            bf16x8 Bf[2][2];
#pragma unroll
            for (int bj = 0; bj < 2; ++bj)
#pragma unroll
                for (int n = 0; n < 2; ++n) {
                    const int slot = 16 * n + fr; const int rr = Epi::PERM ? pg8::perm32(slot) : slot;
                    Bf[bj][n] = *(const bf16x8*)(g.Bt + (size_t)(u.pn * 256 + bj * 128 + wc * 32 + rr) * g.K + k0 + 8 * fq);
                }
#pragma unroll
            for (int ai = 0; ai < 2; ++ai)
#pragma unroll
                for (int m = 0; m < 4; ++m) {
                    const bf16x8 Af = *(const bf16x8*)(g.A + (size_t)(u.pm * 256 + ai * 128 + wr * 64 + m * 16 + fr) * g.K + k0 + 8 * fq);
#pragma unroll
                    for (int bj = 0; bj < 2; ++bj)
#pragma unroll
                        for (int n = 0; n < 2; ++n) acc[ai][bj][m][n] = __builtin_amdgcn_mfma_f32_16x16x32_bf16(Bf[bj][n], Af, acc[ai][bj][m][n], 0, 0, 0);
                }
        }
        E(acc, u, wr, wc, fr, fq);
    }
}
template <class Epi>
__device__ __forceinline__ void gemm_run(int wv, LAS unsigned char* lds, const bf16_t* A, const bf16_t* Bt, int Mm, int Nn, int Kk, const Epi& E) {
    int bx_ = blockIdx.x; asm volatile("" : "+s"(bx_));
    Gemm g{A, Bt, Mm, Nn, Kk}; StaticOrder S; S.init(Mm, Nn, (int)gridDim.x, bx_);
#if NAIVE_GEMM
    gemm_naive<Epi>(wv, g, S, E);
    __syncthreads();
#else
    pg8::gemm_phase<Epi, StaticOrder, true, true>(lds, g, S, E, fresh_tid(wv));
#endif
}

__device__ __forceinline__ void transpose_item(const float* W, int K, int N, const float* gain, bf16_t* WT, int mode, int row_off, LAS float* scr, int item, int lane) {
    const int nblk = N / 32, kb = item / nblk, nb = item % nblk, k0 = 64 * kb, n0 = 32 * nb;
#pragma unroll 8
    for (int i = 0; i < 32; ++i) { const int kk = 2 * i + (lane >> 5); float v = W[(size_t)(k0 + kk) * N + n0 + (lane & 31)]; if (gain) v *= gain[k0 + kk]; scr[kk * 33 + (lane & 31)] = v; }
    asm volatile("s_waitcnt lgkmcnt(0)" ::: "memory");
    const int c = lane & 7;
#pragma unroll
    for (int j = 0; j < 4; ++j) {
        const int n = (lane >> 3) + 8 * j, ncol = n0 + n; const LAS float* s = scr + (8 * c) * 33 + n;
        const int row = (mode == 1) ? (256 * (ncol >> 7) + (ncol & 127) + row_off) : (row_off + ncol);
        const float sc = (mode == 2 && ncol < 512) ? 0.125f : 1.0f;
        u32x4 o; o.x = cvt_pk_bf16(s[0 * 33] * sc, s[1 * 33] * sc); o.y = cvt_pk_bf16(s[2 * 33] * sc, s[3 * 33] * sc); o.z = cvt_pk_bf16(s[4 * 33] * sc, s[5 * 33] * sc); o.w = cvt_pk_bf16(s[6 * 33] * sc, s[7 * 33] * sc);
        *(u32x4*)(WT + (size_t)row * K + k0 + 8 * c) = o;
    }
    asm volatile("s_waitcnt lgkmcnt(0)" ::: "memory");
}

constexpr float MIN_DECAY = -3.0701134573253946f, MAX_DECAY = -15.350567286626973f;
__device__ __forceinline__ void filter_item(KPC p, int layer, int item, int lane, float* FT) {
    const float* wf1 = p->in[11] + layer * 33 * 64; const float* bf1 = p->in[12] + layer * 64;
    const float* wf2 = p->in[13] + layer * 4096;    const float* bf2 = p->in[14] + layer * 64;
    const float* wf3 = p->in[15] + layer * 4096;    const float* bf3 = p->in[16] + layer * 64;
    const float* wf4 = p->in[17] + layer * 64 * 1024; const float fq = p->in[18][layer * 64 + lane];
    const int i0 = item * 4;
    float h[4];
#pragma unroll
    for (int q = 0; q < 4; ++q) {
        const int i = i0 + q;
        const float t = (float)i * (1.0f / 2047.0f), w = 6.283185307179586f * (float)i / 2048.0f;
        const int j = (lane - 1) & 15; const float f = 1e-4f + (float)j * ((15.0f - 1e-4f) / 15.0f);
        const float a = f * w;
        float zf = 0.f;
        if (lane == 0) zf = t; else if (lane <= 16) zf = __cosf(a); else if (lane <= 32) zf = -__sinf(a);
        float s = bf1[lane];
        for (int k = 0; k < 33; ++k) s += __shfl(zf, k) * wf1[k * 64 + lane];
        h[q] = __sinf(fq * s);
    }
#pragma unroll
    for (int q = 0; q < 4; ++q) {
        float s = bf2[lane];
        for (int k = 0; k < 64; ++k) s += __shfl(h[q], k) * wf2[k * 64 + lane];
        const float h2 = __sinf(fq * s);
        float s3 = bf3[lane];
        for (int k = 0; k < 64; ++k) s3 += __shfl(h2, k) * wf3[k * 64 + lane];
        h[q] = __sinf(fq * s3);
    }
    float acc[4][16];
#pragma unroll
    for (int q = 0; q < 4; ++q)
#pragma unroll
        for (int jj = 0; jj < 16; ++jj) acc[q][jj] = 0.f;
    for (int k = 0; k < 64; ++k) {
        const float h0 = __shfl(h[0], k), h1 = __shfl(h[1], k), h2 = __shfl(h[2], k), h3 = __shfl(h[3], k);
#pragma unroll
        for (int jj = 0; jj < 16; ++jj) { const float w = wf4[k * 1024 + lane + 64 * jj]; acc[0][jj] += h0 * w; acc[1][jj] += h1 * w; acc[2][jj] += h2 * w; acc[3][jj] += h3 * w; }
    }
#pragma unroll
    for (int jj = 0; jj < 16; ++jj) {
        const int cf = lane + 64 * jj, dir = cf >> 9, c = cf & 511;
        const float delta = fabsf(MIN_DECAY + (float)c * ((MAX_DECAY - MIN_DECAY) / 511.0f));
        f32x4 o;
#pragma unroll
        for (int q = 0; q < 4; ++q) { const float t = (float)(i0 + q) * (1.0f / 2047.0f); o[q] = acc[q][jj] * __expf(-t * delta); }
        *(f32x4*)(FT + ((size_t)(dir * 512 + c)) * SEQ + i0) = o;
    }
}

__device__ __forceinline__ void layer_prologue(int wv, KPC p, int layer, LAS unsigned char* lds) {
    const int tid = fresh_tid(wv), bx = fresh_bx(), lane = tid & 63, wave = tid >> 6;
    LAS float* scr = (LAS float*)(lds + wave * 16384);
    const int gw = bx * 8 + wave, NGW = gridDim.x * 8;
    unsigned char* Wb = p->ws + WS_W;
    const size_t lf = (size_t)layer;
    constexpr int I_G = 16 * 88, I_D = 44 * 32, I_IN = 16 * 96, I_O = 16 * 32, I_PP = 4 * 32;
    constexpr int NITEMS = 6 * I_G + I_IN + 2 * I_O + I_PP;
    static_assert(I_G == I_D, "items");
    for (int it = gw; it < NITEMS + 512; it += NGW) {
        int r = it;
        if (r >= NITEMS) { filter_item(p, layer, r - NITEMS, lane, (float*)(p->ws + WS_FT)); continue; }
        int wi, gi = -1, K = D, N = FF, mode = 1, row_off = 0; size_t wo = W_GUA, wstride = (size_t)D * FF;
        if (r < I_G) { wi = 3; gi = 2; }
        else if ((r -= I_G) < I_G) { wi = 4; gi = 2; row_off = 128; }
        else if ((r -= I_G) < I_D) { wi = 5; K = FF; N = D; mode = 0; wo = W_DA; }
        else if ((r -= I_D) < I_IN) { wi = 7; gi = 6; N = 3072; mode = 2; wo = W_IN; wstride = (size_t)D * 3072; }
        else if ((r -= I_IN) < I_O) { wi = 21; gi = 20; N = D; mode = 0; wo = W_OUT; wstride = (size_t)D * D; }
        else if ((r -= I_O) < I_G) { wi = 23; gi = 22; wo = W_GUB; }
        else if ((r -= I_G) < I_G) { wi = 24; gi = 22; row_off = 128; wo = W_GUB; }
        else if ((r -= I_G) < I_D) { wi = 25; K = FF; N = D; mode = 0; wo = W_DB; }
        else if ((r -= I_D) < I_O) { wi = 27; gi = 26; N = D; mode = 0; wo = W_PG; wstride = (size_t)D * D; }
        else { r -= I_O; wi = 28; K = PLE; N = D; mode = 0; wo = W_PP; wstride = (size_t)PLE * D; }
        const float* gain = gi >= 0 ? p->in[gi] + lf * D : nullptr;
        transpose_item(p->in[wi] + lf * wstride, K, N, gain, (bf16_t*)(Wb + wo), mode, row_off, scr, r, lane);
    }
    if (layer == 0) {
        bf16_t* xb = (bf16_t*)(p->ws + WS_XB); float* ss0 = (float*)(p->ws + WS_CTL);
        for (int m = gw; m < M; m += NGW) {
            const f32x4* xr = (const f32x4*)(p->in[0] + (size_t)m * D) + lane;
            f32x4 v[4]; float s = 0.f;
#pragma unroll
            for (int j = 0; j < 4; ++j) { v[j] = xr[64 * j]; s += (v[j][0] * v[j][0] + v[j][1] * v[j][1]) + (v[j][2] * v[j][2] + v[j][3] * v[j][3]); }
            s = wave_sum(s);
            if (lane == 0) ss0[m] = s;
            u32x2* o8 = (u32x2*)(xb + (size_t)m * D) + lane;
#pragma unroll
            for (int j = 0; j < 4; ++j) o8[64 * j] = (u32x2){cvt_pk_bf16(v[j][0], v[j][1]), cvt_pk_bf16(v[j][2], v[j][3])};
        }
        bf16_t* pb = (bf16_t*)(p->ws + WS_PB);
        const size_t n8 = (size_t)2 * M * PLE / 8;
        for (size_t i = (size_t)bx * 512 + tid; i < n8; i += (size_t)gridDim.x * 512) {
            const f32x4 a = *(const f32x4*)(p->in[1] + i * 8), b = *(const f32x4*)(p->in[1] + i * 8 + 4);
            *(u32x4*)(pb + i * 8) = (u32x4){cvt_pk_bf16(a[0], a[1]), cvt_pk_bf16(a[2], a[3]), cvt_pk_bf16(b[0], b[1]), cvt_pk_bf16(b[2], b[3])};
        }
    }
}

__device__ __forceinline__ void attn_naive(int wv, KPC p, int layer, const bf16_t* QK, const bf16_t* UT, bf16_t* yna) {
    const float* rpb = p->in[8] + layer * 8 * 15 * 31;
    const int tid = fresh_tid(wv), bx = fresh_bx();
    for (int it = bx * 512 + tid; it < M * 8; it += gridDim.x * 512) {
        const int h = it / M, tok = it % M;
        const int b = tok >> 11, l = tok & 2047, r = l >> 6, qc = l & 63;
        const int rs = min(max(r - 4, 0), 24), qcs = min(max(qc - 8, 0), 48);
        float o[64]; u32x4 qp[8];
#pragma unroll
        for (int j = 0; j < 8; ++j) qp[j] = *(const u32x4*)(QK + (size_t)tok * 1024 + 64 * h + 8 * j);
#pragma unroll
        for (int d = 0; d < 64; ++d) o[d] = 0.f;
        float mx = -3.0e38f, ls = 0.f;
        for (int kr = 0; kr < 8; ++kr)
            for (int kx = 0; kx < 16; ++kx) {
                const int krow = rs + kr, kc = qcs + kx; const size_t ktok = (size_t)b * 2048 + krow * 64 + kc;
                float s = 0.f;
#pragma unroll
                for (int j = 0; j < 8; ++j) {
                    const u32x4 v = *(const u32x4*)(QK + ktok * 1024 + 512 + 64 * h + 8 * j);
                    const u32x4 qq = qp[j];
                    s += bf_lo(qq.x) * bf_lo(v.x) + bf_hi(qq.x) * bf_hi(v.x) + bf_lo(qq.y) * bf_lo(v.y) + bf_hi(qq.y) * bf_hi(v.y)
                       + bf_lo(qq.z) * bf_lo(v.z) + bf_hi(qq.z) * bf_hi(v.z) + bf_lo(qq.w) * bf_lo(v.w) + bf_hi(qq.w) * bf_hi(v.w);
                }
                s += rpb[(h * 15 + (krow - r + 7)) * 31 + (kc - qc + 15)];
                const float mn = fmaxf(mx, s), corr = __expf(mx - mn), pe = __expf(s - mn);
                ls = ls * corr + pe; mx = mn;
#pragma unroll
                for (int d = 0; d < 64; ++d) o[d] = o[d] * corr + pe * bf2f(UT[(size_t)(64 * h + d) * M + ktok]);
            }
        const float inv = 1.0f / ls;
#pragma unroll
        for (int j = 0; j < 8; ++j)
            *(u32x4*)(yna + (size_t)tok * 512 + 64 * h + 8 * j) = (u32x4){cvt_pk_bf16(o[8 * j] * inv, o[8 * j + 1] * inv), cvt_pk_bf16(o[8 * j + 2] * inv, o[8 * j + 3] * inv),
                                                                         cvt_pk_bf16(o[8 * j + 4] * inv, o[8 * j + 5] * inv), cvt_pk_bf16(o[8 * j + 6] * inv, o[8 * j + 7] * inv)};
    }
}

__device__ __forceinline__ float sconv(const bf16_t* row, int t, float w0, float w1, float w2, float bb) {
    const float a = t > 0 ? bf2f(row[t - 1]) : 0.f, b = bf2f(row[t]), c = t < SEQ - 1 ? bf2f(row[t + 1]) : 0.f;
    return a * w0 + b * w1 + c * w2 + bb;
}
__device__ __forceinline__ void conv_naive(int wv, KPC p, int layer, LAS unsigned char* lds, const bf16_t* UT, const float* FT, bf16_t* yhyT) {
    LAS float* karr = (LAS float*)lds; LAS float* zf = karr + 4096; LAS float* x0f = zf + 2048; LAS float* red = x0f + 2048;
    const float* wsc = p->in[9] + layer * 3 * 1536; const float* bsc = p->in[10] + layer * 1536; const float* hyb = p->in[19] + layer * 512;
    const int tid = fresh_tid(wv), bx = fresh_bx(), lane = tid & 63, wave = tid >> 6;
    for (int it = bx; it < 512 * 8; it += gridDim.x) {
        const int c = it >> 3, b = it & 7;
        __syncthreads();
        float asum = 0.f;
        for (int d = tid; d < 4096; d += 512) {
            const int dd = d - 2048; float v;
            if (dd == -2048) v = 0.f; else if (dd == 0) v = FT[(size_t)c * SEQ] + FT[(size_t)(512 + c) * SEQ]; else if (dd > 0) v = FT[(size_t)c * SEQ + dd]; else v = FT[(size_t)(512 + c) * SEQ - dd];
            karr[d] = v; asum += fabsf(v);
        }
        {
            const bf16_t* r0 = UT + (size_t)(512 + c) * M + b * 2048; const bf16_t* r1 = UT + (size_t)(1024 + c) * M + b * 2048; const bf16_t* r2 = UT + (size_t)(1536 + c) * M + b * 2048;
            const float a0 = wsc[c], a1 = wsc[1536 + c], a2 = wsc[3072 + c], ab = bsc[c];
            const float b0 = wsc[512 + c], b1 = wsc[1536 + 512 + c], b2 = wsc[3072 + 512 + c], bb = bsc[512 + c];
            const float c0 = wsc[1024 + c], c1 = wsc[1536 + 1024 + c], c2 = wsc[3072 + 1024 + c], cb = bsc[1024 + c];
            for (int t = tid; t < 2048; t += 512) {
                x0f[t] = sconv(r0, t, a0, a1, a2, ab);
                zf[t] = sconv(r1, t, b0, b1, b2, bb) * sconv(r2, t, c0, c1, c2, cb);
            }
        }
        asum = wave_sum(asum);
        if (lane == 0) red[wave] = asum;
        __syncthreads();
        float kn = 0.f;
#pragma unroll
        for (int w = 0; w < 8; ++w) kn += red[w];
        const float ikn = 1.0f / kn, hb = hyb[c];
#pragma unroll
        for (int e = 0; e < 4; ++e) {
            const int t = tid + 512 * e; float acc = 0.f;
            for (int s = 0; s < 2048; ++s) acc += karr[t - s + 2048] * zf[s];
            const float y = x0f[t] * (acc * ikn + zf[t] * hb);
            yhyT[(size_t)c * M + b * 2048 + t] = (bf16_t)(cvt_pk_bf16(y, 0.f) & 0xffffu);
        }
    }
}

__device__ __forceinline__ void post_pass(int wv, LAS unsigned char* lds, const bf16_t* yna, const bf16_t* yhyT, bf16_t* yn) {
    LAS bf16_t* tile = (LAS bf16_t*)lds;
    const int tid = fresh_tid(wv), bx = fresh_bx(), lane = tid & 63, wave = tid >> 6;
    for (int it = bx; it < M / 32; it += gridDim.x) {
        const int tok0 = it * 32;
        __syncthreads();
        {
            const u32x4* src = (const u32x4*)(yhyT + (size_t)tid * M + tok0);
#pragma unroll
            for (int j = 0; j < 4; ++j) {
                const u32x4 v = src[j];
                tile[(8 * j + 0) * 520 + tid] = (bf16_t)(v.x & 0xffffu); tile[(8 * j + 1) * 520 + tid] = (bf16_t)(v.x >> 16);
                tile[(8 * j + 2) * 520 + tid] = (bf16_t)(v.y & 0xffffu); tile[(8 * j + 3) * 520 + tid] = (bf16_t)(v.y >> 16);
                tile[(8 * j + 4) * 520 + tid] = (bf16_t)(v.z & 0xffffu); tile[(8 * j + 5) * 520 + tid] = (bf16_t)(v.z >> 16);
                tile[(8 * j + 6) * 520 + tid] = (bf16_t)(v.w & 0xffffu); tile[(8 * j + 7) * 520 + tid] = (bf16_t)(v.w >> 16);
            }
        }
        __syncthreads();
#pragma unroll
        for (int q = 0; q < 4; ++q) {
            const int tk = 4 * wave + q; const size_t tok = (size_t)tok0 + tk;
#pragma unroll
            for (int half = 0; half < 2; ++half) {
                u32x4 v;
                if (half == 0) v = *(const u32x4*)(yna + tok * 512 + 8 * lane); else v = *(const LAS u32x4*)(tile + tk * 520 + 8 * lane);
                float f[8] = {bf_lo(v.x), bf_hi(v.x), bf_lo(v.y), bf_hi(v.y), bf_lo(v.z), bf_hi(v.z), bf_lo(v.w), bf_hi(v.w)};
                float s = 0.f;
#pragma unroll
                for (int e = 0; e < 8; ++e) s += f[e] * f[e];
                s = wave_sum(s);
                const float rs = rstd_of(s, 1.0f / 512.0f);
                *(u32x4*)(yn + tok * 1024 + half * 512 + 8 * lane) = (u32x4){cvt_pk_bf16(f[0] * rs, f[1] * rs), cvt_pk_bf16(f[2] * rs, f[3] * rs), cvt_pk_bf16(f[4] * rs, f[5] * rs), cvt_pk_bf16(f[6] * rs, f[7] * rs)};
            }
        }
    }
}

__global__ void __launch_bounds__(512, 2) hybrid_fwd(KP kparams_unused) {
    extern __shared__ __attribute__((aligned(16))) unsigned char lds_raw[];
    LAS unsigned char* lds = (LAS unsigned char*)lds_raw;
    cg::grid_group grid = cg::this_grid();
    const int wv = __builtin_amdgcn_readfirstlane((int)(threadIdx.x >> 6));
#define WSV() KPC p = KPARAMS(); unsigned char* ws = p->ws; float* ss = (float*)(ws + WS_CTL) + (size_t)(4 * layer) * M;   \
    bf16_t* xb = (bf16_t*)(ws + WS_XB); bf16_t* Hb = (bf16_t*)(ws + WS_R1); bf16_t* QK = (bf16_t*)(ws + WS_R1); bf16_t* UT = (bf16_t*)(ws + WS_R1 + 32 * MiB); \
    bf16_t* yna = (bf16_t*)(ws + WS_R2); bf16_t* yhyT = (bf16_t*)(ws + WS_R2 + 16 * MiB); bf16_t* yn = (bf16_t*)(ws + WS_R2 + 32 * MiB); float* PP = (float*)(ws + WS_R2); \
    bf16_t* pb = (bf16_t*)(ws + WS_PB); const float* FT = (const float*)(ws + WS_FT); unsigned char* Wb = ws + WS_W; float* X = p->out; \
    (void)ss; (void)xb; (void)Hb; (void)QK; (void)UT; (void)yna; (void)yhyT; (void)yn; (void)PP; (void)pb; (void)FT; (void)Wb; (void)X;

    for (int layer = 0; layer < 2; ++layer) {
#ifndef NO_PRO
        { WSV(); layer_prologue(wv, p, layer, lds); }
#endif
        grid.sync();
        { WSV(); gemm_run(wv, lds, xb, (const bf16_t*)(Wb + W_GUA), M, 2 * FF, D, EpiSwiGLU{Hb, ss}); }
        grid.sync();
        { WSV(); gemm_run(wv, lds, Hb, (const bf16_t*)(Wb + W_DA), M, D, FF, EpiResid{layer == 0 ? p->in[0] : X, X, xb, ss + M, 0.5f}); }
        grid.sync();
        { WSV(); gemm_run(wv, lds, (const bf16_t*)(Wb + W_IN) + (size_t)1024 * D, xb, 2048, M, D, EpiScaleCol{UT, M, ss + M}); }
        { WSV(); gemm_run(wv, lds, xb, (const bf16_t*)(Wb + W_IN), M, 1024, D, EpiScaleRow{QK, 1024, ss + M}); }
        grid.sync();
#ifndef NO_ATTN
        { WSV(); attn_naive(wv, p, layer, QK, UT, yna); }
#endif
#ifndef NO_CONV
        { WSV(); conv_naive(wv, p, layer, lds, UT, FT, yhyT); }
#endif
        grid.sync();
#ifndef NO_POST
        { WSV(); post_pass(wv, lds, yna, yhyT, yn); }
#endif
        grid.sync();
        { WSV(); gemm_run(wv, lds, yn, (const bf16_t*)(Wb + W_OUT), M, D, D, EpiResid{X, X, xb, ss + 2 * M, 1.0f}); }
        grid.sync();
        { WSV(); gemm_run(wv, lds, pb + (size_t)layer * M * PLE, (const bf16_t*)(Wb + W_PP), M, D, PLE, EpiStoreF32{PP, D}); }
        { WSV(); gemm_run(wv, lds, xb, (const bf16_t*)(Wb + W_GUB), M, 2 * FF, D, EpiSwiGLU{Hb, ss + 2 * M}); }
        grid.sync();
        { WSV(); gemm_run(wv, lds, Hb, (const bf16_t*)(Wb + W_DB), M, D, FF, EpiResid{X, X, xb, ss + 3 * M, 0.5f}); }
        grid.sync();
        { WSV(); gemm_run(wv, lds, xb, (const bf16_t*)(Wb + W_PG), M, D, D, EpiPle{X, PP, ss + 3 * M, xb, ss + 4 * M}); }
        grid.sync();
    }
    {
        const int layer = 2; WSV();
        const int tid = fresh_tid(wv), bx = fresh_bx(), lane = tid & 63, wave = tid >> 6;
        const float* gf = p->in[29];
        for (int m = bx * 8 + wave; m < M; m += gridDim.x * 8) {
            const float rs = rstd_of(ss[m], 1.0f / D);
            f32x4* xr = (f32x4*)(X + (size_t)m * D) + lane; const f32x4* gr = (const f32x4*)gf + lane;
#pragma unroll
            for (int j = 0; j < 4; ++j) { f32x4 v = xr[64 * j]; const f32x4 g = gr[64 * j]; v = v * rs * g; xr[64 * j] = v; }
        }
    }
}

extern "C" void kernel_launch(void* const* d_in, const int* in_sizes, int n_in, void* d_out, int out_size, void* d_ws, size_t ws_size, hipStream_t stream) {
    static int grid = 0;
    if (grid == 0) {
        if (n_in != 30 || out_size != M * D || ws_size < WS_END) { fprintf(stderr, "kernel_launch: unexpected shapes: n_in %d out %d ws %zu (need %zu)\n", n_in, out_size, ws_size, (size_t)WS_END); grid = -1; return; }
        int dev = 0, cus = 0, per_cu = 0;
        hipGetDevice(&dev);
        hipDeviceGetAttribute(&cus, hipDeviceAttributeMultiprocessorCount, dev);
        if (hipFuncSetAttribute((const void*)hybrid_fwd, hipFuncAttributeMaxDynamicSharedMemorySize, LDS_BYTES) != hipSuccess) { fprintf(stderr, "kernel_launch: hipFuncSetAttribute failed\n"); }
        if (hipOccupancyMaxActiveBlocksPerMultiprocessor(&per_cu, (const void*)hybrid_fwd, 512, LDS_BYTES) != hipSuccess || per_cu < 1) { fprintf(stderr, "kernel_launch: occupancy query says %d\n", per_cu); per_cu = 1; }
        (void)hipGetLastError();
        grid = cus * per_cu;
        fprintf(stderr, "kernel_launch: grid %d (cus %d x %d)\n", grid, cus, per_cu);
    }
    if (grid < 0) return;
    (void)hipMemsetAsync((char*)d_ws + WS_CTL, 0, 1 * MiB, stream);
    KP hp{};
    for (int i = 0; i < 30; ++i) hp.in[i] = (const float*)d_in[i];
    hp.out = (float*)d_out; hp.ws = (unsigned char*)d_ws;
    void* args[] = {&hp};
    hipError_t e = hipLaunchCooperativeKernel((const void*)hybrid_fwd, dim3(grid), dim3(512), args, LDS_BYTES, stream);
    if (e != hipSuccess) fprintf(stderr, "kernel_launch: cooperative launch failed: %s (grid %d)\n", hipGetErrorString(e), grid);
}
```

```cpp
#include <hip/hip_runtime.h>
#include <hip/hip_cooperative_groups.h>
#include <cstdio>
#include <cstdint>
namespace cg = cooperative_groups;
namespace pg8 {
#define PG8_LAS __attribute__((address_space(3)))
typedef unsigned short bf16_t;
typedef short bf16x8 __attribute__((ext_vector_type(8)));
typedef float f32x4 __attribute__((ext_vector_type(4)));
typedef unsigned u32x4 __attribute__((ext_vector_type(4)));
constexpr int BM = 256, BK = 64, HALF = 128, HTB = HALF * BK * 2  , STAGE_BYTES = 8 * HTB, NXCD = 8, WGM = 8;

__host__ __device__ __forceinline__ int lds_byte(int r, int c) { const int st = (r >> 4) * 2 + (c >> 5), rr = r & 15, cc = c & 31, ob = rr * 64 + cc * 2; return st * 1024 + (ob ^ (((ob >> 9) & 1) << 5)); }
__host__ __device__ __forceinline__ void stage_rc(int b, int& R, int& C) { const int st = b / 1024, sb = b % 1024, swz = sb ^ (((sb >> 9) & 1) << 5); R = (st >> 1) * 16 + swz / 64; C = (st & 1) * 32 + (swz % 64) / 2; }
__host__ __device__ __forceinline__ int perm32(int rho) { const int n = rho >> 4, i = rho & 15; return 8 * (i >> 2) + 4 * n + (i & 3); }

struct Unit { int pm, pn; };
struct Gemm { const bf16_t* A; const bf16_t* Bt; int M, N, K; };

struct StaticOrder {
    int nM, nN, nwg, G, c;
    __host__ __device__ void init(int M, int N, int G_, int c_) { nM = M / BM; nN = N / BM; nwg = nM * nN; G = G_; c = c_; }
    __host__ __device__ bool next(int i, Unit& u) const {
        const long L = (long)i * G + c; if (L >= nwg) return false;
        int wgid = (int)L; { const int q = nwg / NXCD, r = nwg % NXCD, xcd = wgid % NXCD, off = wgid / NXCD; wgid = (xcd < r ? xcd * (q + 1) : r * (q + 1) + (xcd - r) * q) + off; }
        const int nig = WGM * nN, gid = wgid / nig, fm = gid * WGM, gsz = (nM - fm) < WGM ? (nM - fm) : WGM;
        u.pm = fm + ((wgid % nig) % gsz); u.pn = (wgid % nig) / gsz; return true;
    }
    __device__ __forceinline__ void a_ready(const Unit&) const {}
    __device__ __forceinline__ void done(const Unit&) const {}
};

template <class Epi, class Sched, bool ALIGN_EPI = false, bool SP2 = false>
__device__ __forceinline__ void gemm_phase(PG8_LAS unsigned char* lds, const Gemm g, const Sched& S, const Epi& E, int tid_in) {
    int tid_ = tid_in; asm volatile("" : "+v"(tid_)); const int tid = tid_, wid = __builtin_amdgcn_readfirstlane(tid >> 6), lane = tid & 63, wr = wid >> 2, wc = wid & 3, fr = lane & 15, fq = lane >> 4;
    const int K = g.K, nt = K / BK;
    unsigned voffA[2], voffB[2];
#pragma unroll
    for (int i = 0; i < 2; ++i) { int R, C; stage_rc(tid * 16 + i * 8192, R, C); const int Rb = Epi::PERM ? ((R & ~31) + perm32(R & 31)) : R;
        voffA[i] = (unsigned)(R * K + C) * 2u; voffB[i] = (unsigned)(Rb * K + C) * 2u; }
    const size_t kstep = (size_t)(BK * 2);
    const size_t hstep = (size_t)HALF * K * 2;
    const size_t tstep = 2 * hstep;
    const unsigned ldsw = (unsigned)wid * 1024u;
    const int aoff = lds_byte(wr * 64 + fr, fq * 8), boff = lds_byte(wc * 32 + fr, fq * 8);
#define PG8_SA(b, h) (((b) * 2 + (h)) * HTB)
#define PG8_SB(b, h) ((4 + (b) * 2 + (h)) * HTB)
#define PG8_STAGE(bufoff, gbase, voff) do { _Pragma("unroll") for (int _i = 0; _i < 2; ++_i) \
        __builtin_amdgcn_global_load_lds((const unsigned*)((const char*)(gbase) + (voff)[_i]), (PG8_LAS unsigned*)(lds + (bufoff) + ldsw + _i * 8192), 16, 0, 0); } while (0)
#define PG8_LDA(dst, b, h) do { _Pragma("unroll") for (int m = 0; m < 4; ++m) _Pragma("unroll") for (int k = 0; k < 2; ++k) dst[m][k] = *(const PG8_LAS bf16x8*)(lds + PG8_SA(b, h) + aoff + m * 2048 + k * 1024); } while (0)
#define PG8_LDB(dst, b, h) do { _Pragma("unroll") for (int n = 0; n < 2; ++n) _Pragma("unroll") for (int k = 0; k < 2; ++k) dst[n][k] = *(const PG8_LAS bf16x8*)(lds + PG8_SB(b, h) + boff + n * 2048 + k * 1024); } while (0)
#define PG8_MMA(ai, bj, At, Bt) do { __builtin_amdgcn_s_setprio(1); _Pragma("unroll") for (int m = 0; m < 4; ++m) _Pragma("unroll") for (int n = 0; n < 2; ++n) _Pragma("unroll") for (int k = 0; k < 2; ++k) \
        acc[ai][bj][m][n] = __builtin_amdgcn_mfma_f32_16x16x32_bf16(Bt[n][k], At[m][k], acc[ai][bj][m][n], 0, 0, 0); __builtin_amdgcn_s_setprio(0); } while (0)
#define PG8_WAIT_V(n) asm volatile("s_waitcnt vmcnt(" #n ")" ::: "memory")
#define PG8_WAIT_L(n) asm volatile("s_waitcnt lgkmcnt(" #n ")" ::: "memory")
#define PG8_BAR __builtin_amdgcn_s_barrier()
#define PG8_SCHED __builtin_amdgcn_sched_barrier(0)
    Unit cur, nxt; int ui = 0;
    if (!S.next(0, cur)) return;
    f32x4 acc[2][2][4][2];
#pragma unroll
    for (int a = 0; a < 2; ++a)
#pragma unroll
        for (int b = 0; b < 2; ++b)
#pragma unroll
            for (int m = 0; m < 4; ++m)
#pragma unroll
                for (int n = 0; n < 2; ++n) acc[a][b][m][n] = (f32x4){0.f, 0.f, 0.f, 0.f};
    bf16x8 At[4][2], B0[2][2], B1[2][2];
    const char* cA = (const char*)g.A + (size_t)cur.pm * tstep; const char* cB = (const char*)g.Bt + (size_t)cur.pn * tstep;
    S.a_ready(cur);
    if constexpr (SP2) {
        PG8_STAGE(PG8_SB(0, 0), cB, voffB); PG8_STAGE(PG8_SB(0, 1), cB + hstep, voffB); PG8_STAGE(PG8_SA(0, 0), cA, voffA); PG8_STAGE(PG8_SA(0, 1), cA + hstep, voffA);
        if (wr == 1) PG8_BAR;
        PG8_WAIT_V(2); PG8_BAR;
        PG8_STAGE(PG8_SB(1, 0), cB + kstep, voffB); PG8_STAGE(PG8_SA(1, 0), cA + kstep, voffA); PG8_STAGE(PG8_SB(1, 1), cB + hstep + kstep, voffB);
        PG8_WAIT_V(6); PG8_BAR;
    } else {
        PG8_STAGE(PG8_SB(0, 0), cB, voffB); PG8_STAGE(PG8_SA(0, 0), cA, voffA); PG8_STAGE(PG8_SB(0, 1), cB + hstep, voffB); PG8_STAGE(PG8_SA(0, 1), cA + hstep, voffA);
        if (wr == 1) PG8_BAR;
        PG8_WAIT_V(4); PG8_BAR;
        PG8_STAGE(PG8_SB(1, 0), cB + kstep, voffB); PG8_STAGE(PG8_SA(1, 0), cA + kstep, voffA); PG8_STAGE(PG8_SB(1, 1), cB + hstep + kstep, voffB);
        PG8_WAIT_V(6); PG8_BAR;
    }
    for (;;) {
        const bool has_next = S.next(ui + 1, nxt);
        const char* nA = has_next ? (const char*)g.A + (size_t)nxt.pm * tstep : cA; const char* nB = has_next ? (const char*)g.Bt + (size_t)nxt.pn * tstep : cB;
        for (int t = 0; t < nt; t += 2) {
            const bool last = (t == nt - 2);
            const char* a1 = cA + (size_t)(t + 1) * kstep;
            const char* a2 = last ? nA : cA + (size_t)(t + 2) * kstep; const char* b2 = last ? nB : cB + (size_t)(t + 2) * kstep;
            const char* a3 = a2 + kstep; const char* b3 = b2 + kstep;
            if (last && has_next) S.a_ready(nxt);
            if constexpr (SP2) {
            PG8_LDB(B0, 0, 0); PG8_LDB(B1, 0, 1); PG8_SCHED; PG8_LDA(At, 0, 0); PG8_STAGE(PG8_SA(1, 1), a1 + hstep, voffA);
            PG8_WAIT_V(8); PG8_WAIT_L(0); PG8_BAR; PG8_MMA(0, 0, At, B0); PG8_MMA(0, 1, At, B1); PG8_BAR; PG8_SCHED;
            PG8_LDA(At, 0, 1); PG8_STAGE(PG8_SB(0, 0), b2, voffB); PG8_STAGE(PG8_SB(0, 1), b2 + hstep, voffB); PG8_STAGE(PG8_SA(0, 0), a2, voffA);
            PG8_WAIT_V(8); PG8_WAIT_L(0); PG8_BAR; PG8_MMA(1, 0, At, B0); PG8_MMA(1, 1, At, B1); PG8_BAR; PG8_SCHED;
            PG8_LDB(B0, 1, 0); PG8_LDB(B1, 1, 1); PG8_SCHED; PG8_LDA(At, 1, 0); PG8_STAGE(PG8_SA(0, 1), a2 + hstep, voffA);
            PG8_WAIT_V(8); PG8_WAIT_L(0); PG8_BAR; PG8_MMA(0, 0, At, B0); PG8_MMA(0, 1, At, B1); PG8_BAR; PG8_SCHED;
            PG8_LDA(At, 1, 1); PG8_STAGE(PG8_SB(1, 0), b3, voffB); PG8_STAGE(PG8_SB(1, 1), b3 + hstep, voffB); PG8_STAGE(PG8_SA(1, 0), a3, voffA);
            PG8_WAIT_V(8); PG8_WAIT_L(0); PG8_BAR; PG8_MMA(1, 0, At, B0); PG8_MMA(1, 1, At, B1); PG8_BAR; PG8_SCHED;
            } else {
            PG8_LDB(B0, 0, 0); PG8_SCHED; PG8_LDA(At, 0, 0); PG8_STAGE(PG8_SA(1, 1), a1 + hstep, voffA);
            PG8_WAIT_L(8); PG8_BAR; PG8_WAIT_L(0); PG8_MMA(0, 0, At, B0); PG8_BAR; PG8_SCHED;
            PG8_LDB(B1, 0, 1); PG8_STAGE(PG8_SB(0, 0), b2, voffB);
            PG8_BAR; PG8_WAIT_L(0); PG8_MMA(0, 1, At, B1); PG8_BAR;
            PG8_LDA(At, 0, 1); PG8_STAGE(PG8_SA(0, 0), a2, voffA);
            PG8_BAR; PG8_WAIT_L(0); PG8_MMA(1, 0, At, B0); PG8_BAR; PG8_SCHED;
            PG8_STAGE(PG8_SB(0, 1), b2 + hstep, voffB);
            PG8_WAIT_V(6); PG8_BAR; PG8_MMA(1, 1, At, B1); PG8_BAR;
            PG8_LDB(B0, 1, 0); PG8_SCHED; PG8_LDA(At, 1, 0); PG8_STAGE(PG8_SA(0, 1), a2 + hstep, voffA);
            PG8_WAIT_L(8); PG8_BAR; PG8_WAIT_L(0); PG8_MMA(0, 0, At, B0); PG8_BAR; PG8_SCHED;
            PG8_LDB(B1, 1, 1); PG8_STAGE(PG8_SB(1, 0), b3, voffB);
            PG8_BAR; PG8_WAIT_L(0); PG8_MMA(0, 1, At, B1); PG8_BAR;
            PG8_LDA(At, 1, 1); PG8_STAGE(PG8_SA(1, 0), a3, voffA);
            PG8_BAR; PG8_WAIT_L(0); PG8_MMA(1, 0, At, B0); PG8_BAR; PG8_SCHED;
            PG8_STAGE(PG8_SB(1, 1), b3 + hstep, voffB);
            PG8_WAIT_V(6); PG8_BAR; PG8_MMA(1, 1, At, B1); PG8_BAR;
            }
        }
        if constexpr (ALIGN_EPI) { if (wr == 0) PG8_BAR; }
        if constexpr (!Epi::AFTER_DRAIN) { E(acc, cur, wr, wc, fr, fq); S.done(cur); }
        if (!has_next) break;
#pragma unroll
        for (int a = 0; a < 2; ++a)
#pragma unroll
            for (int b = 0; b < 2; ++b)
#pragma unroll
                for (int m = 0; m < 4; ++m)
#pragma unroll
                    for (int n = 0; n < 2; ++n) acc[a][b][m][n] = (f32x4){0.f, 0.f, 0.f, 0.f};
        cur = nxt; cA = nA; cB = nB; ++ui;
        if constexpr (ALIGN_EPI) { if (wr == 1) PG8_BAR; }
    }
    PG8_WAIT_V(0);
    if constexpr (!ALIGN_EPI) { if (wr == 0) PG8_BAR; }
    PG8_BAR;
    if constexpr (Epi::AFTER_DRAIN) { E.fused(acc, cur, wr, wc, fr, fq, lds, wid, lane); S.done(cur); }
#undef PG8_SA
#undef PG8_SB
#undef PG8_STAGE
#undef PG8_LDA
#undef PG8_LDB
#undef PG8_MMA
#undef PG8_WAIT_V
#undef PG8_WAIT_L
#undef PG8_BAR
#undef PG8_SCHED
}
}
using pg8::bf16_t; using pg8::bf16x8; using pg8::f32x4; using pg8::u32x4; using pg8::Unit; using pg8::Gemm; using pg8::StaticOrder;
typedef float f32x2 __attribute__((ext_vector_type(2)));
typedef unsigned u32x2 __attribute__((ext_vector_type(2)));
#define LAS __attribute__((address_space(3)))

#ifndef NAIVE_GEMM
#define NAIVE_GEMM 0
#endif
#ifndef NAIVE_ATTN
#define NAIVE_ATTN 0
#endif
#ifndef NAIVE_CONV
#define NAIVE_CONV 0
#endif

constexpr int M = 16384, D = 1024, FF = 2816, SEQ = 2048, HC = 512, PLE = 256;
constexpr float EPS = 1e-6f;
constexpr size_t MiB = 1u << 20;
constexpr size_t WS_CTL = 0, WS_W = 1 * MiB, WS_FT = 45 * MiB, WS_PB = 53 * MiB, WS_XB = 69 * MiB, WS_R1 = 101 * MiB, WS_R2 = 197 * MiB, WS_END = 261 * MiB;
constexpr size_t W_GUA = 0, W_DA = 11 * MiB, W_IN = W_DA + 5767168, W_OUT = W_IN + 6 * MiB, W_GUB = W_OUT + 2 * MiB, W_DB = W_GUB + 11 * MiB, W_PG = W_DB + 5767168, W_PP = W_PG + 2 * MiB;
static_assert(W_PP + 512 * 1024 <= 44 * MiB, "weights");
constexpr int LDS_BYTES = 131072 + 4096;

struct KP { const float* in[30]; float* out; unsigned char* ws; };
typedef const __attribute__((address_space(4))) KP* KPC;
#define KPARAMS() ({ KPC q_ = (KPC)__builtin_amdgcn_kernarg_segment_ptr(); asm volatile("" : "+s"(q_)); q_; })

__device__ __forceinline__ unsigned cvt_pk_bf16(float lo, float hi) { unsigned r; asm volatile("v_cvt_pk_bf16_f32 %0, %1, %2" : "=v"(r) : "v"(lo), "v"(hi)); return r; }
__device__ __forceinline__ float bf_lo(unsigned w) { return __uint_as_float(w << 16); }
__device__ __forceinline__ float bf_hi(unsigned w) { return __uint_as_float(w & 0xffff0000u); }
__device__ __forceinline__ float bf2f(bf16_t b) { return __uint_as_float(((unsigned)b) << 16); }
__device__ __forceinline__ float wave_sum(float v) {
#pragma unroll
    for (int o = 1; o < 64; o <<= 1) v += __shfl_xor(v, o);
    return v;
}
__device__ __forceinline__ int fresh_tid(int wv) {
    int l; asm volatile("v_mbcnt_lo_u32_b32 %0, -1, 0\n\tv_mbcnt_hi_u32_b32 %0, -1, %0" : "=v"(l));
    return wv * 64 + l;
}
__device__ __forceinline__ int fresh_bx() { int b = blockIdx.x; asm volatile("" : "+s"(b)); return b; }
__device__ __forceinline__ float rstd_of(float ss, float invn) { return rsqrtf(ss * invn + EPS); }

struct EpiSwiGLU {
    static constexpr bool PERM = true, AFTER_DRAIN = false;
    bf16_t* H; const float* ss;
    __device__ __forceinline__ void operator()(const f32x4 (&acc)[2][2][4][2], const Unit& u, int wr, int wc, int fr, int fq) const {
        const int row0 = u.pm * 256 + wr * 64 + fr, col0 = u.pn * 128 + wc * 32 + 8 * fq;
#pragma unroll
        for (int ai = 0; ai < 2; ++ai)
#pragma unroll
            for (int m = 0; m < 4; ++m) {
                const int row = row0 + ai * 128 + m * 16;
                const float rs = rstd_of(ss[row], 1.0f / D);
                unsigned w[4];
#pragma unroll
                for (int n = 0; n < 2; ++n) {
                    float hv[4];
#pragma unroll
                    for (int e = 0; e < 4; ++e) {
                        const float g = acc[ai][0][m][n][e] * rs, uu = acc[ai][1][m][n][e] * rs;
                        hv[e] = g * __builtin_amdgcn_rcpf(1.0f + __expf(-g)) * uu;
                    }
                    w[2 * n] = cvt_pk_bf16(hv[0], hv[1]); w[2 * n + 1] = cvt_pk_bf16(hv[2], hv[3]);
                }
                *(u32x4*)(H + (size_t)row * FF + col0) = (u32x4){w[0], w[1], w[2], w[3]};
            }
    }
};
struct EpiResid {
    static constexpr bool PERM = false, AFTER_DRAIN = false;
    const float* base; float* X; bf16_t* xb; float* ssn; float alpha;
    __device__ __forceinline__ void operator()(const f32x4 (&acc)[2][2][4][2], const Unit& u, int wr, int wc, int fr, int fq) const {
        const int row0 = u.pm * 256 + wr * 64 + fr, col0 = u.pn * 256 + wc * 32 + 4 * fq;
#pragma unroll
        for (int ai = 0; ai < 2; ++ai)
#pragma unroll
            for (int m = 0; m < 4; ++m) {
                const int row = row0 + ai * 128 + m * 16; float sq = 0.f;
#pragma unroll
                for (int bj = 0; bj < 2; ++bj)
#pragma unroll
                    for (int n = 0; n < 2; ++n) {
                        const size_t off = (size_t)row * D + col0 + bj * 128 + n * 16;
                        const f32x4 bs = *(const f32x4*)(base + off);
                        const f32x4 o = bs + acc[ai][bj][m][n] * alpha;
                        *(f32x4*)(X + off) = o;
                        *(u32x2*)(xb + off) = (u32x2){cvt_pk_bf16(o[0], o[1]), cvt_pk_bf16(o[2], o[3])};
                        sq += (o[0] * o[0] + o[1] * o[1]) + (o[2] * o[2] + o[3] * o[3]);
                    }
                sq += __shfl_xor(sq, 16); sq += __shfl_xor(sq, 32);
                if (fq == 0) unsafeAtomicAdd(ssn + row, sq);
                asm volatile("" ::: "memory");
            }
    }
};
struct EpiPle {
    static constexpr bool PERM = false, AFTER_DRAIN = false;
    float* X; const float* PP; const float* ss; bf16_t* xb; float* ssn;
    __device__ __forceinline__ void operator()(const f32x4 (&acc)[2][2][4][2], const Unit& u, int wr, int wc, int fr, int fq) const {
        const int row0 = u.pm * 256 + wr * 64 + fr, col0 = u.pn * 256 + wc * 32 + 4 * fq;
#pragma unroll
        for (int ai = 0; ai < 2; ++ai)
#pragma unroll
            for (int m = 0; m < 4; ++m) {
                const int row = row0 + ai * 128 + m * 16; float sq = 0.f;
                const float rs = rstd_of(ss[row], 1.0f / D);
#pragma unroll
                for (int bj = 0; bj < 2; ++bj)
#pragma unroll
                    for (int n = 0; n < 2; ++n) {
                        const size_t off = (size_t)row * D + col0 + bj * 128 + n * 16;
                        const f32x4 bs = *(const f32x4*)(X + off);
                        const f32x4 pp = *(const f32x4*)(PP + off);
                        f32x4 o;
#pragma unroll
                        for (int e = 0; e < 4; ++e) { const float a = acc[ai][bj][m][n][e] * rs; o[e] = bs[e] + __builtin_amdgcn_rcpf(1.0f + __expf(-a)) * pp[e]; }
                        *(f32x4*)(X + off) = o;
                        *(u32x2*)(xb + off) = (u32x2){cvt_pk_bf16(o[0], o[1]), cvt_pk_bf16(o[2], o[3])};
                        sq += (o[0] * o[0] + o[1] * o[1]) + (o[2] * o[2] + o[3] * o[3]);
                    }
                sq += __shfl_xor(sq, 16); sq += __shfl_xor(sq, 32);
                if (fq == 0) unsafeAtomicAdd(ssn + row, sq);
                asm volatile("" ::: "memory");
            }
    }
};
struct EpiScaleRow {
    static constexpr bool PERM = true, AFTER_DRAIN = false;
    bf16_t* O; int ldc; const float* ss;
    __device__ __forceinline__ void operator()(const f32x4 (&acc)[2][2][4][2], const Unit& u, int wr, int wc, int fr, int fq) const {
        const int row0 = u.pm * 256 + wr * 64 + fr, col0 = u.pn * 256 + wc * 32 + 8 * fq;
#pragma unroll
        for (int ai = 0; ai < 2; ++ai)
#pragma unroll
            for (int m = 0; m < 4; ++m) {
                const int row = row0 + ai * 128 + m * 16;
                const float rs = rstd_of(ss[row], 1.0f / D);
#pragma unroll
                for (int bj = 0; bj < 2; ++bj) {
                    const f32x4 v0 = acc[ai][bj][m][0] * rs, v1 = acc[ai][bj][m][1] * rs;
                    *(u32x4*)(O + (size_t)row * ldc + col0 + bj * 128) = (u32x4){cvt_pk_bf16(v0[0], v0[1]), cvt_pk_bf16(v0[2], v0[3]), cvt_pk_bf16(v1[0], v1[1]), cvt_pk_bf16(v1[2], v1[3])};
                }
            }
    }
};
struct EpiScaleCol {
    static constexpr bool PERM = true, AFTER_DRAIN = false;
    bf16_t* O; int ldc; const float* ss;
    __device__ __forceinline__ void operator()(const f32x4 (&acc)[2][2][4][2], const Unit& u, int wr, int wc, int fr, int fq) const {
        const int row0 = u.pm * 256 + wr * 64 + fr, col0 = u.pn * 256 + wc * 32 + 8 * fq;
#pragma unroll
        for (int bj = 0; bj < 2; ++bj) {
            float rs[8];
            {
                const f32x4 a = *(const f32x4*)(ss + col0 + bj * 128), b = *(const f32x4*)(ss + col0 + bj * 128 + 4);
#pragma unroll
                for (int e = 0; e < 4; ++e) { rs[e] = rstd_of(a[e], 1.0f / D); rs[4 + e] = rstd_of(b[e], 1.0f / D); }
            }
#pragma unroll
            for (int ai = 0; ai < 2; ++ai)
#pragma unroll
                for (int m = 0; m < 4; ++m) {
                    const int row = row0 + ai * 128 + m * 16;
                    const f32x4 v0 = acc[ai][bj][m][0], v1 = acc[ai][bj][m][1];
                    *(u32x4*)(O + (size_t)row * ldc + col0 + bj * 128) = (u32x4){cvt_pk_bf16(v0[0] * rs[0], v0[1] * rs[1]), cvt_pk_bf16(v0[2] * rs[2], v0[3] * rs[3]),
                                                                                  cvt_pk_bf16(v1[0] * rs[4], v1[1] * rs[5]), cvt_pk_bf16(v1[2] * rs[6], v1[3] * rs[7])};
                }
        }
    }
};
struct EpiStoreF32 {
    static constexpr bool PERM = false, AFTER_DRAIN = false;
    float* O; int ldc;
    __device__ __forceinline__ void operator()(const f32x4 (&acc)[2][2][4][2], const Unit& u, int wr, int wc, int fr, int fq) const {
        const int row0 = u.pm * 256 + wr * 64 + fr, col0 = u.pn * 256 + wc * 32 + 4 * fq;
#pragma unroll
        for (int ai = 0; ai < 2; ++ai)
#pragma unroll
            for (int m = 0; m < 4; ++m)
#pragma unroll
                for (int bj = 0; bj < 2; ++bj)
#pragma unroll
                    for (int n = 0; n < 2; ++n) *(f32x4*)(O + (size_t)(row0 + ai * 128 + m * 16) * ldc + col0 + bj * 128 + n * 16) = acc[ai][bj][m][n];
    }
};

template <class Epi>
__device__ __forceinline__ void gemm_naive(int wv, const Gemm g, const StaticOrder& S, const Epi& E) {
    const int tid = fresh_tid(wv), wid = tid >> 6, lane = tid & 63, wr = wid >> 2, wc = wid & 3, fr = lane & 15, fq = lane >> 4;
    Unit u;
    for (int ui = 0; S.next(ui, u); ++ui) {
        f32x4 acc[2][2][4][2];
#pragma unroll
        for (int a = 0; a < 2; ++a)
#pragma unroll
            for (int b = 0; b < 2; ++b)
#pragma unroll
                for (int m = 0; m < 4; ++m)
#pragma unroll
                    for (int n = 0; n < 2; ++n) acc[a][b][m][n] = (f32x4){0.f, 0.f, 0.f, 0.f};
        for (int k0 = 0; k0 < g.K; k0 += 32) {
            bf16x8 Bf[2][2];
#pragma unroll
            for (int bj = 0; bj < 2; ++bj)
#pragma unroll
                for (int n = 0; n < 2; ++n) {
                    const int slot = 16 * n + fr; const int rr = Epi::PERM ? pg8::perm32(slot) : slot;
                    Bf[bj][n] = *(const bf16x8*)(g.Bt + (size_t)(u.pn * 256 + bj * 128 + wc * 32 + rr) * g.K + k0 + 8 * fq);
                }
#pragma unroll
            for (int ai = 0; ai < 2; ++ai)
#pragma unroll
                for (int m = 0; m < 4; ++m) {
                    const bf16x8 Af = *(const bf16x8*)(g.A + (size_t)(u.pm * 256 + ai * 128 + wr * 64 + m * 16 + fr) * g.K + k0 + 8 * fq);
#pragma unroll
                    for (int bj = 0; bj < 2; ++bj)
#pragma unroll
                        for (int n = 0; n < 2; ++n) acc[ai][bj][m][n] = __builtin_amdgcn_mfma_f32_16x16x32_bf16(Bf[bj][n], Af, acc[ai][bj][m][n], 0, 0, 0);
                }
        }
        E(acc, u, wr, wc, fr, fq);
    }
}
template <class Epi>
__device__ __forceinline__ void gemm_run(int wv, LAS unsigned char* lds, const bf16_t* A, const bf16_t* Bt, int Mm, int Nn, int Kk, const Epi& E) {
    int bx_ = blockIdx.x; asm volatile("" : "+s"(bx_));
    Gemm g{A, Bt, Mm, Nn, Kk}; StaticOrder S; S.init(Mm, Nn, (int)gridDim.x, bx_);
#if NAIVE_GEMM
    gemm_naive<Epi>(wv, g, S, E);
    __syncthreads();
#else
    pg8::gemm_phase<Epi, StaticOrder, true, true>(lds, g, S, E, fresh_tid(wv));
#endif
}

__device__ __forceinline__ void transpose_item(const float* W, int K, int N, const float* gain, bf16_t* WT, int mode, int row_off, LAS float* scr, int item, int lane) {
    const int nblk = N / 32, kb = item / nblk, nb = item % nblk, k0 = 64 * kb, n0 = 32 * nb;
#pragma unroll 8
    for (int i = 0; i < 32; ++i) { const int kk = 2 * i + (lane >> 5); float v = W[(size_t)(k0 + kk) * N + n0 + (lane & 31)]; if (gain) v *= gain[k0 + kk]; scr[kk * 33 + (lane & 31)] = v; }
    asm volatile("s_waitcnt lgkmcnt(0)" ::: "memory");
    const int c = lane & 7;
#pragma unroll
    for (int j = 0; j < 4; ++j) {
        const int n = (lane >> 3) + 8 * j, ncol = n0 + n; const LAS float* s = scr + (8 * c) * 33 + n;
        const int row = (mode == 1) ? (256 * (ncol >> 7) + (ncol & 127) + row_off) : (row_off + ncol);
        const float sc = (mode == 2 && ncol < 512) ? 0.125f : 1.0f;
        u32x4 o; o.x = cvt_pk_bf16(s[0 * 33] * sc, s[1 * 33] * sc); o.y = cvt_pk_bf16(s[2 * 33] * sc, s[3 * 33] * sc); o.z = cvt_pk_bf16(s[4 * 33] * sc, s[5 * 33] * sc); o.w = cvt_pk_bf16(s[6 * 33] * sc, s[7 * 33] * sc);
        *(u32x4*)(WT + (size_t)row * K + k0 + 8 * c) = o;
    }
    asm volatile("s_waitcnt lgkmcnt(0)" ::: "memory");
}

constexpr float MIN_DECAY = -3.0701134573253946f, MAX_DECAY = -15.350567286626973f;
__device__ __forceinline__ void filter_item(KPC p, int layer, int item, int lane, float* FT) {
    const float* wf1 = p->in[11] + layer * 33 * 64; const float* bf1 = p->in[12] + layer * 64;
    const float* wf2 = p->in[13] + layer * 4096;    const float* bf2 = p->in[14] + layer * 64;
    const float* wf3 = p->in[15] + layer * 4096;    const float* bf3 = p->in[16] + layer * 64;
    const float* wf4 = p->in[17] + layer * 64 * 1024; const float fq = p->in[18][layer * 64 + lane];
    const int i0 = item * 4;
    float h[4];
#pragma unroll
    for (int q = 0; q < 4; ++q) {
        const int i = i0 + q;
        const float t = (float)i * (1.0f / 2047.0f), w = 6.283185307179586f * (float)i / 2048.0f;
        const int j = (lane - 1) & 15; const float f = 1e-4f + (float)j * ((15.0f - 1e-4f) / 15.0f);
        const float a = f * w;
        float zf = 0.f;
        if (lane == 0) zf = t; else if (lane <= 16) zf = __cosf(a); else if (lane <= 32) zf = -__sinf(a);
        float s = bf1[lane];
        for (int k = 0; k < 33; ++k) s += __shfl(zf, k) * wf1[k * 64 + lane];
        h[q] = __sinf(fq * s);
    }
#pragma unroll
    for (int q = 0; q < 4; ++q) {
        float s = bf2[lane];
        for (int k = 0; k < 64; ++k) s += __shfl(h[q], k) * wf2[k * 64 + lane];
        const float h2 = __sinf(fq * s);
        float s3 = bf3[lane];
        for (int k = 0; k < 64; ++k) s3 += __shfl(h2, k) * wf3[k * 64 + lane];
        h[q] = __sinf(fq * s3);
    }
    float acc[4][16];
#pragma unroll
    for (int q = 0; q < 4; ++q)
#pragma unroll
        for (int jj = 0; jj < 16; ++jj) acc[q][jj] = 0.f;
    for (int k = 0; k < 64; ++k) {
        const float h0 = __shfl(h[0], k), h1 = __shfl(h[1], k), h2 = __shfl(h[2], k), h3 = __shfl(h[3], k);
#pragma unroll
        for (int jj = 0; jj < 16; ++jj) { const float w = wf4[k * 1024 + lane + 64 * jj]; acc[0][jj] += h0 * w; acc[1][jj] += h1 * w; acc[2][jj] += h2 * w; acc[3][jj] += h3 * w; }
    }
#pragma unroll
    for (int jj = 0; jj < 16; ++jj) {
        const int cf = lane + 64 * jj, dir = cf >> 9, c = cf & 511;
        const float delta = fabsf(MIN_DECAY + (float)c * ((MAX_DECAY - MIN_DECAY) / 511.0f));
        f32x4 o;
#pragma unroll
        for (int q = 0; q < 4; ++q) { const float t = (float)(i0 + q) * (1.0f / 2047.0f); o[q] = acc[q][jj] * __expf(-t * delta); }
        *(f32x4*)(FT + ((size_t)(dir * 512 + c)) * SEQ + i0) = o;
    }
}

__device__ __forceinline__ void layer_prologue(int wv, KPC p, int layer, LAS unsigned char* lds) {
    const int tid = fresh_tid(wv), bx = fresh_bx(), lane = tid & 63, wave = tid >> 6;
    LAS float* scr = (LAS float*)(lds + wave * 16384);
    const int gw = bx * 8 + wave, NGW = gridDim.x * 8;
    unsigned char* Wb = p->ws + WS_W;
    const size_t lf = (size_t)layer;
    constexpr int I_G = 16 * 88, I_D = 44 * 32, I_IN = 16 * 96, I_O = 16 * 32, I_PP = 4 * 32;
    constexpr int NITEMS = 6 * I_G + I_IN + 2 * I_O + I_PP;
    static_assert(I_G == I_D, "items");
    for (int it = gw; it < NITEMS + 512; it += NGW) {
        int r = it;
        if (r >= NITEMS) { filter_item(p, layer, r - NITEMS, lane, (float*)(p->ws + WS_FT)); continue; }
        int wi, gi = -1, K = D, N = FF, mode = 1, row_off = 0; size_t wo = W_GUA, wstride = (size_t)D * FF;
        if (r < I_G) { wi = 3; gi = 2; }
        else if ((r -= I_G) < I_G) { wi = 4; gi = 2; row_off = 128; }
        else if ((r -= I_G) < I_D) { wi = 5; K = FF; N = D; mode = 0; wo = W_DA; }
        else if ((r -= I_D) < I_IN) { wi = 7; gi = 6; N = 3072; mode = 2; wo = W_IN; wstride = (size_t)D * 3072; }
        else if ((r -= I_IN) < I_O) { wi = 21; gi = 20; N = D; mode = 0; wo = W_OUT; wstride = (size_t)D * D; }
        else if ((r -= I_O) < I_G) { wi = 23; gi = 22; wo = W_GUB; }
        else if ((r -= I_G) < I_G) { wi = 24; gi = 22; row_off = 128; wo = W_GUB; }
        else if ((r -= I_G) < I_D) { wi = 25; K = FF; N = D; mode = 0; wo = W_DB; }
        else if ((r -= I_D) < I_O) { wi = 27; gi = 26; N = D; mode = 0; wo = W_PG; wstride = (size_t)D * D; }
        else { r -= I_O; wi = 28; K = PLE; N = D; mode = 0; wo = W_PP; wstride = (size_t)PLE * D; }
        const float* gain = gi >= 0 ? p->in[gi] + lf * D : nullptr;
        transpose_item(p->in[wi] + lf * wstride, K, N, gain, (bf16_t*)(Wb + wo), mode, row_off, scr, r, lane);
    }
    if (layer == 0) {
        bf16_t* xb = (bf16_t*)(p->ws + WS_XB); float* ss0 = (float*)(p->ws + WS_CTL);
        for (int m = gw; m < M; m += NGW) {
            const f32x4* xr = (const f32x4*)(p->in[0] + (size_t)m * D) + lane;
            f32x4 v[4]; float s = 0.f;
#pragma unroll
            for (int j = 0; j < 4; ++j) { v[j] = xr[64 * j]; s += (v[j][0] * v[j][0] + v[j][1] * v[j][1]) + (v[j][2] * v[j][2] + v[j][3] * v[j][3]); }
            s = wave_sum(s);
            if (lane == 0) ss0[m] = s;
            u32x2* o8 = (u32x2*)(xb + (size_t)m * D) + lane;
#pragma unroll
            for (int j = 0; j < 4; ++j) o8[64 * j] = (u32x2){cvt_pk_bf16(v[j][0], v[j][1]), cvt_pk_bf16(v[j][2], v[j][3])};
        }
        bf16_t* pb = (bf16_t*)(p->ws + WS_PB);
        const size_t n8 = (size_t)2 * M * PLE / 8;
        for (size_t i = (size_t)bx * 512 + tid; i < n8; i += (size_t)gridDim.x * 512) {
            const f32x4 a = *(const f32x4*)(p->in[1] + i * 8), b = *(const f32x4*)(p->in[1] + i * 8 + 4);
            *(u32x4*)(pb + i * 8) = (u32x4){cvt_pk_bf16(a[0], a[1]), cvt_pk_bf16(a[2], a[3]), cvt_pk_bf16(b[0], b[1]), cvt_pk_bf16(b[2], b[3])};
        }
    }
}

__device__ __forceinline__ void attn_naive(int wv, KPC p, int layer, const bf16_t* QK, const bf16_t* UT, bf16_t* yna) {
    const float* rpb = p->in[8] + layer * 8 * 15 * 31;
    const int tid = fresh_tid(wv), bx = fresh_bx();
    for (int it = bx * 512 + tid; it < M * 8; it += gridDim.x * 512) {
        const int h = it / M, tok = it % M;
        const int b = tok >> 11, l = tok & 2047, r = l >> 6, qc = l & 63;
        const int rs = min(max(r - 4, 0), 24), qcs = min(max(qc - 8, 0), 48);
        float o[64]; u32x4 qp[8];
#pragma unroll
        for (int j = 0; j < 8; ++j) qp[j] = *(const u32x4*)(QK + (size_t)tok * 1024 + 64 * h + 8 * j);
#pragma unroll
        for (int d = 0; d < 64; ++d) o[d] = 0.f;
        float mx = -3.0e38f, ls = 0.f;
        for (int kr = 0; kr < 8; ++kr)
            for (int kx = 0; kx < 16; ++kx) {
                const int krow = rs + kr, kc = qcs + kx; const size_t ktok = (size_t)b * 2048 + krow * 64 + kc;
                float s = 0.f;
#pragma unroll
                for (int j = 0; j < 8; ++j) {
                    const u32x4 v = *(const u32x4*)(QK + ktok * 1024 + 512 + 64 * h + 8 * j);
                    const u32x4 qq = qp[j];
                    s += bf_lo(qq.x) * bf_lo(v.x) + bf_hi(qq.x) * bf_hi(v.x) + bf_lo(qq.y) * bf_lo(v.y) + bf_hi(qq.y) * bf_hi(v.y)
                       + bf_lo(qq.z) * bf_lo(v.z) + bf_hi(qq.z) * bf_hi(v.z) + bf_lo(qq.w) * bf_lo(v.w) + bf_hi(qq.w) * bf_hi(v.w);
                }
                s += rpb[(h * 15 + (krow - r + 7)) * 31 + (kc - qc + 15)];
                const float mn = fmaxf(mx, s), corr = __expf(mx - mn), pe = __expf(s - mn);
                ls = ls * corr + pe; mx = mn;
#pragma unroll
                for (int d = 0; d < 64; ++d) o[d] = o[d] * corr + pe * bf2f(UT[(size_t)(64 * h + d) * M + ktok]);
            }
        const float inv = 1.0f / ls;
#pragma unroll
        for (int j = 0; j < 8; ++j)
            *(u32x4*)(yna + (size_t)tok * 512 + 64 * h + 8 * j) = (u32x4){cvt_pk_bf16(o[8 * j] * inv, o[8 * j + 1] * inv), cvt_pk_bf16(o[8 * j + 2] * inv, o[8 * j + 3] * inv),
                                                                         cvt_pk_bf16(o[8 * j + 4] * inv, o[8 * j + 5] * inv), cvt_pk_bf16(o[8 * j + 6] * inv, o[8 * j + 7] * inv)};
    }
}

__device__ __forceinline__ float sconv(const bf16_t* row, int t, float w0, float w1, float w2, float bb) {
    const float a = t > 0 ? bf2f(row[t - 1]) : 0.f, b = bf2f(row[t]), c = t < SEQ - 1 ? bf2f(row[t + 1]) : 0.f;
    return a * w0 + b * w1 + c * w2 + bb;
}
__device__ __forceinline__ void conv_naive(int wv, KPC p, int layer, LAS unsigned char* lds, const bf16_t* UT, const float* FT, bf16_t* yhyT) {
    LAS float* karr = (LAS float*)lds; LAS float* zf = karr + 4096; LAS float* x0f = zf + 2048; LAS float* red = x0f + 2048;
    const float* wsc = p->in[9] + layer * 3 * 1536; const float* bsc = p->in[10] + layer * 1536; const float* hyb = p->in[19] + layer * 512;
    const int tid = fresh_tid(wv), bx = fresh_bx(), lane = tid & 63, wave = tid >> 6;
    for (int it = bx; it < 512 * 8; it += gridDim.x) {
        const int c = it >> 3, b = it & 7;
        __syncthreads();
        float asum = 0.f;
        for (int d = tid; d < 4096; d += 512) {
            const int dd = d - 2048; float v;
            if (dd == -2048) v = 0.f; else if (dd == 0) v = FT[(size_t)c * SEQ] + FT[(size_t)(512 + c) * SEQ]; else if (dd > 0) v = FT[(size_t)c * SEQ + dd]; else v = FT[(size_t)(512 + c) * SEQ - dd];
            karr[d] = v; asum += fabsf(v);
        }
        {
            const bf16_t* r0 = UT + (size_t)(512 + c) * M + b * 2048; const bf16_t* r1 = UT + (size_t)(1024 + c) * M + b * 2048; const bf16_t* r2 = UT + (size_t)(1536 + c) * M + b * 2048;
            const float a0 = wsc[c], a1 = wsc[1536 + c], a2 = wsc[3072 + c], ab = bsc[c];
            const float b0 = wsc[512 + c], b1 = wsc[1536 + 512 + c], b2 = wsc[3072 + 512 + c], bb = bsc[512 + c];
            const float c0 = wsc[1024 + c], c1 = wsc[1536 + 1024 + c], c2 = wsc[3072 + 1024 + c], cb = bsc[1024 + c];
            for (int t = tid; t < 2048; t += 512) {
                x0f[t] = sconv(r0, t, a0, a1, a2, ab);
                zf[t] = sconv(r1, t, b0, b1, b2, bb) * sconv(r2, t, c0, c1, c2, cb);
            }
        }
        asum = wave_sum(asum);
        if (lane == 0) red[wave] = asum;
        __syncthreads();
        float kn = 0.f;
#pragma unroll
        for (int w = 0; w < 8; ++w) kn += red[w];
        const float ikn = 1.0f / kn, hb = hyb[c];
#pragma unroll
        for (int e = 0; e < 4; ++e) {
            const int t = tid + 512 * e; float acc = 0.f;
            for (int s = 0; s < 2048; ++s) acc += karr[t - s + 2048] * zf[s];
            const float y = x0f[t] * (acc * ikn + zf[t] * hb);
            yhyT[(size_t)c * M + b * 2048 + t] = (bf16_t)(cvt_pk_bf16(y, 0.f) & 0xffffu);
        }
    }
}


__device__ __forceinline__ void attn_mfma(int wv, KPC p, int layer, const bf16_t* QK, const bf16_t* UT, bf16_t* yna) {
    const float* rpb = p->in[8] + layer * 8 * 15 * 31;
    const int tid = fresh_tid(wv), bx = fresh_bx(), lane = tid & 63, qi = lane & 15, g = lane >> 4;
    for (int it = bx * 8 + wv; it < 8192; it += gridDim.x * 8) {
        const int h = it & 7, j = (it >> 3) & 3, r = (it >> 5) & 31, b = it >> 10;
        const int rs = min(max(r - 4, 0), 24), bc0 = min(max(16 * j - 8, 0), 32);
        const int qc = 16 * j + qi, qcs = min(max(qc - 8, 0), 48);
        const size_t qtok = (size_t)b * 2048 + r * 64 + qc;
        const bf16x8 qf0 = *(const bf16x8*)(QK + qtok * 1024 + 64 * h + 8 * g), qf1 = *(const bf16x8*)(QK + qtok * 1024 + 64 * h + 32 + 8 * g);
        f32x4 s[16];
#pragma unroll
        for (int T = 0; T < 16; ++T) {
            const size_t ktok = (size_t)b * 2048 + (rs + (T >> 1)) * 64 + bc0 + 16 * (T & 1) + qi;
            const bf16x8 k0 = *(const bf16x8*)(QK + ktok * 1024 + 512 + 64 * h + 8 * g), k1 = *(const bf16x8*)(QK + ktok * 1024 + 512 + 64 * h + 32 + 8 * g);
            f32x4 z = (f32x4){0.f, 0.f, 0.f, 0.f};
            z = __builtin_amdgcn_mfma_f32_16x16x32_bf16(k0, qf0, z, 0, 0, 0);
            z = __builtin_amdgcn_mfma_f32_16x16x32_bf16(k1, qf1, z, 0, 0, 0);
            s[T] = z;
        }
        float mx = -3.0e38f;
#pragma unroll
        for (int T = 0; T < 16; ++T)
#pragma unroll
            for (int e = 0; e < 4; ++e) {
                const int kc = bc0 + 16 * (T & 1) + 4 * g + e, kr = rs + (T >> 1);
                const bool valid = (kc >= qcs) && (kc < qcs + 16);
                float v = -3.0e38f;
                if (valid) v = s[T][e] + rpb[(h * 15 + kr - r + 7) * 31 + kc - qc + 15];
                s[T][e] = v; mx = fmaxf(mx, v);
            }
        mx = fmaxf(mx, __shfl_xor(mx, 16)); mx = fmaxf(mx, __shfl_xor(mx, 32));
        float ls = 0.f;
#pragma unroll
        for (int T = 0; T < 16; ++T)
#pragma unroll
            for (int e = 0; e < 4; ++e) { const float pe = __expf(s[T][e] - mx); s[T][e] = pe; ls += pe; }
        ls += __shfl_xor(ls, 16); ls += __shfl_xor(ls, 32);
        f32x4 o[4];
#pragma unroll
        for (int dt = 0; dt < 4; ++dt) o[dt] = (f32x4){0.f, 0.f, 0.f, 0.f};
#pragma unroll
        for (int kr = 0; kr < 8; ++kr) {
            const u32x4 pw = (u32x4){cvt_pk_bf16(s[2 * kr][0], s[2 * kr][1]), cvt_pk_bf16(s[2 * kr][2], s[2 * kr][3]), cvt_pk_bf16(s[2 * kr + 1][0], s[2 * kr + 1][1]), cvt_pk_bf16(s[2 * kr + 1][2], s[2 * kr + 1][3])};
            const bf16x8 pf = __builtin_bit_cast(bf16x8, pw);
#pragma unroll
            for (int dt = 0; dt < 4; ++dt) {
                const bf16_t* vp = UT + (size_t)(64 * h + 16 * dt + qi) * M + (size_t)b * 2048 + (rs + kr) * 64 + bc0 + 4 * g;
                const u32x2 v0 = *(const u32x2*)vp, v1 = *(const u32x2*)(vp + 16);
                const bf16x8 vf = __builtin_bit_cast(bf16x8, ((u32x4){v0.x, v0.y, v1.x, v1.y}));
                o[dt] = __builtin_amdgcn_mfma_f32_16x16x32_bf16(vf, pf, o[dt], 0, 0, 0);
            }
        }
        const float inv = 1.0f / ls;
#pragma unroll
        for (int dt = 0; dt < 4; ++dt)
            *(u32x2*)(yna + qtok * 512 + 64 * h + 16 * dt + 4 * g) = (u32x2){cvt_pk_bf16(o[dt][0] * inv, o[dt][1] * inv), cvt_pk_bf16(o[dt][2] * inv, o[dt][3] * inv)};
    }
}

__device__ __forceinline__ void conv_mfma(int wv, KPC p, int layer, LAS unsigned char* lds, const bf16_t* UT, const float* FT, bf16_t* yhyT) {
    constexpr int CPS = 8224, ZRS = 4112;
    LAS unsigned char* FC = lds; LAS unsigned char* ZT = lds + 8 * CPS; LAS float* red = (LAS float*)(ZT + 16 * ZRS);
    const float* wsc = p->in[9] + layer * 3 * 1536; const float* bsc = p->in[10] + layer * 1536; const float* hyb = p->in[19] + layer * 512;
    const int tid = fresh_tid(wv), bx = fresh_bx(), lane = tid & 63, i = lane & 15, g = lane >> 4;
    const int rho = (8 - (i & 7)) & 7;
    const int abase = rho * CPS + 2 * (2048 - i + 8 * g - rho) - 512 * wv;
    const int bbase = i * ZRS + 16 * g;
    for (int c = bx; c < 512; c += gridDim.x) {
        __syncthreads();
        float asum = 0.f;
#pragma unroll
        for (int k = 0; k < 8; ++k) {
            const int m = tid + 512 * k; float v;
            if (m == 0) v = 0.f; else if (m < 2048) v = FT[(size_t)c * SEQ + 2048 - m]; else if (m == 2048) v = FT[(size_t)c * SEQ] + FT[(size_t)(512 + c) * SEQ]; else v = FT[(size_t)(512 + c) * SEQ + m - 2048];
            asum += fabsf(v);
            const bf16_t vb = (bf16_t)(cvt_pk_bf16(v, 0.f) & 0xffffu);
#pragma unroll
            for (int r8 = 0; r8 < 8; ++r8) if (m - r8 >= 0) *(LAS bf16_t*)(FC + r8 * CPS + 2 * (m - r8)) = vb;
        }
        {
            const float a0 = wsc[c], a1 = wsc[1536 + c], a2 = wsc[3072 + c], ab = bsc[c];
            const float b0 = wsc[512 + c], b1 = wsc[1536 + 512 + c], b2 = wsc[3072 + 512 + c], bb = bsc[512 + c];
            const float c0 = wsc[1024 + c], c1 = wsc[1536 + 1024 + c], c2 = wsc[3072 + 1024 + c], cb = bsc[1024 + c];
#pragma unroll
            for (int k = 0; k < 4; ++k) {
                const int idx = tid + 512 * k, b = idx >> 8, t0 = (idx & 255) * 8;
                float x0v[8], zv[8];
#pragma unroll
                for (int rr = 0; rr < 3; ++rr) {
                    const bf16_t* row = UT + (size_t)(512 + 512 * rr + c) * M + (size_t)b * 2048;
                    const u32x4 w = *(const u32x4*)(row + t0);
                    float f[10];
                    f[0] = t0 > 0 ? bf2f(row[t0 - 1]) : 0.f; f[9] = t0 + 8 < SEQ ? bf2f(row[t0 + 8]) : 0.f;
                    f[1] = bf_lo(w.x); f[2] = bf_hi(w.x); f[3] = bf_lo(w.y); f[4] = bf_hi(w.y); f[5] = bf_lo(w.z); f[6] = bf_hi(w.z); f[7] = bf_lo(w.w); f[8] = bf_hi(w.w);
                    const float w0 = rr == 0 ? a0 : (rr == 1 ? b0 : c0), w1 = rr == 0 ? a1 : (rr == 1 ? b1 : c1), w2 = rr == 0 ? a2 : (rr == 1 ? b2 : c2), wb = rr == 0 ? ab : (rr == 1 ? bb : cb);
#pragma unroll
                    for (int e = 0; e < 8; ++e) {
                        const float v = f[e] * w0 + f[e + 1] * w1 + f[e + 2] * w2 + wb;
                        if (rr == 0) x0v[e] = v; else if (rr == 1) zv[e] = v; else zv[e] *= v;
                    }
                }
                *(LAS u32x4*)(ZT + b * ZRS + 2 * t0) = (u32x4){cvt_pk_bf16(zv[0], zv[1]), cvt_pk_bf16(zv[2], zv[3]), cvt_pk_bf16(zv[4], zv[5]), cvt_pk_bf16(zv[6], zv[7])};
                *(LAS u32x4*)(ZT + (8 + b) * ZRS + 2 * t0) = (u32x4){cvt_pk_bf16(x0v[0], x0v[1]), cvt_pk_bf16(x0v[2], x0v[3]), cvt_pk_bf16(x0v[4], x0v[5]), cvt_pk_bf16(x0v[6], x0v[7])};
            }
        }
        asum = wave_sum(asum);
        if (lane == 0) red[wv] = asum;
        __syncthreads();
        float kn = 0.f;
#pragma unroll
        for (int w = 0; w < 8; ++w) kn += red[w];
        bf16x8 ring[16]; f32x4 acc[16];
#pragma unroll
        for (int tau = 0; tau < 16; ++tau) { ring[tau] = *(const LAS bf16x8*)(FC + abase - 32 * tau); acc[tau] = (f32x4){0.f, 0.f, 0.f, 0.f}; }
        bf16x8 bcur = *(const LAS bf16x8*)(ZT + bbase);
        for (int s8 = 0; s8 < 8; ++s8) {
#pragma unroll
            for (int sp = 0; sp < 8; ++sp) {
                const int sn = min(8 * s8 + sp + 1, 63);
                const bf16x8 bnext = *(const LAS bf16x8*)(ZT + bbase + 64 * sn);
                const bf16x8 n0 = *(const LAS bf16x8*)(FC + abase + 64 * sn), n1 = *(const LAS bf16x8*)(FC + abase + 64 * sn - 32);
#pragma unroll
                for (int tau = 0; tau < 16; ++tau) acc[tau] = __builtin_amdgcn_mfma_f32_16x16x32_bf16(ring[(tau - 2 * sp) & 15], bcur, acc[tau], 0, 0, 0);
                ring[(0 - 2 * (sp + 1)) & 15] = n0; ring[(1 - 2 * (sp + 1)) & 15] = n1;
                bcur = bnext;
            }
        }
        if (i < 8) {
            const float ikn = 1.0f / kn, hb = hyb[c];
#pragma unroll
            for (int tau = 0; tau < 16; ++tau) {
                const int t = 256 * wv + 16 * tau + 4 * g;
                const u32x2 zz = *(const LAS u32x2*)(ZT + i * ZRS + 2 * t), xx = *(const LAS u32x2*)(ZT + (8 + i) * ZRS + 2 * t);
                const float y0 = bf_lo(xx.x) * (acc[tau][0] * ikn + bf_lo(zz.x) * hb), y1 = bf_hi(xx.x) * (acc[tau][1] * ikn + bf_hi(zz.x) * hb);
                const float y2 = bf_lo(xx.y) * (acc[tau][2] * ikn + bf_lo(zz.y) * hb), y3 = bf_hi(xx.y) * (acc[tau][3] * ikn + bf_hi(zz.y) * hb);
                *(u32x2*)(yhyT + (size_t)c * M + (size_t)i * 2048 + t) = (u32x2){cvt_pk_bf16(y0, y1), cvt_pk_bf16(y2, y3)};
            }
        }
    }
}

__device__ __forceinline__ void post_pass(int wv, LAS unsigned char* lds, const bf16_t* yna, const bf16_t* yhyT, bf16_t* yn) {
    LAS bf16_t* tile = (LAS bf16_t*)lds;
    const int tid = fresh_tid(wv), bx = fresh_bx(), lane = tid & 63, wave = tid >> 6;
    for (int it = bx; it < M / 32; it += gridDim.x) {
        const int tok0 = it * 32;
        __syncthreads();
        {
            const u32x4* src = (const u32x4*)(yhyT + (size_t)tid * M + tok0);
#pragma unroll
            for (int j = 0; j < 4; ++j) {
                const u32x4 v = src[j];
                tile[(8 * j + 0) * 520 + tid] = (bf16_t)(v.x & 0xffffu); tile[(8 * j + 1) * 520 + tid] = (bf16_t)(v.x >> 16);
                tile[(8 * j + 2) * 520 + tid] = (bf16_t)(v.y & 0xffffu); tile[(8 * j + 3) * 520 + tid] = (bf16_t)(v.y >> 16);
                tile[(8 * j + 4) * 520 + tid] = (bf16_t)(v.z & 0xffffu); tile[(8 * j + 5) * 520 + tid] = (bf16_t)(v.z >> 16);
                tile[(8 * j + 6) * 520 + tid] = (bf16_t)(v.w & 0xffffu); tile[(8 * j + 7) * 520 + tid] = (bf16_t)(v.w >> 16);
            }
        }
        __syncthreads();
#pragma unroll
        for (int q = 0; q < 4; ++q) {
            const int tk = 4 * wave + q; const size_t tok = (size_t)tok0 + tk;
#pragma unroll
            for (int half = 0; half < 2; ++half) {
                u32x4 v;
                if (half == 0) v = *(const u32x4*)(yna + tok * 512 + 8 * lane); else v = *(const LAS u32x4*)(tile + tk * 520 + 8 * lane);
                float f[8] = {bf_lo(v.x), bf_hi(v.x), bf_lo(v.y), bf_hi(v.y), bf_lo(v.z), bf_hi(v.z), bf_lo(v.w), bf_hi(v.w)};
                float s = 0.f;
#pragma unroll
                for (int e = 0; e < 8; ++e) s += f[e] * f[e];
                s = wave_sum(s);
                const float rs = rstd_of(s, 1.0f / 512.0f);
                *(u32x4*)(yn + tok * 1024 + half * 512 + 8 * lane) = (u32x4){cvt_pk_bf16(f[0] * rs, f[1] * rs), cvt_pk_bf16(f[2] * rs, f[3] * rs), cvt_pk_bf16(f[4] * rs, f[5] * rs), cvt_pk_bf16(f[6] * rs, f[7] * rs)};
            }
        }
    }
}

__global__ void __launch_bounds__(512, 2) hybrid_fwd(KP kparams_unused) {
    extern __shared__ __attribute__((aligned(16))) unsigned char lds_raw[];
    LAS unsigned char* lds = (LAS unsigned char*)lds_raw;
    cg::grid_group grid = cg::this_grid();
    const int wv = __builtin_amdgcn_readfirstlane((int)(threadIdx.x >> 6));
#define WSV() KPC p = KPARAMS(); unsigned char* ws = p->ws; float* ss = (float*)(ws + WS_CTL) + (size_t)(4 * layer) * M;   \
    bf16_t* xb = (bf16_t*)(ws + WS_XB); bf16_t* Hb = (bf16_t*)(ws + WS_R1); bf16_t* QK = (bf16_t*)(ws + WS_R1); bf16_t* UT = (bf16_t*)(ws + WS_R1 + 32 * MiB); \
    bf16_t* yna = (bf16_t*)(ws + WS_R2); bf16_t* yhyT = (bf16_t*)(ws + WS_R2 + 16 * MiB); bf16_t* yn = (bf16_t*)(ws + WS_R2 + 32 * MiB); float* PP = (float*)(ws + WS_R2); \
    bf16_t* pb = (bf16_t*)(ws + WS_PB); const float* FT = (const float*)(ws + WS_FT); unsigned char* Wb = ws + WS_W; float* X = p->out; \
    (void)ss; (void)xb; (void)Hb; (void)QK; (void)UT; (void)yna; (void)yhyT; (void)yn; (void)PP; (void)pb; (void)FT; (void)Wb; (void)X;

    for (int layer = 0; layer < 2; ++layer) {
#ifndef NO_PRO
        { WSV(); layer_prologue(wv, p, layer, lds); }
#endif
        grid.sync();
        { WSV(); gemm_run(wv, lds, xb, (const bf16_t*)(Wb + W_GUA), M, 2 * FF, D, EpiSwiGLU{Hb, ss}); }
        grid.sync();
        { WSV(); gemm_run(wv, lds, Hb, (const bf16_t*)(Wb + W_DA), M, D, FF, EpiResid{layer == 0 ? p->in[0] : X, X, xb, ss + M, 0.5f}); }
        grid.sync();
        { WSV(); gemm_run(wv, lds, (const bf16_t*)(Wb + W_IN) + (size_t)1024 * D, xb, 2048, M, D, EpiScaleCol{UT, M, ss + M}); }
        { WSV(); gemm_run(wv, lds, xb, (const bf16_t*)(Wb + W_IN), M, 1024, D, EpiScaleRow{QK, 1024, ss + M}); }
        grid.sync();
#ifndef NO_ATTN
#if NAIVE_ATTN
        { WSV(); attn_naive(wv, p, layer, QK, UT, yna); }
#else
        { WSV(); attn_mfma(wv, p, layer, QK, UT, yna); }
#endif
#endif
#ifndef NO_CONV
#if NAIVE_CONV
        { WSV(); conv_naive(wv, p, layer, lds, UT, FT, yhyT); }
#else
        { WSV(); conv_mfma(wv, p, layer, lds, UT, FT, yhyT); }
#endif
#endif
        grid.sync();
#ifndef NO_POST
        { WSV(); post_pass(wv, lds, yna, yhyT, yn); }
#endif
        grid.sync();
        { WSV(); gemm_run(wv, lds, yn, (const bf16_t*)(Wb + W_OUT), M, D, D, EpiResid{X, X, xb, ss + 2 * M, 1.0f}); }
        grid.sync();
        { WSV(); gemm_run(wv, lds, pb + (size_t)layer * M * PLE, (const bf16_t*)(Wb + W_PP), M, D, PLE, EpiStoreF32{PP, D}); }
        { WSV(); gemm_run(wv, lds, xb, (const bf16_t*)(Wb + W_GUB), M, 2 * FF, D, EpiSwiGLU{Hb, ss + 2 * M}); }
        grid.sync();
        { WSV(); gemm_run(wv, lds, Hb, (const bf16_t*)(Wb + W_DB), M, D, FF, EpiResid{X, X, xb, ss + 3 * M, 0.5f}); }
        grid.sync();
        { WSV(); gemm_run(wv, lds, xb, (const bf16_t*)(Wb + W_PG), M, D, D, EpiPle{X, PP, ss + 3 * M, xb, ss + 4 * M}); }
        grid.sync();
    }
    {
        const int layer = 2; WSV();
        const int tid = fresh_tid(wv), bx = fresh_bx(), lane = tid & 63, wave = tid >> 6;
        const float* gf = p->in[29];
        for (int m = bx * 8 + wave; m < M; m += gridDim.x * 8) {
            const float rs = rstd_of(ss[m], 1.0f / D);
            f32x4* xr = (f32x4*)(X + (size_t)m * D) + lane; const f32x4* gr = (const f32x4*)gf + lane;
#pragma unroll
            for (int j = 0; j < 4; ++j) { f32x4 v = xr[64 * j]; const f32x4 g = gr[64 * j]; v = v * rs * g; xr[64 * j] = v; }
        }
    }
}

extern "C" void kernel_launch(void* const* d_in, const int* in_sizes, int n_in, void* d_out, int out_size, void* d_ws, size_t ws_size, hipStream_t stream) {
    static int grid = 0;
    if (grid == 0) {
        if (n_in != 30 || out_size != M * D || ws_size < WS_END) { fprintf(stderr, "kernel_launch: unexpected shapes: n_in %d out %d ws %zu (need %zu)\n", n_in, out_size, ws_size, (size_t)WS_END); grid = -1; return; }
        int dev = 0, cus = 0, per_cu = 0;
        hipGetDevice(&dev);
        hipDeviceGetAttribute(&cus, hipDeviceAttributeMultiprocessorCount, dev);
        if (hipFuncSetAttribute((const void*)hybrid_fwd, hipFuncAttributeMaxDynamicSharedMemorySize, LDS_BYTES) != hipSuccess) { fprintf(stderr, "kernel_launch: hipFuncSetAttribute failed\n"); }
        if (hipOccupancyMaxActiveBlocksPerMultiprocessor(&per_cu, (const void*)hybrid_fwd, 512, LDS_BYTES) != hipSuccess || per_cu < 1) { fprintf(stderr, "kernel_launch: occupancy query says %d\n", per_cu); per_cu = 1; }
        (void)hipGetLastError();
        grid = cus * per_cu;
        fprintf(stderr, "kernel_launch: grid %d (cus %d x %d)\n", grid, cus, per_cu);
    }
    if (grid < 0) return;
    (void)hipMemsetAsync((char*)d_ws + WS_CTL, 0, 1 * MiB, stream);
    KP hp{};
    for (int i = 0; i < 30; ++i) hp.in[i] = (const float*)d_in[i];
    hp.out = (float*)d_out; hp.ws = (unsigned char*)d_ws;
    void* args[] = {&hp};
    hipError_t e = hipLaunchCooperativeKernel((const void*)hybrid_fwd, dim3(grid), dim3(512), args, LDS_BYTES, stream);
    if (e != hipSuccess) fprintf(stderr, "kernel_launch: cooperative launch failed: %s (grid %d)\n", hipGetErrorString(e), grid);
}
```

```cpp
#include <hip/hip_runtime.h>
#include <hip/hip_cooperative_groups.h>
#include <cstdio>
#include <cstdint>
namespace cg = cooperative_groups;
namespace pg8 {
#define PG8_LAS __attribute__((address_space(3)))
typedef unsigned short bf16_t;
typedef short bf16x8 __attribute__((ext_vector_type(8)));
typedef float f32x4 __attribute__((ext_vector_type(4)));
typedef unsigned u32x4 __attribute__((ext_vector_type(4)));
constexpr int BM = 256, BK = 64, HALF = 128, HTB = HALF * BK * 2  , STAGE_BYTES = 8 * HTB, NXCD = 8, WGM = 8;

__host__ __device__ __forceinline__ int lds_byte(int r, int c) { const int st = (r >> 4) * 2 + (c >> 5), rr = r & 15, cc = c & 31, ob = rr * 64 + cc * 2; return st * 1024 + (ob ^ (((ob >> 9) & 1) << 5)); }
__host__ __device__ __forceinline__ void stage_rc(int b, int& R, int& C) { const int st = b / 1024, sb = b % 1024, swz = sb ^ (((sb >> 9) & 1) << 5); R = (st >> 1) * 16 + swz / 64; C = (st & 1) * 32 + (swz % 64) / 2; }
__host__ __device__ __forceinline__ int perm32(int rho) { const int n = rho >> 4, i = rho & 15; return 8 * (i >> 2) + 4 * n + (i & 3); }

struct Unit { int pm, pn; };
struct Gemm { const bf16_t* A; const bf16_t* Bt; int M, N, K; };

struct StaticOrder {
    int nM, nN, nwg, G, c;
    __host__ __device__ void init(int M, int N, int G_, int c_) { nM = M / BM; nN = N / BM; nwg = nM * nN; G = G_; c = c_; }
    __host__ __device__ bool next(int i, Unit& u) const {
        const long L = (long)i * G + c; if (L >= nwg) return false;
        int wgid = (int)L; { const int q = nwg / NXCD, r = nwg % NXCD, xcd = wgid % NXCD, off = wgid / NXCD; wgid = (xcd < r ? xcd * (q + 1) : r * (q + 1) + (xcd - r) * q) + off; }
        const int nig = WGM * nN, gid = wgid / nig, fm = gid * WGM, gsz = (nM - fm) < WGM ? (nM - fm) : WGM;
        u.pm = fm + ((wgid % nig) % gsz); u.pn = (wgid % nig) / gsz; return true;
    }
    __device__ __forceinline__ void a_ready(const Unit&) const {}
    __device__ __forceinline__ void done(const Unit&) const {}
};

template <class Epi, class Sched, bool ALIGN_EPI = false, bool SP2 = false>
__device__ __forceinline__ void gemm_phase(PG8_LAS unsigned char* lds, const Gemm g, const Sched& S, const Epi& E, int tid_in) {
    int tid_ = tid_in; asm volatile("" : "+v"(tid_)); const int tid = tid_, wid = __builtin_amdgcn_readfirstlane(tid >> 6), lane = tid & 63, wr = wid >> 2, wc = wid & 3, fr = lane & 15, fq = lane >> 4;
    const int K = g.K, nt = K / BK;
    unsigned voffA[2], voffB[2];
#pragma unroll
    for (int i = 0; i < 2; ++i) { int R, C; stage_rc(tid * 16 + i * 8192, R, C); const int Rb = Epi::PERM ? ((R & ~31) + perm32(R & 31)) : R;
        voffA[i] = (unsigned)(R * K + C) * 2u; voffB[i] = (unsigned)(Rb * K + C) * 2u; }
    const size_t kstep = (size_t)(BK * 2);
    const size_t hstep = (size_t)HALF * K * 2;
    const size_t tstep = 2 * hstep;
    const unsigned ldsw = (unsigned)wid * 1024u;
    const int aoff = lds_byte(wr * 64 + fr, fq * 8), boff = lds_byte(wc * 32 + fr, fq * 8);
#define PG8_SA(b, h) (((b) * 2 + (h)) * HTB)
#define PG8_SB(b, h) ((4 + (b) * 2 + (h)) * HTB)
#define PG8_STAGE(bufoff, gbase, voff) do { _Pragma("unroll") for (int _i = 0; _i < 2; ++_i) \
        __builtin_amdgcn_global_load_lds((const unsigned*)((const char*)(gbase) + (voff)[_i]), (PG8_LAS unsigned*)(lds + (bufoff) + ldsw + _i * 8192), 16, 0, 0); } while (0)
#define PG8_LDA(dst, b, h) do { _Pragma("unroll") for (int m = 0; m < 4; ++m) _Pragma("unroll") for (int k = 0; k < 2; ++k) dst[m][k] = *(const PG8_LAS bf16x8*)(lds + PG8_SA(b, h) + aoff + m * 2048 + k * 1024); } while (0)
#define PG8_LDB(dst, b, h) do { _Pragma("unroll") for (int n = 0; n < 2; ++n) _Pragma("unroll") for (int k = 0; k < 2; ++k) dst[n][k] = *(const PG8_LAS bf16x8*)(lds + PG8_SB(b, h) + boff + n * 2048 + k * 1024); } while (0)
#define PG8_MMA(ai, bj, At, Bt) do { __builtin_amdgcn_s_setprio(1); _Pragma("unroll") for (int m = 0; m < 4; ++m) _Pragma("unroll") for (int n = 0; n < 2; ++n) _Pragma("unroll") for (int k = 0; k < 2; ++k) \
        acc[ai][bj][m][n] = __builtin_amdgcn_mfma_f32_16x16x32_bf16(Bt[n][k], At[m][k], acc[ai][bj][m][n], 0, 0, 0); __builtin_amdgcn_s_setprio(0); } while (0)
#define PG8_WAIT_V(n) asm volatile("s_waitcnt vmcnt(" #n ")" ::: "memory")
#define PG8_WAIT_L(n) asm volatile("s_waitcnt lgkmcnt(" #n ")" ::: "memory")
#define PG8_BAR __builtin_amdgcn_s_barrier()
#define PG8_SCHED __builtin_amdgcn_sched_barrier(0)
    Unit cur, nxt; int ui = 0;
    if (!S.next(0, cur)) return;
    f32x4 acc[2][2][4][2];
#pragma unroll
    for (int a = 0; a < 2; ++a)
#pragma unroll
        for (int b = 0; b < 2; ++b)
#pragma unroll
            for (int m = 0; m < 4; ++m)
#pragma unroll
                for (int n = 0; n < 2; ++n) acc[a][b][m][n] = (f32x4){0.f, 0.f, 0.f, 0.f};
    bf16x8 At[4][2], B0[2][2], B1[2][2];
    const char* cA = (const char*)g.A + (size_t)cur.pm * tstep; const char* cB = (const char*)g.Bt + (size_t)cur.pn * tstep;
    S.a_ready(cur);
    if constexpr (SP2) {
        PG8_STAGE(PG8_SB(0, 0), cB, voffB); PG8_STAGE(PG8_SB(0, 1), cB + hstep, voffB); PG8_STAGE(PG8_SA(0, 0), cA, voffA); PG8_STAGE(PG8_SA(0, 1), cA + hstep, voffA);
        if (wr == 1) PG8_BAR;
        PG8_WAIT_V(2); PG8_BAR;
        PG8_STAGE(PG8_SB(1, 0), cB + kstep, voffB); PG8_STAGE(PG8_SA(1, 0), cA + kstep, voffA); PG8_STAGE(PG8_SB(1, 1), cB + hstep + kstep, voffB);
        PG8_WAIT_V(6); PG8_BAR;
    } else {
        PG8_STAGE(PG8_SB(0, 0), cB, voffB); PG8_STAGE(PG8_SA(0, 0), cA, voffA); PG8_STAGE(PG8_SB(0, 1), cB + hstep, voffB); PG8_STAGE(PG8_SA(0, 1), cA + hstep, voffA);
        if (wr == 1) PG8_BAR;
        PG8_WAIT_V(4); PG8_BAR;
        PG8_STAGE(PG8_SB(1, 0), cB + kstep, voffB); PG8_STAGE(PG8_SA(1, 0), cA + kstep, voffA); PG8_STAGE(PG8_SB(1, 1), cB + hstep + kstep, voffB);
        PG8_WAIT_V(6); PG8_BAR;
    }
    for (;;) {
        const bool has_next = S.next(ui + 1, nxt);
        const char* nA = has_next ? (const char*)g.A + (size_t)nxt.pm * tstep : cA; const char* nB = has_next ? (const char*)g.Bt + (size_t)nxt.pn * tstep : cB;
        for (int t = 0; t < nt; t += 2) {
            const bool last = (t == nt - 2);
            const char* a1 = cA + (size_t)(t + 1) * kstep;
            const char* a2 = last ? nA : cA + (size_t)(t + 2) * kstep; const char* b2 = last ? nB : cB + (size_t)(t + 2) * kstep;
            const char* a3 = a2 + kstep; const char* b3 = b2 + kstep;
            if (last && has_next) S.a_ready(nxt);
            if constexpr (SP2) {
            PG8_LDB(B0, 0, 0); PG8_LDB(B1, 0, 1); PG8_SCHED; PG8_LDA(At, 0, 0); PG8_STAGE(PG8_SA(1, 1), a1 + hstep, voffA);
            PG8_WAIT_V(8); PG8_WAIT_L(0); PG8_BAR; PG8_MMA(0, 0, At, B0); PG8_MMA(0, 1, At, B1); PG8_BAR; PG8_SCHED;
            PG8_LDA(At, 0, 1); PG8_STAGE(PG8_SB(0, 0), b2, voffB); PG8_STAGE(PG8_SB(0, 1), b2 + hstep, voffB); PG8_STAGE(PG8_SA(0, 0), a2, voffA);
            PG8_WAIT_V(8); PG8_WAIT_L(0); PG8_BAR; PG8_MMA(1, 0, At, B0); PG8_MMA(1, 1, At, B1); PG8_BAR; PG8_SCHED;
            PG8_LDB(B0, 1, 0); PG8_LDB(B1, 1, 1); PG8_SCHED; PG8_LDA(At, 1, 0); PG8_STAGE(PG8_SA(0, 1), a2 + hstep, voffA);
            PG8_WAIT_V(8); PG8_WAIT_L(0); PG8_BAR; PG8_MMA(0, 0, At, B0); PG8_MMA(0, 1, At, B1); PG8_BAR; PG8_SCHED;
            PG8_LDA(At, 1, 1); PG8_STAGE(PG8_SB(1, 0), b3, voffB); PG8_STAGE(PG8_SB(1, 1), b3 + hstep, voffB); PG8_STAGE(PG8_SA(1, 0), a3, voffA);
            PG8_WAIT_V(8); PG8_WAIT_L(0); PG8_BAR; PG8_MMA(1, 0, At, B0); PG8_MMA(1, 1, At, B1); PG8_BAR; PG8_SCHED;
            } else {
            PG8_LDB(B0, 0, 0); PG8_SCHED; PG8_LDA(At, 0, 0); PG8_STAGE(PG8_SA(1, 1), a1 + hstep, voffA);
            PG8_WAIT_L(8); PG8_BAR; PG8_WAIT_L(0); PG8_MMA(0, 0, At, B0); PG8_BAR; PG8_SCHED;
            PG8_LDB(B1, 0, 1); PG8_STAGE(PG8_SB(0, 0), b2, voffB);
            PG8_BAR; PG8_WAIT_L(0); PG8_MMA(0, 1, At, B1); PG8_BAR;
            PG8_LDA(At, 0, 1); PG8_STAGE(PG8_SA(0, 0), a2, voffA);
            PG8_BAR; PG8_WAIT_L(0); PG8_MMA(1, 0, At, B0); PG8_BAR; PG8_SCHED;
            PG8_STAGE(PG8_SB(0, 1), b2 + hstep, voffB);
            PG8_WAIT_V(6); PG8_BAR; PG8_MMA(1, 1, At, B1); PG8_BAR;
            PG8_LDB(B0, 1, 0); PG8_SCHED; PG8_LDA(At, 1, 0); PG8_STAGE(PG8_SA(0, 1), a2 + hstep, voffA);
            PG8_WAIT_L(8); PG8_BAR; PG8_WAIT_L(0); PG8_MMA(0, 0, At, B0); PG8_BAR; PG8_SCHED;
            PG8_LDB(B1, 1, 1); PG8_STAGE(PG8_SB(1, 0), b3, voffB);
            PG8_BAR; PG8_WAIT_L(0); PG8_MMA(0, 1, At, B1); PG8_BAR;
            PG8_LDA(At, 1, 1); PG8_STAGE(PG8_SA(1, 0), a3, voffA);
            PG8_BAR; PG8_WAIT_L(0); PG8_MMA(1, 0, At, B0); PG8_BAR; PG8_SCHED;
            PG8_STAGE(PG8_SB(1, 1), b3 + hstep, voffB);
            PG8_WAIT_V(6); PG8_BAR; PG8_MMA(1, 1, At, B1); PG8_BAR;
            }
        }
        if constexpr (ALIGN_EPI) { if (wr == 0) PG8_BAR; }
        if constexpr (!Epi::AFTER_DRAIN) { E(acc, cur, wr, wc, fr, fq); S.done(cur); }
        if (!has_next) break;
#pragma unroll
        for (int a = 0; a < 2; ++a)
#pragma unroll
            for (int b = 0; b < 2; ++b)
#pragma unroll
                for (int m = 0; m < 4; ++m)
#pragma unroll
                    for (int n = 0; n < 2; ++n) acc[a][b][m][n] = (f32x4){0.f, 0.f, 0.f, 0.f};
        cur = nxt; cA = nA; cB = nB; ++ui;
        if constexpr (ALIGN_EPI) { if (wr == 1) PG8_BAR; }
    }
    PG8_WAIT_V(0);
    if constexpr (!ALIGN_EPI) { if (wr == 0) PG8_BAR; }
    PG8_BAR;
    if constexpr (Epi::AFTER_DRAIN) { E.fused(acc, cur, wr, wc, fr, fq, lds, wid, lane); S.done(cur); }
#undef PG8_SA
#undef PG8_SB
#undef PG8_STAGE
#undef PG8_LDA
#undef PG8_LDB
#undef PG8_MMA
#undef PG8_WAIT_V
#undef PG8_WAIT_L
#undef PG8_BAR
#undef PG8_SCHED
}
}
using pg8::bf16_t; using pg8::bf16x8; using pg8::f32x4; using pg8::u32x4; using pg8::Unit; using pg8::Gemm; using pg8::StaticOrder;
typedef float f32x2 __attribute__((ext_vector_type(2)));
typedef unsigned u32x2 __attribute__((ext_vector_type(2)));
#define LAS __attribute__((address_space(3)))

#ifndef NAIVE_GEMM
#define NAIVE_GEMM 0
#endif
#ifndef R_PRO
#define R_PRO 1
#endif
#ifndef R_ATTN
#define R_ATTN 1
#endif
#ifndef R_CONV
#define R_CONV 1
#endif
#ifndef R_SYNC
#define R_SYNC 1
#endif
#ifndef R_UP
#define R_UP 1
#endif
#ifndef R_POST
#define R_POST 1
#endif
#ifndef NAIVE_ATTN
#define NAIVE_ATTN 0
#endif
#ifndef NAIVE_CONV
#define NAIVE_CONV 0
#endif

constexpr int M = 16384, D = 1024, FF = 2816, SEQ = 2048, HC = 512, PLE = 256;
constexpr float EPS = 1e-6f;
constexpr size_t MiB = 1u << 20;
constexpr size_t WS_CTL = 0, WS_W = 1 * MiB, WS_FT = 45 * MiB, WS_PB = 53 * MiB, WS_XB = 69 * MiB, WS_R1 = 101 * MiB, WS_R2 = 197 * MiB, WS_END = 261 * MiB;
constexpr size_t W_GUA = 0, W_DA = 11 * MiB, W_IN = W_DA + 5767168, W_OUT = W_IN + 6 * MiB, W_GUB = W_OUT + 2 * MiB, W_DB = W_GUB + 11 * MiB, W_PG = W_DB + 5767168, W_PP = W_PG + 2 * MiB;
static_assert(W_PP + 512 * 1024 <= 44 * MiB, "weights");
constexpr int LDS_BYTES = 131072 + 4096;
constexpr size_t BAR_OFF = 640 * 1024;

struct KP { const float* in[30]; float* out; unsigned char* ws; };
typedef const __attribute__((address_space(4))) KP* KPC;
#define KPARAMS() ({ KPC q_ = (KPC)__builtin_amdgcn_kernarg_segment_ptr(); asm volatile("" : "+s"(q_)); q_; })

__device__ __forceinline__ unsigned cvt_pk_bf16(float lo, float hi) { unsigned r; asm volatile("v_cvt_pk_bf16_f32 %0, %1, %2" : "=v"(r) : "v"(lo), "v"(hi)); return r; }
__device__ __forceinline__ float bf_lo(unsigned w) { return __uint_as_float(w << 16); }
__device__ __forceinline__ float bf_hi(unsigned w) { return __uint_as_float(w & 0xffff0000u); }
__device__ __forceinline__ float bf2f(bf16_t b) { return __uint_as_float(((unsigned)b) << 16); }
__device__ __forceinline__ float wave_sum(float v) {
#pragma unroll
    for (int o = 1; o < 64; o <<= 1) v += __shfl_xor(v, o);
    return v;
}
__device__ __forceinline__ int fresh_tid(int wv) {
    int l; asm volatile("v_mbcnt_lo_u32_b32 %0, -1, 0\n\tv_mbcnt_hi_u32_b32 %0, -1, %0" : "=v"(l));
    return wv * 64 + l;
}
__device__ __forceinline__ int fresh_bx() { int b = blockIdx.x; asm volatile("" : "+s"(b)); return b; }
#define XB_TMO      128
#define XB_XCNT(j)  (256  + 64 * (j))
#define XB_XSUB(j)  (1280 + 64 * (j))
#define XB_XGEN(j)  (2304 + 64 * (j))
#define XB_TOP      3328
#define XB_TOPGEN   3392
#define XCD_BAR_WORDS 3456
#define XB_SPIN_CAP (1u << 18)

__device__ __forceinline__ unsigned xb_ld(unsigned* p)              { return __hip_atomic_load(p, __ATOMIC_RELAXED, __HIP_MEMORY_SCOPE_AGENT); }
__device__ __forceinline__ unsigned xb_add(unsigned* p, unsigned v) { return __hip_atomic_fetch_add(p, v, __ATOMIC_RELAXED, __HIP_MEMORY_SCOPE_AGENT); }
__device__ __forceinline__ unsigned xb_xcc_id() { return (unsigned)__builtin_amdgcn_s_getreg((3 << 11) | 20) & 0xFu; }
#define XB_SPIN(cond, bar) do { unsigned _sp = 0; while (cond) { __builtin_amdgcn_s_sleep(1); \
    if ((++_sp & 255u) == 0u) { if (xb_ld(&(bar)[XB_TMO])) break; if (_sp > XB_SPIN_CAP) { atomicAdd(&(bar)[XB_TMO], 1u); break; } } } } while (0)

struct XcdBarrier {
    unsigned* bar; unsigned x;
    volatile LAS unsigned* st;
};

__device__ __forceinline__ XcdBarrier xcd_barrier_post(unsigned* bar, volatile LAS unsigned* st, int wv) {
    XcdBarrier b; b.bar = bar; b.x = xb_xcc_id(); b.st = st;
    if (fresh_tid(wv) == 0) (void)xb_add(&bar[XB_XCNT(b.x)], 1u);
    return b;
}
__device__ __forceinline__ void xcd_barrier_complete(unsigned* bar, unsigned x, unsigned& nloc, unsigned& nx) {
    const unsigned G = gridDim.x * gridDim.y * gridDim.z;
    unsigned sum, cnt, mine, sp = 0u;
    for (;;) {
        sum = 0u; cnt = 0u; mine = 0u;
#pragma unroll
        for (unsigned j = 0; j < 16; ++j) { const unsigned c = xb_ld(&bar[XB_XCNT(j)]); sum += c; cnt += (c > 0u) ? 1u : 0u; mine = (j == x) ? c : mine; }
        if (sum == G) break;
        __builtin_amdgcn_s_sleep(1);
        if ((++sp & 255u) == 0u) { if (xb_ld(&bar[XB_TMO])) break; if (sp > XB_SPIN_CAP) { atomicAdd(&bar[XB_TMO], 1u); break; } }
    }
    nloc = mine > 0u ? mine : 1u; nx = cnt > 0u ? cnt : 1u;
}

__device__ __forceinline__ void xcd_barrier(const XcdBarrier& b, int wv) {
    asm volatile("s_waitcnt vmcnt(0)" ::: "memory");
    __syncthreads();
    if (fresh_tid(wv) == 0) {
        unsigned* bar = b.bar;
        __builtin_amdgcn_s_waitcnt(0);
        unsigned nloc = b.st[0], nx = b.st[1];
        if (nloc == 0u) { xcd_barrier_complete(bar, b.x, nloc, nx); b.st[0] = nloc; b.st[1] = nx; }
        const unsigned old = xb_add(&bar[XB_XSUB(b.x)], 1u);
        const unsigned gen = old / nloc;
        if (old + 1u == (gen + 1u) * nloc) {
            __builtin_amdgcn_fence(__ATOMIC_RELEASE, "agent");
            asm volatile("s_waitcnt vmcnt(0)" ::: "memory");
            const unsigned og = xb_add(&bar[XB_TOP], 1u);
            const unsigned tg = og / nx;
            if (og + 1u == (tg + 1u) * nx) xb_add(&bar[XB_TOPGEN], 1u);
            else XB_SPIN(xb_ld(&bar[XB_TOPGEN]) == tg, bar);
            __builtin_amdgcn_fence(__ATOMIC_ACQUIRE, "agent");
            xb_add(&bar[XB_XGEN(b.x)], 1u);
            asm volatile("s_waitcnt vmcnt(0)" ::: "memory");
        } else {
            XB_SPIN(xb_ld(&bar[XB_XGEN(b.x)]) == gen, bar);
            __builtin_amdgcn_fence(__ATOMIC_ACQUIRE, "agent");
            asm volatile("s_waitcnt vmcnt(0)" ::: "memory");
        }
    }
    __syncthreads();
}

__device__ __forceinline__ float rstd_of(float ss, float invn) { return rsqrtf(ss * invn + EPS); }

struct EpiSwiGLU {
    static constexpr bool PERM = true, AFTER_DRAIN = false;
    bf16_t* H; const float* ss;
    __device__ __forceinline__ void operator()(const f32x4 (&acc)[2][2][4][2], const Unit& u, int wr, int wc, int fr, int fq) const {
        const int row0 = u.pm * 256 + wr * 64 + fr, col0 = u.pn * 128 + wc * 32 + 8 * fq;
#pragma unroll
        for (int ai = 0; ai < 2; ++ai)
#pragma unroll
            for (int m = 0; m < 4; ++m) {
                const int row = row0 + ai * 128 + m * 16;
                const float rs = rstd_of(ss[row], 1.0f / D);
                unsigned w[4];
#pragma unroll
                for (int n = 0; n < 2; ++n) {
                    float hv[4];
#pragma unroll
                    for (int e = 0; e < 4; ++e) {
                        const float g = acc[ai][0][m][n][e] * rs, uu = acc[ai][1][m][n][e] * rs;
                        hv[e] = g * __builtin_amdgcn_rcpf(1.0f + __expf(-g)) * uu;
                    }
                    w[2 * n] = cvt_pk_bf16(hv[0], hv[1]); w[2 * n + 1] = cvt_pk_bf16(hv[2], hv[3]);
                }
                *(u32x4*)(H + (size_t)row * FF + col0) = (u32x4){w[0], w[1], w[2], w[3]};
            }
    }
};
struct EpiResid {
    static constexpr bool PERM = false, AFTER_DRAIN = false;
    const float* base; float* X; bf16_t* xb; float* ssn; float alpha;
    __device__ __forceinline__ void operator()(const f32x4 (&acc)[2][2][4][2], const Unit& u, int wr, int wc, int fr, int fq) const {
        const int row0 = u.pm * 256 + wr * 64 + fr, col0 = u.pn * 256 + wc * 32 + 4 * fq;
#pragma unroll
        for (int ai = 0; ai < 2; ++ai)
#pragma unroll
            for (int m = 0; m < 4; ++m) {
                const int row = row0 + ai * 128 + m * 16; float sq = 0.f;
#pragma unroll
                for (int bj = 0; bj < 2; ++bj)
#pragma unroll
                    for (int n = 0; n < 2; ++n) {
                        const size_t off = (size_t)row * D + col0 + bj * 128 + n * 16;
                        const f32x4 bs = *(const f32x4*)(base + off);
                        const f32x4 o = bs + acc[ai][bj][m][n] * alpha;
                        *(f32x4*)(X + off) = o;
                        *(u32x2*)(xb + off) = (u32x2){cvt_pk_bf16(o[0], o[1]), cvt_pk_bf16(o[2], o[3])};
                        sq += (o[0] * o[0] + o[1] * o[1]) + (o[2] * o[2] + o[3] * o[3]);
                    }
                sq += __shfl_xor(sq, 16); sq += __shfl_xor(sq, 32);
                if (fq == 0) unsafeAtomicAdd(ssn + row, sq);
                asm volatile("" ::: "memory");
            }
    }
};
struct EpiPle {
    static constexpr bool PERM = false, AFTER_DRAIN = false;
    float* X; const float* PP; const float* ss; bf16_t* xb; float* ssn;
    __device__ __forceinline__ void operator()(const f32x4 (&acc)[2][2][4][2], const Unit& u, int wr, int wc, int fr, int fq) const {
        const int row0 = u.pm * 256 + wr * 64 + fr, col0 = u.pn * 256 + wc * 32 + 4 * fq;
#pragma unroll
        for (int ai = 0; ai < 2; ++ai)
#pragma unroll
            for (int m = 0; m < 4; ++m) {
                const int row = row0 + ai * 128 + m * 16; float sq = 0.f;
                const float rs = rstd_of(ss[row], 1.0f / D);
#pragma unroll
                for (int bj = 0; bj < 2; ++bj)
#pragma unroll
                    for (int n = 0; n < 2; ++n) {
                        const size_t off = (size_t)row * D + col0 + bj * 128 + n * 16;
                        const f32x4 bs = *(const f32x4*)(X + off);
                        const f32x4 pp = *(const f32x4*)(PP + off);
                        f32x4 o;
#pragma unroll
                        for (int e = 0; e < 4; ++e) { const float a = acc[ai][bj][m][n][e] * rs; o[e] = bs[e] + __builtin_amdgcn_rcpf(1.0f + __expf(-a)) * pp[e]; }
                        *(f32x4*)(X + off) = o;
                        *(u32x2*)(xb + off) = (u32x2){cvt_pk_bf16(o[0], o[1]), cvt_pk_bf16(o[2], o[3])};
                        sq += (o[0] * o[0] + o[1] * o[1]) + (o[2] * o[2] + o[3] * o[3]);
                    }
                sq += __shfl_xor(sq, 16); sq += __shfl_xor(sq, 32);
                if (fq == 0) unsafeAtomicAdd(ssn + row, sq);
                asm volatile("" ::: "memory");
            }
    }
};
struct EpiScaleRow {
    static constexpr bool PERM = true, AFTER_DRAIN = false;
    bf16_t* O; int ldc; const float* ss;
    __device__ __forceinline__ void operator()(const f32x4 (&acc)[2][2][4][2], const Unit& u, int wr, int wc, int fr, int fq) const {
        const int row0 = u.pm * 256 + wr * 64 + fr, col0 = u.pn * 256 + wc * 32 + 8 * fq;
#pragma unroll
        for (int ai = 0; ai < 2; ++ai)
#pragma unroll
            for (int m = 0; m < 4; ++m) {
                const int row = row0 + ai * 128 + m * 16;
                const float rs = rstd_of(ss[row], 1.0f / D);
#pragma unroll
                for (int bj = 0; bj < 2; ++bj) {
                    const f32x4 v0 = acc[ai][bj][m][0] * rs, v1 = acc[ai][bj][m][1] * rs;
                    *(u32x4*)(O + (size_t)row * ldc + col0 + bj * 128) = (u32x4){cvt_pk_bf16(v0[0], v0[1]), cvt_pk_bf16(v0[2], v0[3]), cvt_pk_bf16(v1[0], v1[1]), cvt_pk_bf16(v1[2], v1[3])};
                }
            }
    }
};
struct EpiScaleCol {
    static constexpr bool PERM = true, AFTER_DRAIN = false;
    bf16_t* O; int ldc; const float* ss;
    __device__ __forceinline__ void operator()(const f32x4 (&acc)[2][2][4][2], const Unit& u, int wr, int wc, int fr, int fq) const {
        const int row0 = u.pm * 256 + wr * 64 + fr, col0 = u.pn * 256 + wc * 32 + 8 * fq;
#pragma unroll
        for (int bj = 0; bj < 2; ++bj) {
            float rs[8];
            {
                const f32x4 a = *(const f32x4*)(ss + col0 + bj * 128), b = *(const f32x4*)(ss + col0 + bj * 128 + 4);
#pragma unroll
                for (int e = 0; e < 4; ++e) { rs[e] = rstd_of(a[e], 1.0f / D); rs[4 + e] = rstd_of(b[e], 1.0f / D); }
            }
#pragma unroll
            for (int ai = 0; ai < 2; ++ai)
#pragma unroll
                for (int m = 0; m < 4; ++m) {
                    const int row = row0 + ai * 128 + m * 16;
                    const f32x4 v0 = acc[ai][bj][m][0], v1 = acc[ai][bj][m][1];
                    *(u32x4*)(O + (size_t)row * ldc + col0 + bj * 128) = (u32x4){cvt_pk_bf16(v0[0] * rs[0], v0[1] * rs[1]), cvt_pk_bf16(v0[2] * rs[2], v0[3] * rs[3]),
                                                                                  cvt_pk_bf16(v1[0] * rs[4], v1[1] * rs[5]), cvt_pk_bf16(v1[2] * rs[6], v1[3] * rs[7])};
                }
        }
    }
};
struct EpiStoreF32 {
    static constexpr bool PERM = false, AFTER_DRAIN = false;
    float* O; int ldc;
    __device__ __forceinline__ void operator()(const f32x4 (&acc)[2][2][4][2], const Unit& u, int wr, int wc, int fr, int fq) const {
        const int row0 = u.pm * 256 + wr * 64 + fr, col0 = u.pn * 256 + wc * 32 + 4 * fq;
#pragma unroll
        for (int ai = 0; ai < 2; ++ai)
#pragma unroll
            for (int m = 0; m < 4; ++m)
#pragma unroll
                for (int bj = 0; bj < 2; ++bj)
#pragma unroll
                    for (int n = 0; n < 2; ++n) *(f32x4*)(O + (size_t)(row0 + ai * 128 + m * 16) * ldc + col0 + bj * 128 + n * 16) = acc[ai][bj][m][n];
    }
};

template <class Epi>
__device__ __forceinline__ void gemm_naive(int wv, const Gemm g, const StaticOrder& S, const Epi& E) {
    const int tid = fresh_tid(wv), wid = tid >> 6, lane = tid & 63, wr = wid >> 2, wc = wid & 3, fr = lane & 15, fq = lane >> 4;
    Unit u;
    for (int ui = 0; S.next(ui, u); ++ui) {
        f32x4 acc[2][2][4][2];
#pragma unroll
        for (int a = 0; a < 2; ++a)
#pragma unroll
            for (int b = 0; b < 2; ++b)
#pragma unroll
                for (int m = 0; m < 4; ++m)
#pragma unroll
                    for (int n = 0; n < 2; ++n) acc[a][b][m][n] = (f32x4){0.f, 0.f, 0.f, 0.f};
        for (int k0 = 0; k0 < g.K; k0 += 32) {
            bf16x8 Bf[2][2];
#pragma unroll
            for (int bj = 0; bj < 2; ++bj)
#pragma unroll
                for (int n = 0; n < 2; ++n) {
                    const int slot = 16 * n + fr; const int rr = Epi::PERM ? pg8::perm32(slot) : slot;
                    Bf[bj][n] = *(const bf16x8*)(g.Bt + (size_t)(u.pn * 256 + bj * 128 + wc * 32 + rr) * g.K + k0 + 8 * fq);
                }
#pragma unroll
            for (int ai = 0; ai < 2; ++ai)
#pragma unroll
                for (int m = 0; m < 4; ++m) {
                    const bf16x8 Af = *(const bf16x8*)(g.A + (size_t)(u.pm * 256 + ai * 128 + wr * 64 + m * 16 + fr) * g.K + k0 + 8 * fq);
#pragma unroll
                    for (int bj = 0; bj < 2; ++bj)
#pragma unroll
                        for (int n = 0; n < 2; ++n) acc[ai][bj][m][n] = __builtin_amdgcn_mfma_f32_16x16x32_bf16(Bf[bj][n], Af, acc[ai][bj][m][n], 0, 0, 0);
                }
        }
        E(acc, u, wr, wc, fr, fq);
    }
}
template <class Epi>
__device__ __forceinline__ void gemm_run(int wv, LAS unsigned char* lds, const bf16_t* A, const bf16_t* Bt, int Mm, int Nn, int Kk, const Epi& E) {
    int bx_ = blockIdx.x; asm volatile("" : "+s"(bx_));
    Gemm g{A, Bt, Mm, Nn, Kk}; StaticOrder S; S.init(Mm, Nn, (int)gridDim.x, bx_);
#if NAIVE_GEMM
    gemm_naive<Epi>(wv, g, S, E);
    __syncthreads();
#else
    pg8::gemm_phase<Epi, StaticOrder, true, true>(lds, g, S, E, fresh_tid(wv));
#endif
}

__device__ __forceinline__ void transpose_item(const float* W, int K, int N, const float* gain, bf16_t* WT, int mode, int row_off, LAS float* scr, int item, int lane) {
    const int nblk = N / 32, kb = item / nblk, nb = item % nblk, k0 = 64 * kb, n0 = 32 * nb;
    f32x4 v[8];
#pragma unroll
    for (int i = 0; i < 8; ++i) v[i] = *(const f32x4*)(W + (size_t)(k0 + (lane >> 3) + 8 * i) * N + n0 + 4 * (lane & 7));
#pragma unroll
    for (int i = 0; i < 8; ++i) {
        const int kk = (lane >> 3) + 8 * i; const float gg = gain ? gain[k0 + kk] : 1.0f;
        LAS float* d = scr + kk * 33 + 4 * (lane & 7);
        d[0] = v[i][0] * gg; d[1] = v[i][1] * gg; d[2] = v[i][2] * gg; d[3] = v[i][3] * gg;
    }
    asm volatile("s_waitcnt lgkmcnt(0)" ::: "memory");
    const int c = lane & 7;
#pragma unroll
    for (int j = 0; j < 4; ++j) {
        const int n = (lane >> 3) + 8 * j, ncol = n0 + n; const LAS float* s = scr + (8 * c) * 33 + n;
        const int row = (mode == 1) ? (256 * (ncol >> 7) + (ncol & 127) + row_off) : (row_off + ncol);
        const float sc = (mode == 2 && ncol < 512) ? 0.125f : 1.0f;
        u32x4 o; o.x = cvt_pk_bf16(s[0 * 33] * sc, s[1 * 33] * sc); o.y = cvt_pk_bf16(s[2 * 33] * sc, s[3 * 33] * sc); o.z = cvt_pk_bf16(s[4 * 33] * sc, s[5 * 33] * sc); o.w = cvt_pk_bf16(s[6 * 33] * sc, s[7 * 33] * sc);
        *(u32x4*)(WT + (size_t)row * K + k0 + 8 * c) = o;
    }
    asm volatile("s_waitcnt lgkmcnt(0)" ::: "memory");
}

constexpr float MIN_DECAY = -3.0701134573253946f, MAX_DECAY = -15.350567286626973f;
__device__ __forceinline__ void filter_item(KPC p, int layer, int item, int lane, float* FT) {
    const float* wf1 = p->in[11] + layer * 33 * 64; const float* bf1 = p->in[12] + layer * 64;
    const float* wf2 = p->in[13] + layer * 4096;    const float* bf2 = p->in[14] + layer * 64;
    const float* wf3 = p->in[15] + layer * 4096;    const float* bf3 = p->in[16] + layer * 64;
    const float* wf4 = p->in[17] + layer * 64 * 1024; const float fq = p->in[18][layer * 64 + lane];
    const int i0 = item * 4;
    float h[4];
#pragma unroll
    for (int q = 0; q < 4; ++q) {
        const int i = i0 + q;
        const float t = (float)i * (1.0f / 2047.0f), w = 6.283185307179586f * (float)i / 2048.0f;
        const int j = (lane - 1) & 15; const float f = 1e-4f + (float)j * ((15.0f - 1e-4f) / 15.0f);
        const float a = f * w;
        float zf = 0.f;
        if (lane == 0) zf = t; else if (lane <= 16) zf = __cosf(a); else if (lane <= 32) zf = -__sinf(a);
        float s = bf1[lane];
        for (int k = 0; k < 33; ++k) s += __shfl(zf, k) * wf1[k * 64 + lane];
        h[q] = __sinf(fq * s);
    }
#pragma unroll
    for (int q = 0; q < 4; ++q) {
        float s = bf2[lane];
        for (int k = 0; k < 64; ++k) s += __shfl(h[q], k) * wf2[k * 64 + lane];
        const float h2 = __sinf(fq * s);
        float s3 = bf3[lane];
        for (int k = 0; k < 64; ++k) s3 += __shfl(h2, k) * wf3[k * 64 + lane];
        h[q] = __sinf(fq * s3);
    }
    float acc[4][16];
#pragma unroll
    for (int q = 0; q < 4; ++q)
#pragma unroll
        for (int jj = 0; jj < 16; ++jj) acc[q][jj] = 0.f;
    for (int k = 0; k < 64; ++k) {
        const float h0 = __shfl(h[0], k), h1 = __shfl(h[1], k), h2 = __shfl(h[2], k), h3 = __shfl(h[3], k);
#pragma unroll
        for (int jj = 0; jj < 16; ++jj) { const float w = wf4[k * 1024 + lane + 64 * jj]; acc[0][jj] += h0 * w; acc[1][jj] += h1 * w; acc[2][jj] += h2 * w; acc[3][jj] += h3 * w; }
    }
#pragma unroll
    for (int jj = 0; jj < 16; ++jj) {
        const int cf = lane + 64 * jj, dir = cf >> 9, c = cf & 511;
        const float delta = fabsf(MIN_DECAY + (float)c * ((MAX_DECAY - MIN_DECAY) / 511.0f));
        f32x4 o;
#pragma unroll
        for (int q = 0; q < 4; ++q) { const float t = (float)(i0 + q) * (1.0f / 2047.0f); o[q] = acc[q][jj] * __expf(-t * delta); }
        *(f32x4*)(FT + ((size_t)(dir * 512 + c)) * SEQ + i0) = o;
    }
}

__device__ __forceinline__ void layer_prologue(int wv, KPC p, int layer, LAS unsigned char* lds) {
    const int tid = fresh_tid(wv), bx = fresh_bx(), lane = tid & 63, wave = tid >> 6;
    LAS float* scr = (LAS float*)(lds + wave * 16384);
    const int gw = bx * 8 + wave, NGW = gridDim.x * 8;
    unsigned char* Wb = p->ws + WS_W;
    const size_t lf = (size_t)layer;
    constexpr int I_G = 16 * 88, I_D = 44 * 32, I_IN = 16 * 96, I_O = 16 * 32, I_PP = 4 * 32;
    constexpr int NITEMS = 6 * I_G + I_IN + 2 * I_O + I_PP;
    static_assert(I_G == I_D, "items");
    for (int it = gw; it < NITEMS + 512; it += NGW) {
        int r = it;
        if (r >= NITEMS) { filter_item(p, layer, r - NITEMS, lane, (float*)(p->ws + WS_FT)); continue; }
        int wi, gi = -1, K = D, N = FF, mode = 1, row_off = 0; size_t wo = W_GUA, wstride = (size_t)D * FF;
        if (r < I_G) { wi = 3; gi = 2; }
        else if ((r -= I_G) < I_G) { wi = 4; gi = 2; row_off = 128; }
        else if ((r -= I_G) < I_D) { wi = 5; K = FF; N = D; mode = 0; wo = W_DA; }
        else if ((r -= I_D) < I_IN) { wi = 7; gi = 6; N = 3072; mode = 2; wo = W_IN; wstride = (size_t)D * 3072; }
        else if ((r -= I_IN) < I_O) { wi = 21; gi = 20; N = D; mode = 0; wo = W_OUT; wstride = (size_t)D * D; }
        else if ((r -= I_O) < I_G) { wi = 23; gi = 22; wo = W_GUB; }
        else if ((r -= I_G) < I_G) { wi = 24; gi = 22; row_off = 128; wo = W_GUB; }
        else if ((r -= I_G) < I_D) { wi = 25; K = FF; N = D; mode = 0; wo = W_DB; }
        else if ((r -= I_D) < I_O) { wi = 27; gi = 26; N = D; mode = 0; wo = W_PG; wstride = (size_t)D * D; }
        else { r -= I_O; wi = 28; K = PLE; N = D; mode = 0; wo = W_PP; wstride = (size_t)PLE * D; }
        const float* gain = gi >= 0 ? p->in[gi] + lf * D : nullptr;
        transpose_item(p->in[wi] + lf * wstride, K, N, gain, (bf16_t*)(Wb + wo), mode, row_off, scr, r, lane);
    }
    if (layer == 0) {
        bf16_t* xb = (bf16_t*)(p->ws + WS_XB); float* ss0 = (float*)(p->ws + WS_CTL);
        for (int m = gw; m < M; m += NGW) {
            const f32x4* xr = (const f32x4*)(p->in[0] + (size_t)m * D) + lane;
            f32x4 v[4]; float s = 0.f;
#pragma unroll
            for (int j = 0; j < 4; ++j) { v[j] = xr[64 * j]; s += (v[j][0] * v[j][0] + v[j][1] * v[j][1]) + (v[j][2] * v[j][2] + v[j][3] * v[j][3]); }
            s = wave_sum(s);
            if (lane == 0) ss0[m] = s;
            u32x2* o8 = (u32x2*)(xb + (size_t)m * D) + lane;
#pragma unroll
            for (int j = 0; j < 4; ++j) o8[64 * j] = (u32x2){cvt_pk_bf16(v[j][0], v[j][1]), cvt_pk_bf16(v[j][2], v[j][3])};
        }
        bf16_t* pb = (bf16_t*)(p->ws + WS_PB);
        const size_t n8 = (size_t)2 * M * PLE / 8;
        for (size_t i = (size_t)bx * 512 + tid; i < n8; i += (size_t)gridDim.x * 512) {
            const f32x4 a = *(const f32x4*)(p->in[1] + i * 8), b = *(const f32x4*)(p->in[1] + i * 8 + 4);
            *(u32x4*)(pb + i * 8) = (u32x4){cvt_pk_bf16(a[0], a[1]), cvt_pk_bf16(a[2], a[3]), cvt_pk_bf16(b[0], b[1]), cvt_pk_bf16(b[2], b[3])};
        }
    }
}

__device__ __forceinline__ void attn_naive(int wv, KPC p, int layer, const bf16_t* QK, const bf16_t* UT, bf16_t* yna) {
    const float* rpb = p->in[8] + layer * 8 * 15 * 31;
    const int tid = fresh_tid(wv), bx = fresh_bx();
    for (int it = bx * 512 + tid; it < M * 8; it += gridDim.x * 512) {
        const int h = it / M, tok = it % M;
        const int b = tok >> 11, l = tok & 2047, r = l >> 6, qc = l & 63;
        const int rs = min(max(r - 4, 0), 24), qcs = min(max(qc - 8, 0), 48);
        float o[64]; u32x4 qp[8];
#pragma unroll
        for (int j = 0; j < 8; ++j) qp[j] = *(const u32x4*)(QK + (size_t)tok * 1024 + 64 * h + 8 * j);
#pragma unroll
        for (int d = 0; d < 64; ++d) o[d] = 0.f;
        float mx = -3.0e38f, ls = 0.f;
        for (int kr = 0; kr < 8; ++kr)
            for (int kx = 0; kx < 16; ++kx) {
                const int krow = rs + kr, kc = qcs + kx; const size_t ktok = (size_t)b * 2048 + krow * 64 + kc;
                float s = 0.f;
#pragma unroll
                for (int j = 0; j < 8; ++j) {
                    const u32x4 v = *(const u32x4*)(QK + ktok * 1024 + 512 + 64 * h + 8 * j);
                    const u32x4 qq = qp[j];
                    s += bf_lo(qq.x) * bf_lo(v.x) + bf_hi(qq.x) * bf_hi(v.x) + bf_lo(qq.y) * bf_lo(v.y) + bf_hi(qq.y) * bf_hi(v.y)
                       + bf_lo(qq.z) * bf_lo(v.z) + bf_hi(qq.z) * bf_hi(v.z) + bf_lo(qq.w) * bf_lo(v.w) + bf_hi(qq.w) * bf_hi(v.w);
                }
                s += rpb[(h * 15 + (krow - r + 7)) * 31 + (kc - qc + 15)];
                const float mn = fmaxf(mx, s), corr = __expf(mx - mn), pe = __expf(s - mn);
                ls = ls * corr + pe; mx = mn;
#pragma unroll
                for (int d = 0; d < 64; ++d) o[d] = o[d] * corr + pe * bf2f(UT[(size_t)(64 * h + d) * M + ktok]);
            }
        const float inv = 1.0f / ls;
#pragma unroll
        for (int j = 0; j < 8; ++j)
            *(u32x4*)(yna + (size_t)tok * 512 + 64 * h + 8 * j) = (u32x4){cvt_pk_bf16(o[8 * j] * inv, o[8 * j + 1] * inv), cvt_pk_bf16(o[8 * j + 2] * inv, o[8 * j + 3] * inv),
                                                                         cvt_pk_bf16(o[8 * j + 4] * inv, o[8 * j + 5] * inv), cvt_pk_bf16(o[8 * j + 6] * inv, o[8 * j + 7] * inv)};
    }
}

__device__ __forceinline__ float sconv(const bf16_t* row, int t, float w0, float w1, float w2, float bb) {
    const float a = t > 0 ? bf2f(row[t - 1]) : 0.f, b = bf2f(row[t]), c = t < SEQ - 1 ? bf2f(row[t + 1]) : 0.f;
    return a * w0 + b * w1 + c * w2 + bb;
}
__device__ __forceinline__ void conv_naive(int wv, KPC p, int layer, LAS unsigned char* lds, const bf16_t* UT, const float* FT, bf16_t* yhyT) {
    LAS float* karr = (LAS float*)lds; LAS float* zf = karr + 4096; LAS float* x0f = zf + 2048; LAS float* red = x0f + 2048;
    const float* wsc = p->in[9] + layer * 3 * 1536; const float* bsc = p->in[10] + layer * 1536; const float* hyb = p->in[19] + layer * 512;
    const int tid = fresh_tid(wv), bx = fresh_bx(), lane = tid & 63, wave = tid >> 6;
    for (int it = bx; it < 512 * 8; it += gridDim.x) {
        const int c = it >> 3, b = it & 7;
        __syncthreads();
        float asum = 0.f;
        for (int d = tid; d < 4096; d += 512) {
            const int dd = d - 2048; float v;
            if (dd == -2048) v = 0.f; else if (dd == 0) v = FT[(size_t)c * SEQ] + FT[(size_t)(512 + c) * SEQ]; else if (dd > 0) v = FT[(size_t)c * SEQ + dd]; else v = FT[(size_t)(512 + c) * SEQ - dd];
            karr[d] = v; asum += fabsf(v);
        }
        {
            const bf16_t* r0 = UT + (size_t)(512 + c) * M + b * 2048; const bf16_t* r1 = UT + (size_t)(1024 + c) * M + b * 2048; const bf16_t* r2 = UT + (size_t)(1536 + c) * M + b * 2048;
            const float a0 = wsc[c], a1 = wsc[1536 + c], a2 = wsc[3072 + c], ab = bsc[c];
            const float b0 = wsc[512 + c], b1 = wsc[1536 + 512 + c], b2 = wsc[3072 + 512 + c], bb = bsc[512 + c];
            const float c0 = wsc[1024 + c], c1 = wsc[1536 + 1024 + c], c2 = wsc[3072 + 1024 + c], cb = bsc[1024 + c];
            for (int t = tid; t < 2048; t += 512) {
                x0f[t] = sconv(r0, t, a0, a1, a2, ab);
                zf[t] = sconv(r1, t, b0, b1, b2, bb) * sconv(r2, t, c0, c1, c2, cb);
            }
        }
        asum = wave_sum(asum);
        if (lane == 0) red[wave] = asum;
        __syncthreads();
        float kn = 0.f;
#pragma unroll
        for (int w = 0; w < 8; ++w) kn += red[w];
        const float ikn = 1.0f / kn, hb = hyb[c];
#pragma unroll
        for (int e = 0; e < 4; ++e) {
            const int t = tid + 512 * e; float acc = 0.f;
            for (int s = 0; s < 2048; ++s) acc += karr[t - s + 2048] * zf[s];
            const float y = x0f[t] * (acc * ikn + zf[t] * hb);
            yhyT[(size_t)c * M + b * 2048 + t] = (bf16_t)(cvt_pk_bf16(y, 0.f) & 0xffffu);
        }
    }
}


__device__ __forceinline__ void attn_mfma(int wv, KPC p, int layer, const bf16_t* QK, const bf16_t* UT, bf16_t* yna) {
    const float* rpb = p->in[8] + layer * 8 * 15 * 31;
    const int tid = fresh_tid(wv), bx = fresh_bx(), lane = tid & 63, qi = lane & 15, g = lane >> 4;
    for (int it = bx * 8 + wv; it < 8192; it += gridDim.x * 8) {
        const int h = it & 7, j = (it >> 3) & 3, r = (it >> 5) & 31, b = it >> 10;
        const int rs = min(max(r - 4, 0), 24), bc0 = min(max(16 * j - 8, 0), 32);
        const int qc = 16 * j + qi, qcs = min(max(qc - 8, 0), 48);
        const size_t qtok = (size_t)b * 2048 + r * 64 + qc;
        const bf16x8 qf0 = *(const bf16x8*)(QK + qtok * 1024 + 64 * h + 8 * g), qf1 = *(const bf16x8*)(QK + qtok * 1024 + 64 * h + 32 + 8 * g);
        f32x4 s[16];
#pragma unroll
        for (int T = 0; T < 16; ++T) {
            const size_t ktok = (size_t)b * 2048 + (rs + (T >> 1)) * 64 + bc0 + 16 * (T & 1) + qi;
            const bf16x8 k0 = *(const bf16x8*)(QK + ktok * 1024 + 512 + 64 * h + 8 * g), k1 = *(const bf16x8*)(QK + ktok * 1024 + 512 + 64 * h + 32 + 8 * g);
            f32x4 z = (f32x4){0.f, 0.f, 0.f, 0.f};
            z = __builtin_amdgcn_mfma_f32_16x16x32_bf16(k0, qf0, z, 0, 0, 0);
            z = __builtin_amdgcn_mfma_f32_16x16x32_bf16(k1, qf1, z, 0, 0, 0);
            s[T] = z;
        }
        float mx = -3.0e38f;
#pragma unroll
        for (int T = 0; T < 16; ++T)
#pragma unroll
            for (int e = 0; e < 4; ++e) {
                const int kc = bc0 + 16 * (T & 1) + 4 * g + e, kr = rs + (T >> 1);
                const bool valid = (kc >= qcs) && (kc < qcs + 16);
                float v = -3.0e38f;
                if (valid) v = s[T][e] + rpb[(h * 15 + kr - r + 7) * 31 + kc - qc + 15];
                s[T][e] = v; mx = fmaxf(mx, v);
            }
        mx = fmaxf(mx, __shfl_xor(mx, 16)); mx = fmaxf(mx, __shfl_xor(mx, 32));
        float ls = 0.f;
#pragma unroll
        for (int T = 0; T < 16; ++T)
#pragma unroll
            for (int e = 0; e < 4; ++e) { const float pe = __expf(s[T][e] - mx); s[T][e] = pe; ls += pe; }
        ls += __shfl_xor(ls, 16); ls += __shfl_xor(ls, 32);
        f32x4 o[4];
#pragma unroll
        for (int dt = 0; dt < 4; ++dt) o[dt] = (f32x4){0.f, 0.f, 0.f, 0.f};
#pragma unroll
        for (int kr = 0; kr < 8; ++kr) {
            const u32x4 pw = (u32x4){cvt_pk_bf16(s[2 * kr][0], s[2 * kr][1]), cvt_pk_bf16(s[2 * kr][2], s[2 * kr][3]), cvt_pk_bf16(s[2 * kr + 1][0], s[2 * kr + 1][1]), cvt_pk_bf16(s[2 * kr + 1][2], s[2 * kr + 1][3])};
            const bf16x8 pf = __builtin_bit_cast(bf16x8, pw);
#pragma unroll
            for (int dt = 0; dt < 4; ++dt) {
                const bf16_t* vp = UT + (size_t)(64 * h + 16 * dt + qi) * M + (size_t)b * 2048 + (rs + kr) * 64 + bc0 + 4 * g;
                const u32x2 v0 = *(const u32x2*)vp, v1 = *(const u32x2*)(vp + 16);
                const bf16x8 vf = __builtin_bit_cast(bf16x8, ((u32x4){v0.x, v0.y, v1.x, v1.y}));
                o[dt] = __builtin_amdgcn_mfma_f32_16x16x32_bf16(vf, pf, o[dt], 0, 0, 0);
            }
        }
        const float inv = 1.0f / ls;
#pragma unroll
        for (int dt = 0; dt < 4; ++dt)
            *(u32x2*)(yna + qtok * 512 + 64 * h + 16 * dt + 4 * g) = (u32x2){cvt_pk_bf16(o[dt][0] * inv, o[dt][1] * inv), cvt_pk_bf16(o[dt][2] * inv, o[dt][3] * inv)};
    }
}

__device__ __forceinline__ void conv_mfma(int wv, KPC p, int layer, LAS unsigned char* lds, const bf16_t* UT, const float* FT, bf16_t* yhyT) {
    constexpr int CPS = 8224, ZRS = 4112;
    LAS unsigned char* FC = lds; LAS unsigned char* ZT = lds + 8 * CPS; LAS float* red = (LAS float*)(ZT + 16 * ZRS);
    const float* wsc = p->in[9] + layer * 3 * 1536; const float* bsc = p->in[10] + layer * 1536; const float* hyb = p->in[19] + layer * 512;
    const int tid = fresh_tid(wv), bx = fresh_bx(), lane = tid & 63, i = lane & 15, g = lane >> 4;
    const int rho = (8 - (i & 7)) & 7;
    const int abase = rho * CPS + 2 * (2048 - i + 8 * g - rho) - 512 * wv;
    const int bbase = i * ZRS + 16 * g;
    for (int c = bx; c < 512; c += gridDim.x) {
        __syncthreads();
        float asum = 0.f;
#pragma unroll
        for (int k = 0; k < 8; ++k) {
            const int m = tid + 512 * k; float v;
            if (m == 0) v = 0.f; else if (m < 2048) v = FT[(size_t)c * SEQ + 2048 - m]; else if (m == 2048) v = FT[(size_t)c * SEQ] + FT[(size_t)(512 + c) * SEQ]; else v = FT[(size_t)(512 + c) * SEQ + m - 2048];
            asum += fabsf(v);
            const bf16_t vb = (bf16_t)(cvt_pk_bf16(v, 0.f) & 0xffffu);
#pragma unroll
            for (int r8 = 0; r8 < 8; ++r8) if (m - r8 >= 0) *(LAS bf16_t*)(FC + r8 * CPS + 2 * (m - r8)) = vb;
        }
        {
            const float a0 = wsc[c], a1 = wsc[1536 + c], a2 = wsc[3072 + c], ab = bsc[c];
            const float b0 = wsc[512 + c], b1 = wsc[1536 + 512 + c], b2 = wsc[3072 + 512 + c], bb = bsc[512 + c];
            const float c0 = wsc[1024 + c], c1 = wsc[1536 + 1024 + c], c2 = wsc[3072 + 1024 + c], cb = bsc[1024 + c];
#pragma unroll
            for (int k = 0; k < 4; ++k) {
                const int idx = tid + 512 * k, b = idx >> 8, t0 = (idx & 255) * 8;
                float x0v[8], zv[8];
#pragma unroll
                for (int rr = 0; rr < 3; ++rr) {
                    const bf16_t* row = UT + (size_t)(512 + 512 * rr + c) * M + (size_t)b * 2048;
                    const u32x4 w = *(const u32x4*)(row + t0);
                    float f[10];
                    f[0] = t0 > 0 ? bf2f(row[t0 - 1]) : 0.f; f[9] = t0 + 8 < SEQ ? bf2f(row[t0 + 8]) : 0.f;
                    f[1] = bf_lo(w.x); f[2] = bf_hi(w.x); f[3] = bf_lo(w.y); f[4] = bf_hi(w.y); f[5] = bf_lo(w.z); f[6] = bf_hi(w.z); f[7] = bf_lo(w.w); f[8] = bf_hi(w.w);
                    const float w0 = rr == 0 ? a0 : (rr == 1 ? b0 : c0), w1 = rr == 0 ? a1 : (rr == 1 ? b1 : c1), w2 = rr == 0 ? a2 : (rr == 1 ? b2 : c2), wb = rr == 0 ? ab : (rr == 1 ? bb : cb);
#pragma unroll
                    for (int e = 0; e < 8; ++e) {
                        const float v = f[e] * w0 + f[e + 1] * w1 + f[e + 2] * w2 + wb;
                        if (rr == 0) x0v[e] = v; else if (rr == 1) zv[e] = v; else zv[e] *= v;
                    }
                }
                *(LAS u32x4*)(ZT + b * ZRS + 2 * t0) = (u32x4){cvt_pk_bf16(zv[0], zv[1]), cvt_pk_bf16(zv[2], zv[3]), cvt_pk_bf16(zv[4], zv[5]), cvt_pk_bf16(zv[6], zv[7])};
                *(LAS u32x4*)(ZT + (8 + b) * ZRS + 2 * t0) = (u32x4){cvt_pk_bf16(x0v[0], x0v[1]), cvt_pk_bf16(x0v[2], x0v[3]), cvt_pk_bf16(x0v[4], x0v[5]), cvt_pk_bf16(x0v[6], x0v[7])};
            }
        }
        asum = wave_sum(asum);
        if (lane == 0) red[wv] = asum;
        __syncthreads();
        float kn = 0.f;
#pragma unroll
        for (int w = 0; w < 8; ++w) kn += red[w];
        bf16x8 ring[16]; f32x4 acc[16];
#pragma unroll
        for (int tau = 0; tau < 16; ++tau) { ring[tau] = *(const LAS bf16x8*)(FC + abase - 32 * tau); acc[tau] = (f32x4){0.f, 0.f, 0.f, 0.f}; }
        bf16x8 bcur = *(const LAS bf16x8*)(ZT + bbase);
        for (int s8 = 0; s8 < 8; ++s8) {
#pragma unroll
            for (int sp = 0; sp < 8; ++sp) {
                const int sn = min(8 * s8 + sp + 1, 63);
                const bf16x8 bnext = *(const LAS bf16x8*)(ZT + bbase + 64 * sn);
                const bf16x8 n0 = *(const LAS bf16x8*)(FC + abase + 64 * sn), n1 = *(const LAS bf16x8*)(FC + abase + 64 * sn - 32);
#pragma unroll
                for (int tau = 0; tau < 16; ++tau) acc[tau] = __builtin_amdgcn_mfma_f32_16x16x32_bf16(ring[(tau - 2 * sp) & 15], bcur, acc[tau], 0, 0, 0);
                ring[(0 - 2 * (sp + 1)) & 15] = n0; ring[(1 - 2 * (sp + 1)) & 15] = n1;
                bcur = bnext;
            }
        }
        if (i < 8) {
            const float ikn = 1.0f / kn, hb = hyb[c];
#pragma unroll
            for (int tau = 0; tau < 16; ++tau) {
                const int t = 256 * wv + 16 * tau + 4 * g;
                const u32x2 zz = *(const LAS u32x2*)(ZT + i * ZRS + 2 * t), xx = *(const LAS u32x2*)(ZT + (8 + i) * ZRS + 2 * t);
                const float y0 = bf_lo(xx.x) * (acc[tau][0] * ikn + bf_lo(zz.x) * hb), y1 = bf_hi(xx.x) * (acc[tau][1] * ikn + bf_hi(zz.x) * hb);
                const float y2 = bf_lo(xx.y) * (acc[tau][2] * ikn + bf_lo(zz.y) * hb), y3 = bf_hi(xx.y) * (acc[tau][3] * ikn + bf_hi(zz.y) * hb);
                *(u32x2*)(yhyT + (size_t)c * M + (size_t)i * 2048 + t) = (u32x2){cvt_pk_bf16(y0, y1), cvt_pk_bf16(y2, y3)};
            }
        }
    }
}

__device__ __forceinline__ void post_pass(int wv, LAS unsigned char* lds, const bf16_t* yna, const bf16_t* yhyT, bf16_t* yn) {
    LAS bf16_t* tile = (LAS bf16_t*)lds;
    const int tid = fresh_tid(wv), bx = fresh_bx(), lane = tid & 63, wave = tid >> 6;
    for (int it = bx; it < M / 32; it += gridDim.x) {
        const int tok0 = it * 32;
        __syncthreads();
        {
            const u32x4* src = (const u32x4*)(yhyT + (size_t)tid * M + tok0);
#pragma unroll
            for (int j = 0; j < 4; ++j) {
                const u32x4 v = src[j];
                tile[(8 * j + 0) * 520 + tid] = (bf16_t)(v.x & 0xffffu); tile[(8 * j + 1) * 520 + tid] = (bf16_t)(v.x >> 16);
                tile[(8 * j + 2) * 520 + tid] = (bf16_t)(v.y & 0xffffu); tile[(8 * j + 3) * 520 + tid] = (bf16_t)(v.y >> 16);
                tile[(8 * j + 4) * 520 + tid] = (bf16_t)(v.z & 0xffffu); tile[(8 * j + 5) * 520 + tid] = (bf16_t)(v.z >> 16);
                tile[(8 * j + 6) * 520 + tid] = (bf16_t)(v.w & 0xffffu); tile[(8 * j + 7) * 520 + tid] = (bf16_t)(v.w >> 16);
            }
        }
        __syncthreads();
#pragma unroll
        for (int q = 0; q < 4; ++q) {
            const int tk = 4 * wave + q; const size_t tok = (size_t)tok0 + tk;
#pragma unroll
            for (int half = 0; half < 2; ++half) {
                u32x4 v;
                if (half == 0) v = *(const u32x4*)(yna + tok * 512 + 8 * lane); else v = *(const LAS u32x4*)(tile + tk * 520 + 8 * lane);
                float f[8] = {bf_lo(v.x), bf_hi(v.x), bf_lo(v.y), bf_hi(v.y), bf_lo(v.z), bf_hi(v.z), bf_lo(v.w), bf_hi(v.w)};
                float s = 0.f;
#pragma unroll
                for (int e = 0; e < 8; ++e) s += f[e] * f[e];
                s = wave_sum(s);
                const float rs = rstd_of(s, 1.0f / 512.0f);
                *(u32x4*)(yn + tok * 1024 + half * 512 + 8 * lane) = (u32x4){cvt_pk_bf16(f[0] * rs, f[1] * rs), cvt_pk_bf16(f[2] * rs, f[3] * rs), cvt_pk_bf16(f[4] * rs, f[5] * rs), cvt_pk_bf16(f[6] * rs, f[7] * rs)};
            }
        }
    }
}

__global__ void __launch_bounds__(512, 2) hybrid_fwd(KP kparams_unused) {
    extern __shared__ __attribute__((aligned(16))) unsigned char lds_raw[];
    LAS unsigned char* lds = (LAS unsigned char*)lds_raw;
    cg::grid_group grid = cg::this_grid();
    const int wv = __builtin_amdgcn_readfirstlane((int)(threadIdx.x >> 6));
#define WSV() KPC p = KPARAMS(); unsigned char* ws = p->ws; float* ss = (float*)(ws + WS_CTL) + (size_t)(4 * layer) * M;   \
    bf16_t* xb = (bf16_t*)(ws + WS_XB); bf16_t* Hb = (bf16_t*)(ws + WS_R1); bf16_t* QK = (bf16_t*)(ws + WS_R1); bf16_t* UT = (bf16_t*)(ws + WS_R1 + 32 * MiB); \
    bf16_t* yna = (bf16_t*)(ws + WS_R2); bf16_t* yhyT = (bf16_t*)(ws + WS_R2 + 16 * MiB); bf16_t* yn = (bf16_t*)(ws + WS_R2 + 32 * MiB); float* PP = (float*)(ws + WS_R2); \
    bf16_t* pb = (bf16_t*)(ws + WS_PB); const float* FT = (const float*)(ws + WS_FT); unsigned char* Wb = ws + WS_W; float* X = p->out; \
    (void)ss; (void)xb; (void)Hb; (void)QK; (void)UT; (void)yna; (void)yhyT; (void)yn; (void)PP; (void)pb; (void)FT; (void)Wb; (void)X;

    { const int t0_ = fresh_tid(wv); if (t0_ < 4) ((volatile LAS unsigned*)(lds + LDS_BYTES - 16))[t0_] = 0u; __syncthreads(); }
    XcdBarrier xbar;
    { KPC p = KPARAMS(); xbar = xcd_barrier_post((unsigned*)(p->ws + WS_CTL + BAR_OFF), (volatile LAS unsigned*)(lds + LDS_BYTES - 16), wv); }
#define GSYNC() do { for (int rs_ = 0; rs_ < R_SYNC; ++rs_) xcd_barrier(xbar, wv); } while (0)
    for (int layer = 0; layer < 2; ++layer) {
#ifndef NO_PRO
        for (int rep_ = 0; rep_ < R_PRO; ++rep_) { WSV(); layer_prologue(wv, p, layer, lds); __syncthreads(); }
#endif
        if (layer == 0) grid.sync(); else GSYNC();
        for (int rep_ = 0; rep_ < R_UP; ++rep_) { WSV(); gemm_run(wv, lds, xb, (const bf16_t*)(Wb + W_GUA), M, 2 * FF, D, EpiSwiGLU{Hb, ss}); }
        GSYNC();
        { WSV(); gemm_run(wv, lds, Hb, (const bf16_t*)(Wb + W_DA), M, D, FF, EpiResid{layer == 0 ? p->in[0] : X, X, xb, ss + M, 0.5f}); }
        GSYNC();
        { WSV(); gemm_run(wv, lds, (const bf16_t*)(Wb + W_IN) + (size_t)1024 * D, xb, 2048, M, D, EpiScaleCol{UT, M, ss + M}); }
        { WSV(); gemm_run(wv, lds, xb, (const bf16_t*)(Wb + W_IN), M, 1024, D, EpiScaleRow{QK, 1024, ss + M}); }
        GSYNC();
#ifndef NO_ATTN
#if NAIVE_ATTN
        { WSV(); attn_naive(wv, p, layer, QK, UT, yna); }
#else
        for (int rep_ = 0; rep_ < R_ATTN; ++rep_) { WSV(); attn_mfma(wv, p, layer, QK, UT, yna); }
#endif
#endif
#ifndef NO_CONV
#if NAIVE_CONV
        { WSV(); conv_naive(wv, p, layer, lds, UT, FT, yhyT); }
#else
        for (int rep_ = 0; rep_ < R_CONV; ++rep_) { WSV(); conv_mfma(wv, p, layer, lds, UT, FT, yhyT); }
#endif
#endif
        GSYNC();
#ifndef NO_POST
        for (int rep_ = 0; rep_ < R_POST; ++rep_) { WSV(); post_pass(wv, lds, yna, yhyT, yn); }
#endif
        GSYNC();
        { WSV(); gemm_run(wv, lds, yn, (const bf16_t*)(Wb + W_OUT), M, D, D, EpiResid{X, X, xb, ss + 2 * M, 1.0f}); }
        GSYNC();
        { WSV(); gemm_run(wv, lds, pb + (size_t)layer * M * PLE, (const bf16_t*)(Wb + W_PP), M, D, PLE, EpiStoreF32{PP, D}); }
        { WSV(); gemm_run(wv, lds, xb, (const bf16_t*)(Wb + W_GUB), M, 2 * FF, D, EpiSwiGLU{Hb, ss + 2 * M}); }
        GSYNC();
        { WSV(); gemm_run(wv, lds, Hb, (const bf16_t*)(Wb + W_DB), M, D, FF, EpiResid{X, X, xb, ss + 3 * M, 0.5f}); }
        GSYNC();
        { WSV(); gemm_run(wv, lds, xb, (const bf16_t*)(Wb + W_PG), M, D, D, EpiPle{X, PP, ss + 3 * M, xb, ss + 4 * M}); }
        GSYNC();
    }
    {
        const int layer = 2; WSV();
        const int tid = fresh_tid(wv), bx = fresh_bx(), lane = tid & 63, wave = tid >> 6;
        const float* gf = p->in[29];
        for (int m = bx * 8 + wave; m < M; m += gridDim.x * 8) {
            const float rs = rstd_of(ss[m], 1.0f / D);
            f32x4* xr = (f32x4*)(X + (size_t)m * D) + lane; const f32x4* gr = (const f32x4*)gf + lane;
#pragma unroll
            for (int j = 0; j < 4; ++j) { f32x4 v = xr[64 * j]; const f32x4 g = gr[64 * j]; v = v * rs * g; xr[64 * j] = v; }
        }
    }
}

extern "C" void kernel_launch(void* const* d_in, const int* in_sizes, int n_in, void* d_out, int out_size, void* d_ws, size_t ws_size, hipStream_t stream) {
    static int grid = 0;
    if (grid == 0) {
        if (n_in != 30 || out_size != M * D || ws_size < WS_END) { fprintf(stderr, "kernel_launch: unexpected shapes: n_in %d out %d ws %zu (need %zu)\n", n_in, out_size, ws_size, (size_t)WS_END); grid = -1; return; }
        int dev = 0, cus = 0, per_cu = 0;
        hipGetDevice(&dev);
        hipDeviceGetAttribute(&cus, hipDeviceAttributeMultiprocessorCount, dev);
        if (hipFuncSetAttribute((const void*)hybrid_fwd, hipFuncAttributeMaxDynamicSharedMemorySize, LDS_BYTES) != hipSuccess) { fprintf(stderr, "kernel_launch: hipFuncSetAttribute failed\n"); }
        if (hipOccupancyMaxActiveBlocksPerMultiprocessor(&per_cu, (const void*)hybrid_fwd, 512, LDS_BYTES) != hipSuccess || per_cu < 1) { fprintf(stderr, "kernel_launch: occupancy query says %d\n", per_cu); per_cu = 1; }
        (void)hipGetLastError();
        grid = cus * per_cu;
        fprintf(stderr, "kernel_launch: grid %d (cus %d x %d)\n", grid, cus, per_cu);
    }
    if (grid < 0) return;
    (void)hipMemsetAsync((char*)d_ws + WS_CTL, 0, 1 * MiB, stream);
    KP hp{};
    for (int i = 0; i < 30; ++i) hp.in[i] = (const float*)d_in[i];
    hp.out = (float*)d_out; hp.ws = (unsigned char*)d_ws;
    void* args[] = {&hp};
    hipError_t e = hipLaunchCooperativeKernel((const void*)hybrid_fwd, dim3(grid), dim3(512), args, LDS_BYTES, stream);
    if (e != hipSuccess) fprintf(stderr, "kernel_launch: cooperative launch failed: %s (grid %d)\n", hipGetErrorString(e), grid);
}
```

```cpp
#include <hip/hip_runtime.h>
#include <hip/hip_cooperative_groups.h>
#include <cstdio>
#include <cstdint>
namespace cg = cooperative_groups;
namespace pg8 {
#define PG8_LAS __attribute__((address_space(3)))
typedef unsigned short bf16_t;
typedef short bf16x8 __attribute__((ext_vector_type(8)));
typedef float f32x4 __attribute__((ext_vector_type(4)));
typedef unsigned u32x4 __attribute__((ext_vector_type(4)));
constexpr int BM = 256, BK = 64, HALF = 128, HTB = HALF * BK * 2  , STAGE_BYTES = 8 * HTB, NXCD = 8, WGM = 8;

__host__ __device__ __forceinline__ int lds_byte(int r, int c) { const int st = (r >> 4) * 2 + (c >> 5), rr = r & 15, cc = c & 31, ob = rr * 64 + cc * 2; return st * 1024 + (ob ^ (((ob >> 9) & 1) << 5)); }
__host__ __device__ __forceinline__ void stage_rc(int b, int& R, int& C) { const int st = b / 1024, sb = b % 1024, swz = sb ^ (((sb >> 9) & 1) << 5); R = (st >> 1) * 16 + swz / 64; C = (st & 1) * 32 + (swz % 64) / 2; }
__host__ __device__ __forceinline__ int perm32(int rho) { const int n = rho >> 4, i = rho & 15; return 8 * (i >> 2) + 4 * n + (i & 3); }

struct Unit { int pm, pn; };
struct Gemm { const bf16_t* A; const bf16_t* Bt; int M, N, K; };

struct StaticOrder {
    int nM, nN, nwg, G, c;
    __host__ __device__ void init(int M, int N, int G_, int c_) { nM = M / BM; nN = N / BM; nwg = nM * nN; G = G_; c = c_; }
    __host__ __device__ bool next(int i, Unit& u) const {
        const long L = (long)i * G + c; if (L >= nwg) return false;
        int wgid = (int)L; { const int q = nwg / NXCD, r = nwg % NXCD, xcd = wgid % NXCD, off = wgid / NXCD; wgid = (xcd < r ? xcd * (q + 1) : r * (q + 1) + (xcd - r) * q) + off; }
        const int nig = WGM * nN, gid = wgid / nig, fm = gid * WGM, gsz = (nM - fm) < WGM ? (nM - fm) : WGM;
        u.pm = fm + ((wgid % nig) % gsz); u.pn = (wgid % nig) / gsz; return true;
    }
    __device__ __forceinline__ void a_ready(const Unit&) const {}
    __device__ __forceinline__ void done(const Unit&) const {}
};

template <class Epi, class Sched, bool ALIGN_EPI = false, bool SP2 = false>
__device__ __forceinline__ void gemm_phase(PG8_LAS unsigned char* lds, const Gemm g, const Sched& S, const Epi& E, int tid_in) {
    int tid_ = tid_in; asm volatile("" : "+v"(tid_)); const int tid = tid_, wid = __builtin_amdgcn_readfirstlane(tid >> 6), lane = tid & 63, wr = wid >> 2, wc = wid & 3, fr = lane & 15, fq = lane >> 4;
    const int K = g.K, nt = K / BK;
    unsigned voffA[2], voffB[2];
#pragma unroll
    for (int i = 0; i < 2; ++i) { int R, C; stage_rc(tid * 16 + i * 8192, R, C); const int Rb = Epi::PERM ? ((R & ~31) + perm32(R & 31)) : R;
        voffA[i] = (unsigned)(R * K + C) * 2u; voffB[i] = (unsigned)(Rb * K + C) * 2u; }
    const size_t kstep = (size_t)(BK * 2);
    const size_t hstep = (size_t)HALF * K * 2;
    const size_t tstep = 2 * hstep;
    const unsigned ldsw = (unsigned)wid * 1024u;
    const int aoff = lds_byte(wr * 64 + fr, fq * 8), boff = lds_byte(wc * 32 + fr, fq * 8);
#define PG8_SA(b, h) (((b) * 2 + (h)) * HTB)
#define PG8_SB(b, h) ((4 + (b) * 2 + (h)) * HTB)
#define PG8_STAGE(bufoff, gbase, voff) do { _Pragma("unroll") for (int _i = 0; _i < 2; ++_i) \
        __builtin_amdgcn_global_load_lds((const unsigned*)((const char*)(gbase) + (voff)[_i]), (PG8_LAS unsigned*)(lds + (bufoff) + ldsw + _i * 8192), 16, 0, 0); } while (0)
#define PG8_LDA(dst, b, h) do { _Pragma("unroll") for (int m = 0; m < 4; ++m) _Pragma("unroll") for (int k = 0; k < 2; ++k) dst[m][k] = *(const PG8_LAS bf16x8*)(lds + PG8_SA(b, h) + aoff + m * 2048 + k * 1024); } while (0)
#define PG8_LDB(dst, b, h) do { _Pragma("unroll") for (int n = 0; n < 2; ++n) _Pragma("unroll") for (int k = 0; k < 2; ++k) dst[n][k] = *(const PG8_LAS bf16x8*)(lds + PG8_SB(b, h) + boff + n * 2048 + k * 1024); } while (0)
#define PG8_MMA(ai, bj, At, Bt) do { __builtin_amdgcn_s_setprio(1); _Pragma("unroll") for (int m = 0; m < 4; ++m) _Pragma("unroll") for (int n = 0; n < 2; ++n) _Pragma("unroll") for (int k = 0; k < 2; ++k) \
        acc[ai][bj][m][n] = __builtin_amdgcn_mfma_f32_16x16x32_bf16(Bt[n][k], At[m][k], acc[ai][bj][m][n], 0, 0, 0); __builtin_amdgcn_s_setprio(0); } while (0)
#define PG8_WAIT_V(n) asm volatile("s_waitcnt vmcnt(" #n ")" ::: "memory")
#define PG8_WAIT_L(n) asm volatile("s_waitcnt lgkmcnt(" #n ")" ::: "memory")
#define PG8_BAR __builtin_amdgcn_s_barrier()
#define PG8_SCHED __builtin_amdgcn_sched_barrier(0)
    Unit cur, nxt; int ui = 0;
    if (!S.next(0, cur)) return;
    f32x4 acc[2][2][4][2];
#pragma unroll
    for (int a = 0; a < 2; ++a)
#pragma unroll
        for (int b = 0; b < 2; ++b)
#pragma unroll
            for (int m = 0; m < 4; ++m)
#pragma unroll
                for (int n = 0; n < 2; ++n) acc[a][b][m][n] = (f32x4){0.f, 0.f, 0.f, 0.f};
    bf16x8 At[4][2], B0[2][2], B1[2][2];
    const char* cA = (const char*)g.A + (size_t)cur.pm * tstep; const char* cB = (const char*)g.Bt + (size_t)cur.pn * tstep;
    S.a_ready(cur);
    if constexpr (SP2) {
        PG8_STAGE(PG8_SB(0, 0), cB, voffB); PG8_STAGE(PG8_SB(0, 1), cB + hstep, voffB); PG8_STAGE(PG8_SA(0, 0), cA, voffA); PG8_STAGE(PG8_SA(0, 1), cA + hstep, voffA);
        if (wr == 1) PG8_BAR;
        PG8_WAIT_V(2); PG8_BAR;
        PG8_STAGE(PG8_SB(1, 0), cB + kstep, voffB); PG8_STAGE(PG8_SA(1, 0), cA + kstep, voffA); PG8_STAGE(PG8_SB(1, 1), cB + hstep + kstep, voffB);
        PG8_WAIT_V(6); PG8_BAR;
    } else {
        PG8_STAGE(PG8_SB(0, 0), cB, voffB); PG8_STAGE(PG8_SA(0, 0), cA, voffA); PG8_STAGE(PG8_SB(0, 1), cB + hstep, voffB); PG8_STAGE(PG8_SA(0, 1), cA + hstep, voffA);
        if (wr == 1) PG8_BAR;
        PG8_WAIT_V(4); PG8_BAR;
        PG8_STAGE(PG8_SB(1, 0), cB + kstep, voffB); PG8_STAGE(PG8_SA(1, 0), cA + kstep, voffA); PG8_STAGE(PG8_SB(1, 1), cB + hstep + kstep, voffB);
        PG8_WAIT_V(6); PG8_BAR;
    }
    for (;;) {
        const bool has_next = S.next(ui + 1, nxt);
        const char* nA = has_next ? (const char*)g.A + (size_t)nxt.pm * tstep : cA; const char* nB = has_next ? (const char*)g.Bt + (size_t)nxt.pn * tstep : cB;
        for (int t = 0; t < nt; t += 2) {
            const bool last = (t == nt - 2);
            const char* a1 = cA + (size_t)(t + 1) * kstep;
            const char* a2 = last ? nA : cA + (size_t)(t + 2) * kstep; const char* b2 = last ? nB : cB + (size_t)(t + 2) * kstep;
            const char* a3 = a2 + kstep; const char* b3 = b2 + kstep;
            if (last && has_next) S.a_ready(nxt);
            if constexpr (SP2) {
            PG8_LDB(B0, 0, 0); PG8_LDB(B1, 0, 1); PG8_SCHED; PG8_LDA(At, 0, 0); PG8_STAGE(PG8_SA(1, 1), a1 + hstep, voffA);
            PG8_WAIT_V(8); PG8_WAIT_L(0); PG8_BAR; PG8_MMA(0, 0, At, B0); PG8_MMA(0, 1, At, B1); PG8_BAR; PG8_SCHED;
            PG8_LDA(At, 0, 1); PG8_STAGE(PG8_SB(0, 0), b2, voffB); PG8_STAGE(PG8_SB(0, 1), b2 + hstep, voffB); PG8_STAGE(PG8_SA(0, 0), a2, voffA);
            PG8_WAIT_V(8); PG8_WAIT_L(0); PG8_BAR; PG8_MMA(1, 0, At, B0); PG8_MMA(1, 1, At, B1); PG8_BAR; PG8_SCHED;
            PG8_LDB(B0, 1, 0); PG8_LDB(B1, 1, 1); PG8_SCHED; PG8_LDA(At, 1, 0); PG8_STAGE(PG8_SA(0, 1), a2 + hstep, voffA);
            PG8_WAIT_V(8); PG8_WAIT_L(0); PG8_BAR; PG8_MMA(0, 0, At, B0); PG8_MMA(0, 1, At, B1); PG8_BAR; PG8_SCHED;
            PG8_LDA(At, 1, 1); PG8_STAGE(PG8_SB(1, 0), b3, voffB); PG8_STAGE(PG8_SB(1, 1), b3 + hstep, voffB); PG8_STAGE(PG8_SA(1, 0), a3, voffA);
            PG8_WAIT_V(8); PG8_WAIT_L(0); PG8_BAR; PG8_MMA(1, 0, At, B0); PG8_MMA(1, 1, At, B1); PG8_BAR; PG8_SCHED;
            } else {
            PG8_LDB(B0, 0, 0); PG8_SCHED; PG8_LDA(At, 0, 0); PG8_STAGE(PG8_SA(1, 1), a1 + hstep, voffA);
            PG8_WAIT_L(8); PG8_BAR; PG8_WAIT_L(0); PG8_MMA(0, 0, At, B0); PG8_BAR; PG8_SCHED;
            PG8_LDB(B1, 0, 1); PG8_STAGE(PG8_SB(0, 0), b2, voffB);
            PG8_BAR; PG8_WAIT_L(0); PG8_MMA(0, 1, At, B1); PG8_BAR;
            PG8_LDA(At, 0, 1); PG8_STAGE(PG8_SA(0, 0), a2, voffA);
            PG8_BAR; PG8_WAIT_L(0); PG8_MMA(1, 0, At, B0); PG8_BAR; PG8_SCHED;
            PG8_STAGE(PG8_SB(0, 1), b2 + hstep, voffB);
            PG8_WAIT_V(6); PG8_BAR; PG8_MMA(1, 1, At, B1); PG8_BAR;
            PG8_LDB(B0, 1, 0); PG8_SCHED; PG8_LDA(At, 1, 0); PG8_STAGE(PG8_SA(0, 1), a2 + hstep, voffA);
            PG8_WAIT_L(8); PG8_BAR; PG8_WAIT_L(0); PG8_MMA(0, 0, At, B0); PG8_BAR; PG8_SCHED;
            PG8_LDB(B1, 1, 1); PG8_STAGE(PG8_SB(1, 0), b3, voffB);
            PG8_BAR; PG8_WAIT_L(0); PG8_MMA(0, 1, At, B1); PG8_BAR;
            PG8_LDA(At, 1, 1); PG8_STAGE(PG8_SA(1, 0), a3, voffA);
            PG8_BAR; PG8_WAIT_L(0); PG8_MMA(1, 0, At, B0); PG8_BAR; PG8_SCHED;
            PG8_STAGE(PG8_SB(1, 1), b3 + hstep, voffB);
            PG8_WAIT_V(6); PG8_BAR; PG8_MMA(1, 1, At, B1); PG8_BAR;
            }
        }
        if constexpr (ALIGN_EPI) { if (wr == 0) PG8_BAR; }
        if constexpr (!Epi::AFTER_DRAIN) { E(acc, cur, wr, wc, fr, fq); S.done(cur); }
        if (!has_next) break;
#pragma unroll
        for (int a = 0; a < 2; ++a)
#pragma unroll
            for (int b = 0; b < 2; ++b)
#pragma unroll
                for (int m = 0; m < 4; ++m)
#pragma unroll
                    for (int n = 0; n < 2; ++n) acc[a][b][m][n] = (f32x4){0.f, 0.f, 0.f, 0.f};
        cur = nxt; cA = nA; cB = nB; ++ui;
        if constexpr (ALIGN_EPI) { if (wr == 1) PG8_BAR; }
    }
    PG8_WAIT_V(0);
    if constexpr (!ALIGN_EPI) { if (wr == 0) PG8_BAR; }
    PG8_BAR;
    if constexpr (Epi::AFTER_DRAIN) { E.fused(acc, cur, wr, wc, fr, fq, lds, wid, lane); S.done(cur); }
#undef PG8_SA
#undef PG8_SB
#undef PG8_STAGE
#undef PG8_LDA
#undef PG8_LDB
#undef PG8_MMA
#undef PG8_WAIT_V
#undef PG8_WAIT_L
#undef PG8_BAR
#undef PG8_SCHED
}
}
using pg8::bf16_t; using pg8::bf16x8; using pg8::f32x4; using pg8::u32x4; using pg8::Unit; using pg8::Gemm; using pg8::StaticOrder;
typedef float f32x2 __attribute__((ext_vector_type(2)));
typedef unsigned u32x2 __attribute__((ext_vector_type(2)));
#define LAS __attribute__((address_space(3)))

#ifndef NAIVE_GEMM
#define NAIVE_GEMM 0
#endif
#ifndef R_PRO
#define R_PRO 1
#endif
#ifndef R_ATTN
#define R_ATTN 1
#endif
#ifndef R_CONV
#define R_CONV 1
#endif
#ifndef R_SYNC
#define R_SYNC 1
#endif
#ifndef R_UP
#define R_UP 1
#endif
#ifndef R_POST
#define R_POST 1
#endif
#ifndef NAIVE_ATTN
#define NAIVE_ATTN 0
#endif
#ifndef NAIVE_CONV
#define NAIVE_CONV 0
#endif

constexpr int M = 16384, D = 1024, FF = 2816, SEQ = 2048, HC = 512, PLE = 256;
constexpr float EPS = 1e-6f;
constexpr size_t MiB = 1u << 20;
constexpr size_t WS_CTL = 0, WS_W = 1 * MiB, WS_FT = 45 * MiB, WS_PB = 53 * MiB, WS_XB = 69 * MiB, WS_R1 = 101 * MiB, WS_R2 = 197 * MiB, WS_END = 261 * MiB;
constexpr size_t W_GUA = 0, W_DA = 11 * MiB, W_IN = W_DA + 5767168, W_OUT = W_IN + 6 * MiB, W_GUB = W_OUT + 2 * MiB, W_DB = W_GUB + 11 * MiB, W_PG = W_DB + 5767168, W_PP = W_PG + 2 * MiB;
static_assert(W_PP + 512 * 1024 <= 44 * MiB, "weights");
constexpr int LDS_BYTES = 131072 + 4096;
constexpr size_t BAR_OFF = 640 * 1024;

struct KP { const float* in[30]; float* out; unsigned char* ws; };
typedef const __attribute__((address_space(4))) KP* KPC;
#define KPARAMS() ({ KPC q_ = (KPC)__builtin_amdgcn_kernarg_segment_ptr(); asm volatile("" : "+s"(q_)); q_; })

__device__ __forceinline__ unsigned cvt_pk_bf16(float lo, float hi) { unsigned r; asm volatile("v_cvt_pk_bf16_f32 %0, %1, %2" : "=v"(r) : "v"(lo), "v"(hi)); return r; }
__device__ __forceinline__ float bf_lo(unsigned w) { return __uint_as_float(w << 16); }
__device__ __forceinline__ float bf_hi(unsigned w) { return __uint_as_float(w & 0xffff0000u); }
__device__ __forceinline__ float bf2f(bf16_t b) { return __uint_as_float(((unsigned)b) << 16); }
__device__ __forceinline__ float wave_sum(float v) {
#pragma unroll
    for (int o = 1; o < 64; o <<= 1) v += __shfl_xor(v, o);
    return v;
}
__device__ __forceinline__ int fresh_tid(int wv) {
    int l; asm volatile("v_mbcnt_lo_u32_b32 %0, -1, 0\n\tv_mbcnt_hi_u32_b32 %0, -1, %0" : "=v"(l));
    return wv * 64 + l;
}
__device__ __forceinline__ int fresh_bx() { int b = blockIdx.x; asm volatile("" : "+s"(b)); return b; }
#define XB_TMO      128
#define XB_XCNT(j)  (256  + 64 * (j))
#define XB_XSUB(j)  (1280 + 64 * (j))
#define XB_XGEN(j)  (2304 + 64 * (j))
#define XB_TOP      3328
#define XB_TOPGEN   3392
#define XCD_BAR_WORDS 3456
#define XB_SPIN_CAP (1u << 18)

__device__ __forceinline__ unsigned xb_ld(unsigned* p)              { return __hip_atomic_load(p, __ATOMIC_RELAXED, __HIP_MEMORY_SCOPE_AGENT); }
__device__ __forceinline__ unsigned xb_add(unsigned* p, unsigned v) { return __hip_atomic_fetch_add(p, v, __ATOMIC_RELAXED, __HIP_MEMORY_SCOPE_AGENT); }
__device__ __forceinline__ unsigned xb_xcc_id() { return (unsigned)__builtin_amdgcn_s_getreg((3 << 11) | 20) & 0xFu; }
#define XB_SPIN(cond, bar) do { unsigned _sp = 0; while (cond) { __builtin_amdgcn_s_sleep(1); \
    if ((++_sp & 255u) == 0u) { if (xb_ld(&(bar)[XB_TMO])) break; if (_sp > XB_SPIN_CAP) { atomicAdd(&(bar)[XB_TMO], 1u); break; } } } } while (0)

struct XcdBarrier {
    unsigned* bar; unsigned x;
    volatile LAS unsigned* st;
};

__device__ __forceinline__ XcdBarrier xcd_barrier_post(unsigned* bar, volatile LAS unsigned* st, int wv) {
    XcdBarrier b; b.bar = bar; b.x = xb_xcc_id(); b.st = st;
    if (fresh_tid(wv) == 0) (void)xb_add(&bar[XB_XCNT(b.x)], 1u);
    return b;
}
__device__ __forceinline__ void xcd_barrier_complete(unsigned* bar, unsigned x, unsigned& nloc, unsigned& nx) {
    const unsigned G = gridDim.x * gridDim.y * gridDim.z;
    unsigned sum, cnt, mine, sp = 0u;
    for (;;) {
        sum = 0u; cnt = 0u; mine = 0u;
#pragma unroll
        for (unsigned j = 0; j < 16; ++j) { const unsigned c = xb_ld(&bar[XB_XCNT(j)]); sum += c; cnt += (c > 0u) ? 1u : 0u; mine = (j == x) ? c : mine; }
        if (sum == G) break;
        __builtin_amdgcn_s_sleep(1);
        if ((++sp & 255u) == 0u) { if (xb_ld(&bar[XB_TMO])) break; if (sp > XB_SPIN_CAP) { atomicAdd(&bar[XB_TMO], 1u); break; } }
    }
    nloc = mine > 0u ? mine : 1u; nx = cnt > 0u ? cnt : 1u;
}

__device__ __forceinline__ void xcd_barrier(const XcdBarrier& b, int wv) {
    asm volatile("s_waitcnt vmcnt(0)" ::: "memory");
    __syncthreads();
    if (fresh_tid(wv) == 0) {
        unsigned* bar = b.bar;
        __builtin_amdgcn_s_waitcnt(0);
        unsigned nloc = b.st[0], nx = b.st[1];
        if (nloc == 0u) { xcd_barrier_complete(bar, b.x, nloc, nx); b.st[0] = nloc; b.st[1] = nx; }
        const unsigned old = xb_add(&bar[XB_XSUB(b.x)], 1u);
        const unsigned gen = old / nloc;
        if (old + 1u == (gen + 1u) * nloc) {
            __builtin_amdgcn_fence(__ATOMIC_RELEASE, "agent");
            asm volatile("s_waitcnt vmcnt(0)" ::: "memory");
            const unsigned og = xb_add(&bar[XB_TOP], 1u);
            const unsigned tg = og / nx;
            if (og + 1u == (tg + 1u) * nx) xb_add(&bar[XB_TOPGEN], 1u);
            else XB_SPIN(xb_ld(&bar[XB_TOPGEN]) == tg, bar);
            __builtin_amdgcn_fence(__ATOMIC_ACQUIRE, "agent");
            xb_add(&bar[XB_XGEN(b.x)], 1u);
            asm volatile("s_waitcnt vmcnt(0)" ::: "memory");
        } else {
            XB_SPIN(xb_ld(&bar[XB_XGEN(b.x)]) == gen, bar);
            __builtin_amdgcn_fence(__ATOMIC_ACQUIRE, "agent");
            asm volatile("s_waitcnt vmcnt(0)" ::: "memory");
        }
    }
    __syncthreads();
}

__device__ __forceinline__ float rstd_of(float ss, float invn) { return rsqrtf(ss * invn + EPS); }

struct EpiSwiGLU {
    static constexpr bool PERM = true, AFTER_DRAIN = false;
    bf16_t* H; const float* ss;
    __device__ __forceinline__ void operator()(const f32x4 (&acc)[2][2][4][2], const Unit& u, int wr, int wc, int fr, int fq) const {
        const int row0 = u.pm * 256 + wr * 64 + fr, col0 = u.pn * 128 + wc * 32 + 8 * fq;
#pragma unroll
        for (int ai = 0; ai < 2; ++ai)
#pragma unroll
            for (int m = 0; m < 4; ++m) {
                const int row = row0 + ai * 128 + m * 16;
                const float rs = rstd_of(ss[row], 1.0f / D);
                unsigned w[4];
#pragma unroll
                for (int n = 0; n < 2; ++n) {
                    float hv[4];
#pragma unroll
                    for (int e = 0; e < 4; ++e) {
                        const float g = acc[ai][0][m][n][e] * rs, uu = acc[ai][1][m][n][e] * rs;
                        hv[e] = g * __builtin_amdgcn_rcpf(1.0f + __expf(-g)) * uu;
                    }
                    w[2 * n] = cvt_pk_bf16(hv[0], hv[1]); w[2 * n + 1] = cvt_pk_bf16(hv[2], hv[3]);
                }
                *(u32x4*)(H + (size_t)row * FF + col0) = (u32x4){w[0], w[1], w[2], w[3]};
            }
    }
};
struct EpiResid {
    static constexpr bool PERM = false, AFTER_DRAIN = false;
    const float* base; float* X; bf16_t* xb; float* ssn; float alpha;
    __device__ __forceinline__ void operator()(const f32x4 (&acc)[2][2][4][2], const Unit& u, int wr, int wc, int fr, int fq) const {
        const int row0 = u.pm * 256 + wr * 64 + fr, col0 = u.pn * 256 + wc * 32 + 4 * fq;
#pragma unroll
        for (int ai = 0; ai < 2; ++ai)
#pragma unroll
            for (int m = 0; m < 4; ++m) {
                const int row = row0 + ai * 128 + m * 16; float sq = 0.f;
#pragma unroll
                for (int bj = 0; bj < 2; ++bj)
#pragma unroll
                    for (int n = 0; n < 2; ++n) {
                        const size_t off = (size_t)row * D + col0 + bj * 128 + n * 16;
                        const f32x4 bs = *(const f32x4*)(base + off);
                        const f32x4 o = bs + acc[ai][bj][m][n] * alpha;
                        *(f32x4*)(X + off) = o;
                        *(u32x2*)(xb + off) = (u32x2){cvt_pk_bf16(o[0], o[1]), cvt_pk_bf16(o[2], o[3])};
                        sq += (o[0] * o[0] + o[1] * o[1]) + (o[2] * o[2] + o[3] * o[3]);
                    }
                sq += __shfl_xor(sq, 16); sq += __shfl_xor(sq, 32);
                if (fq == 0) unsafeAtomicAdd(ssn + row, sq);
                asm volatile("" ::: "memory");
            }
    }
};
struct EpiPle {
    static constexpr bool PERM = false, AFTER_DRAIN = false;
    float* X; const float* PP; const float* ss; bf16_t* xb; float* ssn;
    __device__ __forceinline__ void operator()(const f32x4 (&acc)[2][2][4][2], const Unit& u, int wr, int wc, int fr, int fq) const {
        const int row0 = u.pm * 256 + wr * 64 + fr, col0 = u.pn * 256 + wc * 32 + 4 * fq;
#pragma unroll
        for (int ai = 0; ai < 2; ++ai)
#pragma unroll
            for (int m = 0; m < 4; ++m) {
                const int row = row0 + ai * 128 + m * 16; float sq = 0.f;
                const float rs = rstd_of(ss[row], 1.0f / D);
#pragma unroll
                for (int bj = 0; bj < 2; ++bj)
#pragma unroll
                    for (int n = 0; n < 2; ++n) {
                        const size_t off = (size_t)row * D + col0 + bj * 128 + n * 16;
                        const f32x4 bs = *(const f32x4*)(X + off);
                        const f32x4 pp = *(const f32x4*)(PP + off);
                        f32x4 o;
#pragma unroll
                        for (int e = 0; e < 4; ++e) { const float a = acc[ai][bj][m][n][e] * rs; o[e] = bs[e] + __builtin_amdgcn_rcpf(1.0f + __expf(-a)) * pp[e]; }
                        *(f32x4*)(X + off) = o;
                        *(u32x2*)(xb + off) = (u32x2){cvt_pk_bf16(o[0], o[1]), cvt_pk_bf16(o[2], o[3])};
                        sq += (o[0] * o[0] + o[1] * o[1]) + (o[2] * o[2] + o[3] * o[3]);
                    }
                sq += __shfl_xor(sq, 16); sq += __shfl_xor(sq, 32);
                if (fq == 0) unsafeAtomicAdd(ssn + row, sq);
                asm volatile("" ::: "memory");
            }
    }
};
struct EpiScaleRow {
    static constexpr bool PERM = true, AFTER_DRAIN = false;
    bf16_t* O; int ldc; const float* ss;
    __device__ __forceinline__ void operator()(const f32x4 (&acc)[2][2][4][2], const Unit& u, int wr, int wc, int fr, int fq) const {
        const int row0 = u.pm * 256 + wr * 64 + fr, col0 = u.pn * 256 + wc * 32 + 8 * fq;
#pragma unroll
        for (int ai = 0; ai < 2; ++ai)
#pragma unroll
            for (int m = 0; m < 4; ++m) {
                const int row = row0 + ai * 128 + m * 16;
                const float rs = rstd_of(ss[row], 1.0f / D);
#pragma unroll
                for (int bj = 0; bj < 2; ++bj) {
                    const f32x4 v0 = acc[ai][bj][m][0] * rs, v1 = acc[ai][bj][m][1] * rs;
                    *(u32x4*)(O + (size_t)row * ldc + col0 + bj * 128) = (u32x4){cvt_pk_bf16(v0[0], v0[1]), cvt_pk_bf16(v0[2], v0[3]), cvt_pk_bf16(v1[0], v1[1]), cvt_pk_bf16(v1[2], v1[3])};
                }
            }
    }
};
struct EpiScaleCol {
    static constexpr bool PERM = true, AFTER_DRAIN = false;
    bf16_t* O; int ldc; const float* ss;
    __device__ __forceinline__ void operator()(const f32x4 (&acc)[2][2][4][2], const Unit& u, int wr, int wc, int fr, int fq) const {
        const int row0 = u.pm * 256 + wr * 64 + fr, col0 = u.pn * 256 + wc * 32 + 8 * fq;
#pragma unroll
        for (int bj = 0; bj < 2; ++bj) {
            float rs[8];
            {
                const f32x4 a = *(const f32x4*)(ss + col0 + bj * 128), b = *(const f32x4*)(ss + col0 + bj * 128 + 4);
#pragma unroll
                for (int e = 0; e < 4; ++e) { rs[e] = rstd_of(a[e], 1.0f / D); rs[4 + e] = rstd_of(b[e], 1.0f / D); }
            }
#pragma unroll
            for (int ai = 0; ai < 2; ++ai)
#pragma unroll
                for (int m = 0; m < 4; ++m) {
                    const int row = row0 + ai * 128 + m * 16;
                    const f32x4 v0 = acc[ai][bj][m][0], v1 = acc[ai][bj][m][1];
                    *(u32x4*)(O + (size_t)row * ldc + col0 + bj * 128) = (u32x4){cvt_pk_bf16(v0[0] * rs[0], v0[1] * rs[1]), cvt_pk_bf16(v0[2] * rs[2], v0[3] * rs[3]),
                                                                                  cvt_pk_bf16(v1[0] * rs[4], v1[1] * rs[5]), cvt_pk_bf16(v1[2] * rs[6], v1[3] * rs[7])};
                }
        }
    }
};
struct EpiStoreF32 {
    static constexpr bool PERM = false, AFTER_DRAIN = false;
    float* O; int ldc;
    __device__ __forceinline__ void operator()(const f32x4 (&acc)[2][2][4][2], const Unit& u, int wr, int wc, int fr, int fq) const {
        const int row0 = u.pm * 256 + wr * 64 + fr, col0 = u.pn * 256 + wc * 32 + 4 * fq;
#pragma unroll
        for (int ai = 0; ai < 2; ++ai)
#pragma unroll
            for (int m = 0; m < 4; ++m)
#pragma unroll
                for (int bj = 0; bj < 2; ++bj)
#pragma unroll
                    for (int n = 0; n < 2; ++n) *(f32x4*)(O + (size_t)(row0 + ai * 128 + m * 16) * ldc + col0 + bj * 128 + n * 16) = acc[ai][bj][m][n];
    }
};

template <class Epi>
__device__ __forceinline__ void gemm_naive(int wv, const Gemm g, const StaticOrder& S, const Epi& E) {
    const int tid = fresh_tid(wv), wid = tid >> 6, lane = tid & 63, wr = wid >> 2, wc = wid & 3, fr = lane & 15, fq = lane >> 4;
    Unit u;
    for (int ui = 0; S.next(ui, u); ++ui) {
        f32x4 acc[2][2][4][2];
#pragma unroll
        for (int a = 0; a < 2; ++a)
#pragma unroll
            for (int b = 0; b < 2; ++b)
#pragma unroll
                for (int m = 0; m < 4; ++m)
#pragma unroll
                    for (int n = 0; n < 2; ++n) acc[a][b][m][n] = (f32x4){0.f, 0.f, 0.f, 0.f};
        for (int k0 = 0; k0 < g.K; k0 += 32) {
            bf16x8 Bf[2][2];
#pragma unroll
            for (int bj = 0; bj < 2; ++bj)
#pragma unroll
                for (int n = 0; n < 2; ++n) {
                    const int slot = 16 * n + fr; const int rr = Epi::PERM ? pg8::perm32(slot) : slot;
                    Bf[bj][n] = *(const bf16x8*)(g.Bt + (size_t)(u.pn * 256 + bj * 128 + wc * 32 + rr) * g.K + k0 + 8 * fq);
                }
#pragma unroll
            for (int ai = 0; ai < 2; ++ai)
#pragma unroll
                for (int m = 0; m < 4; ++m) {
                    const bf16x8 Af = *(const bf16x8*)(g.A + (size_t)(u.pm * 256 + ai * 128 + wr * 64 + m * 16 + fr) * g.K + k0 + 8 * fq);
#pragma unroll
                    for (int bj = 0; bj < 2; ++bj)
#pragma unroll
                        for (int n = 0; n < 2; ++n) acc[ai][bj][m][n] = __builtin_amdgcn_mfma_f32_16x16x32_bf16(Bf[bj][n], Af, acc[ai][bj][m][n], 0, 0, 0);
                }
        }
        E(acc, u, wr, wc, fr, fq);
    }
}
template <class Epi>
__device__ __forceinline__ void gemm_run(int wv, LAS unsigned char* lds, const bf16_t* A, const bf16_t* Bt, int Mm, int Nn, int Kk, const Epi& E) {
    int bx_ = blockIdx.x; asm volatile("" : "+s"(bx_));
    Gemm g{A, Bt, Mm, Nn, Kk}; StaticOrder S; S.init(Mm, Nn, (int)gridDim.x, bx_);
#if NAIVE_GEMM
    gemm_naive<Epi>(wv, g, S, E);
    __syncthreads();
#else
    pg8::gemm_phase<Epi, StaticOrder, true, true>(lds, g, S, E, fresh_tid(wv));
#endif
}

__device__ __forceinline__ void transpose_item(const float* W, int K, int N, const float* gain, bf16_t* WT, int mode, int row_off, LAS float* scr, int item, int lane) {
    const int nblk = N / 32, kb = item / nblk, nb = item % nblk, k0 = 64 * kb, n0 = 32 * nb;
    f32x4 v[8];
#pragma unroll
    for (int i = 0; i < 8; ++i) v[i] = *(const f32x4*)(W + (size_t)(k0 + (lane >> 3) + 8 * i) * N + n0 + 4 * (lane & 7));
#pragma unroll
    for (int i = 0; i < 8; ++i) {
        const int kk = (lane >> 3) + 8 * i; const float gg = gain ? gain[k0 + kk] : 1.0f;
        LAS float* d = scr + kk * 33 + 4 * (lane & 7);
        d[0] = v[i][0] * gg; d[1] = v[i][1] * gg; d[2] = v[i][2] * gg; d[3] = v[i][3] * gg;
    }
    asm volatile("s_waitcnt lgkmcnt(0)" ::: "memory");
    const int c = lane & 7;
#pragma unroll
    for (int j = 0; j < 4; ++j) {
        const int n = (lane >> 3) + 8 * j, ncol = n0 + n; const LAS float* s = scr + (8 * c) * 33 + n;
        const int row = (mode == 1) ? (256 * (ncol >> 7) + (ncol & 127) + row_off) : (row_off + ncol);
        const float sc = (mode == 2 && ncol < 512) ? 0.125f : 1.0f;
        u32x4 o; o.x = cvt_pk_bf16(s[0 * 33] * sc, s[1 * 33] * sc); o.y = cvt_pk_bf16(s[2 * 33] * sc, s[3 * 33] * sc); o.z = cvt_pk_bf16(s[4 * 33] * sc, s[5 * 33] * sc); o.w = cvt_pk_bf16(s[6 * 33] * sc, s[7 * 33] * sc);
        *(u32x4*)(WT + (size_t)row * K + k0 + 8 * c) = o;
    }
    asm volatile("s_waitcnt lgkmcnt(0)" ::: "memory");
}

constexpr float MIN_DECAY = -3.0701134573253946f, MAX_DECAY = -15.350567286626973f;
__device__ __forceinline__ float rdl(float v, int k) { return __shfl(v, k); }
__device__ __forceinline__ void filter_item(KPC p, int layer, int item, int lane, float* FT) {
    const float* wf1 = p->in[11] + layer * 33 * 64; const float* bf1 = p->in[12] + layer * 64;
    const float* wf2 = p->in[13] + layer * 4096;    const float* bf2 = p->in[14] + layer * 64;
    const float* wf3 = p->in[15] + layer * 4096;    const float* bf3 = p->in[16] + layer * 64;
    const float* wf4 = p->in[17] + layer * 64 * 1024; const float fq = p->in[18][layer * 64 + lane];
    const int i0 = item * 2;
    float h[2], wc[64];
#pragma unroll
    for (int k = 0; k < 33; ++k) wc[k] = wf1[k * 64 + lane];
    const float bb1 = bf1[lane], bb2 = bf2[lane], bb3 = bf3[lane];
#pragma unroll
    for (int q = 0; q < 2; ++q) {
        const int i = i0 + q;
        const float t = (float)i * (1.0f / 2047.0f), w = 6.283185307179586f * (float)i / 2048.0f;
        const int j = (lane - 1) & 15; const float f = 1e-4f + (float)j * ((15.0f - 1e-4f) / 15.0f);
        const float a = f * w;
        float zf = 0.f;
        if (lane == 0) zf = t; else if (lane <= 16) zf = __cosf(a); else if (lane <= 32) zf = -__sinf(a);
        float s = bb1;
#pragma unroll
        for (int k = 0; k < 33; ++k) s += rdl(zf, k) * wc[k];
        h[q] = __sinf(fq * s);
    }
#pragma unroll
    for (int k = 0; k < 64; ++k) wc[k] = wf2[k * 64 + lane];
#pragma unroll
    for (int q = 0; q < 2; ++q) {
        float s = bb2;
#pragma unroll
        for (int k = 0; k < 64; ++k) s += rdl(h[q], k) * wc[k];
        h[q] = __sinf(fq * s);
    }
#pragma unroll
    for (int k = 0; k < 64; ++k) wc[k] = wf3[k * 64 + lane];
#pragma unroll
    for (int q = 0; q < 2; ++q) {
        float s = bb3;
#pragma unroll
        for (int k = 0; k < 64; ++k) s += rdl(h[q], k) * wc[k];
        h[q] = __sinf(fq * s);
    }
    float acc[2][16];
#pragma unroll
    for (int q = 0; q < 2; ++q)
#pragma unroll
        for (int jj = 0; jj < 16; ++jj) acc[q][jj] = 0.f;
    for (int k0 = 0; k0 < 64; k0 += 4) {
        float w[4][16];
#pragma unroll
        for (int kk = 0; kk < 4; ++kk)
#pragma unroll
            for (int jj = 0; jj < 16; ++jj) w[kk][jj] = wf4[(k0 + kk) * 1024 + lane + 64 * jj];
#pragma unroll
        for (int kk = 0; kk < 4; ++kk) {
            const float h0 = rdl(h[0], k0 + kk), h1 = rdl(h[1], k0 + kk);
#pragma unroll
            for (int jj = 0; jj < 16; ++jj) { acc[0][jj] += h0 * w[kk][jj]; acc[1][jj] += h1 * w[kk][jj]; }
        }
    }
#pragma unroll
    for (int jj = 0; jj < 16; ++jj) {
        const int cf = lane + 64 * jj, dir = cf >> 9, c = cf & 511;
        const float delta = fabsf(MIN_DECAY + (float)c * ((MAX_DECAY - MIN_DECAY) / 511.0f));
        f32x2 o;
#pragma unroll
        for (int q = 0; q < 2; ++q) { const float t = (float)(i0 + q) * (1.0f / 2047.0f); o[q] = acc[q][jj] * __expf(-t * delta); }
        *(f32x2*)(FT + ((size_t)(dir * 512 + c)) * SEQ + i0) = o;
    }
}

__device__ __forceinline__ void layer_prologue(int wv, KPC p, int layer, LAS unsigned char* lds) {
    const int tid = fresh_tid(wv), bx = fresh_bx(), lane = tid & 63, wave = tid >> 6;
    LAS float* scr = (LAS float*)(lds + wave * 16384);
    const int gw = bx * 8 + wave, NGW = gridDim.x * 8;
    unsigned char* Wb = p->ws + WS_W;
    const size_t lf = (size_t)layer;
    constexpr int I_G = 16 * 88, I_D = 44 * 32, I_IN = 16 * 96, I_O = 16 * 32, I_PP = 4 * 32;
    constexpr int NITEMS = 6 * I_G + I_IN + 2 * I_O + I_PP;
    static_assert(I_G == I_D, "items");
    for (int it = gw; it < NITEMS + 1024; it += NGW) {
        if (it < 1024) { filter_item(p, layer, it, lane, (float*)(p->ws + WS_FT)); continue; }
        int r = it - 1024;
        int wi, gi = -1, K = D, N = FF, mode = 1, row_off = 0; size_t wo = W_GUA, wstride = (size_t)D * FF;
        if (r < I_G) { wi = 3; gi = 2; }
        else if ((r -= I_G) < I_G) { wi = 4; gi = 2; row_off = 128; }
        else if ((r -= I_G) < I_D) { wi = 5; K = FF; N = D; mode = 0; wo = W_DA; }
        else if ((r -= I_D) < I_IN) { wi = 7; gi = 6; N = 3072; mode = 2; wo = W_IN; wstride = (size_t)D * 3072; }
        else if ((r -= I_IN) < I_O) { wi = 21; gi = 20; N = D; mode = 0; wo = W_OUT; wstride = (size_t)D * D; }
        else if ((r -= I_O) < I_G) { wi = 23; gi = 22; wo = W_GUB; }
        else if ((r -= I_G) < I_G) { wi = 24; gi = 22; row_off = 128; wo = W_GUB; }
        else if ((r -= I_G) < I_D) { wi = 25; K = FF; N = D; mode = 0; wo = W_DB; }
        else if ((r -= I_D) < I_O) { wi = 27; gi = 26; N = D; mode = 0; wo = W_PG; wstride = (size_t)D * D; }
        else { r -= I_O; wi = 28; K = PLE; N = D; mode = 0; wo = W_PP; wstride = (size_t)PLE * D; }
        const float* gain = gi >= 0 ? p->in[gi] + lf * D : nullptr;
        transpose_item(p->in[wi] + lf * wstride, K, N, gain, (bf16_t*)(Wb + wo), mode, row_off, scr, r, lane);
    }
    if (layer == 0) {
        bf16_t* xb = (bf16_t*)(p->ws + WS_XB); float* ss0 = (float*)(p->ws + WS_CTL);
        for (int m = gw; m < M; m += NGW) {
            const f32x4* xr = (const f32x4*)(p->in[0] + (size_t)m * D) + lane;
            f32x4 v[4]; float s = 0.f;
#pragma unroll
            for (int j = 0; j < 4; ++j) { v[j] = xr[64 * j]; s += (v[j][0] * v[j][0] + v[j][1] * v[j][1]) + (v[j][2] * v[j][2] + v[j][3] * v[j][3]); }
            s = wave_sum(s);
            if (lane == 0) ss0[m] = s;
            u32x2* o8 = (u32x2*)(xb + (size_t)m * D) + lane;
#pragma unroll
            for (int j = 0; j < 4; ++j) o8[64 * j] = (u32x2){cvt_pk_bf16(v[j][0], v[j][1]), cvt_pk_bf16(v[j][2], v[j][3])};
        }
        bf16_t* pb = (bf16_t*)(p->ws + WS_PB);
        const size_t n8 = (size_t)2 * M * PLE / 8;
        for (size_t i = (size_t)bx * 512 + tid; i < n8; i += (size_t)gridDim.x * 512) {
            const f32x4 a = *(const f32x4*)(p->in[1] + i * 8), b = *(const f32x4*)(p->in[1] + i * 8 + 4);
            *(u32x4*)(pb + i * 8) = (u32x4){cvt_pk_bf16(a[0], a[1]), cvt_pk_bf16(a[2], a[3]), cvt_pk_bf16(b[0], b[1]), cvt_pk_bf16(b[2], b[3])};
        }
    }
}

__device__ __forceinline__ void attn_naive(int wv, KPC p, int layer, const bf16_t* QK, const bf16_t* UT, bf16_t* yna) {
    const float* rpb = p->in[8] + layer * 8 * 15 * 31;
    const int tid = fresh_tid(wv), bx = fresh_bx();
    for (int it = bx * 512 + tid; it < M * 8; it += gridDim.x * 512) {
        const int h = it / M, tok = it % M;
        const int b = tok >> 11, l = tok & 2047, r = l >> 6, qc = l & 63;
        const int rs = min(max(r - 4, 0), 24), qcs = min(max(qc - 8, 0), 48);
        float o[64]; u32x4 qp[8];
#pragma unroll
        for (int j = 0; j < 8; ++j) qp[j] = *(const u32x4*)(QK + (size_t)tok * 1024 + 64 * h + 8 * j);
#pragma unroll
        for (int d = 0; d < 64; ++d) o[d] = 0.f;
        float mx = -3.0e38f, ls = 0.f;
        for (int kr = 0; kr < 8; ++kr)
            for (int kx = 0; kx < 16; ++kx) {
                const int krow = rs + kr, kc = qcs + kx; const size_t ktok = (size_t)b * 2048 + krow * 64 + kc;
                float s = 0.f;
#pragma unroll
                for (int j = 0; j < 8; ++j) {
                    const u32x4 v = *(const u32x4*)(QK + ktok * 1024 + 512 + 64 * h + 8 * j);
                    const u32x4 qq = qp[j];
                    s += bf_lo(qq.x) * bf_lo(v.x) + bf_hi(qq.x) * bf_hi(v.x) + bf_lo(qq.y) * bf_lo(v.y) + bf_hi(qq.y) * bf_hi(v.y)
                       + bf_lo(qq.z) * bf_lo(v.z) + bf_hi(qq.z) * bf_hi(v.z) + bf_lo(qq.w) * bf_lo(v.w) + bf_hi(qq.w) * bf_hi(v.w);
                }
                s += rpb[(h * 15 + (krow - r + 7)) * 31 + (kc - qc + 15)];
                const float mn = fmaxf(mx, s), corr = __expf(mx - mn), pe = __expf(s - mn);
                ls = ls * corr + pe; mx = mn;
#pragma unroll
                for (int d = 0; d < 64; ++d) o[d] = o[d] * corr + pe * bf2f(UT[(size_t)(64 * h + d) * M + ktok]);
            }
        const float inv = 1.0f / ls;
#pragma unroll
        for (int j = 0; j < 8; ++j)
            *(u32x4*)(yna + (size_t)tok * 512 + 64 * h + 8 * j) = (u32x4){cvt_pk_bf16(o[8 * j] * inv, o[8 * j + 1] * inv), cvt_pk_bf16(o[8 * j + 2] * inv, o[8 * j + 3] * inv),
                                                                         cvt_pk_bf16(o[8 * j + 4] * inv, o[8 * j + 5] * inv), cvt_pk_bf16(o[8 * j + 6] * inv, o[8 * j + 7] * inv)};
    }
}

__device__ __forceinline__ float sconv(const bf16_t* row, int t, float w0, float w1, float w2, float bb) {
    const float a = t > 0 ? bf2f(row[t - 1]) : 0.f, b = bf2f(row[t]), c = t < SEQ - 1 ? bf2f(row[t + 1]) : 0.f;
    return a * w0 + b * w1 + c * w2 + bb;
}
__device__ __forceinline__ void conv_naive(int wv, KPC p, int layer, LAS unsigned char* lds, const bf16_t* UT, const float* FT, bf16_t* yhyT) {
    LAS float* karr = (LAS float*)lds; LAS float* zf = karr + 4096; LAS float* x0f = zf + 2048; LAS float* red = x0f + 2048;
    const float* wsc = p->in[9] + layer * 3 * 1536; const float* bsc = p->in[10] + layer * 1536; const float* hyb = p->in[19] + layer * 512;
    const int tid = fresh_tid(wv), bx = fresh_bx(), lane = tid & 63, wave = tid >> 6;
    for (int it = bx; it < 512 * 8; it += gridDim.x) {
        const int c = it >> 3, b = it & 7;
        __syncthreads();
        float asum = 0.f;
        for (int d = tid; d < 4096; d += 512) {
            const int dd = d - 2048; float v;
            if (dd == -2048) v = 0.f; else if (dd == 0) v = FT[(size_t)c * SEQ] + FT[(size_t)(512 + c) * SEQ]; else if (dd > 0) v = FT[(size_t)c * SEQ + dd]; else v = FT[(size_t)(512 + c) * SEQ - dd];
            karr[d] = v; asum += fabsf(v);
        }
        {
            const bf16_t* r0 = UT + (size_t)(512 + c) * M + b * 2048; const bf16_t* r1 = UT + (size_t)(1024 + c) * M + b * 2048; const bf16_t* r2 = UT + (size_t)(1536 + c) * M + b * 2048;
            const float a0 = wsc[c], a1 = wsc[1536 + c], a2 = wsc[3072 + c], ab = bsc[c];
            const float b0 = wsc[512 + c], b1 = wsc[1536 + 512 + c], b2 = wsc[3072 + 512 + c], bb = bsc[512 + c];
            const float c0 = wsc[1024 + c], c1 = wsc[1536 + 1024 + c], c2 = wsc[3072 + 1024 + c], cb = bsc[1024 + c];
            for (int t = tid; t < 2048; t += 512) {
                x0f[t] = sconv(r0, t, a0, a1, a2, ab);
                zf[t] = sconv(r1, t, b0, b1, b2, bb) * sconv(r2, t, c0, c1, c2, cb);
            }
        }
        asum = wave_sum(asum);
        if (lane == 0) red[wave] = asum;
        __syncthreads();
        float kn = 0.f;
#pragma unroll
        for (int w = 0; w < 8; ++w) kn += red[w];
        const float ikn = 1.0f / kn, hb = hyb[c];
#pragma unroll
        for (int e = 0; e < 4; ++e) {
            const int t = tid + 512 * e; float acc = 0.f;
            for (int s = 0; s < 2048; ++s) acc += karr[t - s + 2048] * zf[s];
            const float y = x0f[t] * (acc * ikn + zf[t] * hb);
            yhyT[(size_t)c * M + b * 2048 + t] = (bf16_t)(cvt_pk_bf16(y, 0.f) & 0xffffu);
        }
    }
}


__device__ __forceinline__ void attn_mfma(int wv, KPC p, int layer, const bf16_t* QK, const bf16_t* UT, bf16_t* yna) {
    const float* rpb = p->in[8] + layer * 8 * 15 * 31;
    const int tid = fresh_tid(wv), bx = fresh_bx(), lane = tid & 63, qi = lane & 15, g = lane >> 4;
    for (int it = bx * 8 + wv; it < 8192; it += gridDim.x * 8) {
        const int h = it & 7, j = (it >> 3) & 3, r = (it >> 5) & 31, b = it >> 10;
        const int rs = min(max(r - 4, 0), 24), bc0 = min(max(16 * j - 8, 0), 32);
        const int qc = 16 * j + qi, qcs = min(max(qc - 8, 0), 48);
        const size_t qtok = (size_t)b * 2048 + r * 64 + qc;
        const bf16x8 qf0 = *(const bf16x8*)(QK + qtok * 1024 + 64 * h + 8 * g), qf1 = *(const bf16x8*)(QK + qtok * 1024 + 64 * h + 32 + 8 * g);
        f32x4 s[16];
#pragma unroll
        for (int T = 0; T < 16; ++T) {
            const size_t ktok = (size_t)b * 2048 + (rs + (T >> 1)) * 64 + bc0 + 16 * (T & 1) + qi;
            const bf16x8 k0 = *(const bf16x8*)(QK + ktok * 1024 + 512 + 64 * h + 8 * g), k1 = *(const bf16x8*)(QK + ktok * 1024 + 512 + 64 * h + 32 + 8 * g);
            f32x4 z = (f32x4){0.f, 0.f, 0.f, 0.f};
            z = __builtin_amdgcn_mfma_f32_16x16x32_bf16(k0, qf0, z, 0, 0, 0);
            z = __builtin_amdgcn_mfma_f32_16x16x32_bf16(k1, qf1, z, 0, 0, 0);
            s[T] = z;
        }
        float mx = -3.0e38f;
#pragma unroll
        for (int T = 0; T < 16; ++T)
#pragma unroll
            for (int e = 0; e < 4; ++e) {
                const int kc = bc0 + 16 * (T & 1) + 4 * g + e, kr = rs + (T >> 1);
                const bool valid = (kc >= qcs) && (kc < qcs + 16);
                float v = -3.0e38f;
                if (valid) v = s[T][e] + rpb[(h * 15 + kr - r + 7) * 31 + kc - qc + 15];
                s[T][e] = v; mx = fmaxf(mx, v);
            }
        mx = fmaxf(mx, __shfl_xor(mx, 16)); mx = fmaxf(mx, __shfl_xor(mx, 32));
        float ls = 0.f;
#pragma unroll
        for (int T = 0; T < 16; ++T)
#pragma unroll
            for (int e = 0; e < 4; ++e) { const float pe = __expf(s[T][e] - mx); s[T][e] = pe; ls += pe; }
        ls += __shfl_xor(ls, 16); ls += __shfl_xor(ls, 32);
        f32x4 o[4];
#pragma unroll
        for (int dt = 0; dt < 4; ++dt) o[dt] = (f32x4){0.f, 0.f, 0.f, 0.f};
#pragma unroll
        for (int kr = 0; kr < 8; ++kr) {
            const u32x4 pw = (u32x4){cvt_pk_bf16(s[2 * kr][0], s[2 * kr][1]), cvt_pk_bf16(s[2 * kr][2], s[2 * kr][3]), cvt_pk_bf16(s[2 * kr + 1][0], s[2 * kr + 1][1]), cvt_pk_bf16(s[2 * kr + 1][2], s[2 * kr + 1][3])};
            const bf16x8 pf = __builtin_bit_cast(bf16x8, pw);
#pragma unroll
            for (int dt = 0; dt < 4; ++dt) {
                const bf16_t* vp = UT + (size_t)(64 * h + 16 * dt + qi) * M + (size_t)b * 2048 + (rs + kr) * 64 + bc0 + 4 * g;
                const u32x2 v0 = *(const u32x2*)vp, v1 = *(const u32x2*)(vp + 16);
                const bf16x8 vf = __builtin_bit_cast(bf16x8, ((u32x4){v0.x, v0.y, v1.x, v1.y}));
                o[dt] = __builtin_amdgcn_mfma_f32_16x16x32_bf16(vf, pf, o[dt], 0, 0, 0);
            }
        }
        const float inv = 1.0f / ls;
#pragma unroll
        for (int dt = 0; dt < 4; ++dt)
            *(u32x2*)(yna + qtok * 512 + 64 * h + 16 * dt + 4 * g) = (u32x2){cvt_pk_bf16(o[dt][0] * inv, o[dt][1] * inv), cvt_pk_bf16(o[dt][2] * inv, o[dt][3] * inv)};
    }
}

__device__ __forceinline__ void conv_mfma(int wv, KPC p, int layer, LAS unsigned char* lds, const bf16_t* UT, const float* FT, bf16_t* yhyT) {
    constexpr int CPS = 8224, ZRS = 4112;
    LAS unsigned char* FC = lds; LAS unsigned char* ZT = lds + 8 * CPS; LAS float* red = (LAS float*)(ZT + 16 * ZRS);
    const float* wsc = p->in[9] + layer * 3 * 1536; const float* bsc = p->in[10] + layer * 1536; const float* hyb = p->in[19] + layer * 512;
    const int tid = fresh_tid(wv), bx = fresh_bx(), lane = tid & 63, i = lane & 15, g = lane >> 4;
    const int rho = (8 - (i & 7)) & 7;
    const int abase = rho * CPS + 2 * (2048 - i + 8 * g - rho) - 512 * wv;
    const int bbase = i * ZRS + 16 * g;
    for (int c = bx; c < 512; c += gridDim.x) {
        __syncthreads();
        float asum = 0.f;
#pragma unroll
        for (int k = 0; k < 8; ++k) {
            const int m = tid + 512 * k; float v;
            if (m == 0) v = 0.f; else if (m < 2048) v = FT[(size_t)c * SEQ + 2048 - m]; else if (m == 2048) v = FT[(size_t)c * SEQ] + FT[(size_t)(512 + c) * SEQ]; else v = FT[(size_t)(512 + c) * SEQ + m - 2048];
            asum += fabsf(v);
            const bf16_t vb = (bf16_t)(cvt_pk_bf16(v, 0.f) & 0xffffu);
#pragma unroll
            for (int r8 = 0; r8 < 8; ++r8) if (m - r8 >= 0) *(LAS bf16_t*)(FC + r8 * CPS + 2 * (m - r8)) = vb;
        }
        {
            const float a0 = wsc[c], a1 = wsc[1536 + c], a2 = wsc[3072 + c], ab = bsc[c];
            const float b0 = wsc[512 + c], b1 = wsc[1536 + 512 + c], b2 = wsc[3072 + 512 + c], bb = bsc[512 + c];
            const float c0 = wsc[1024 + c], c1 = wsc[1536 + 1024 + c], c2 = wsc[3072 + 1024 + c], cb = bsc[1024 + c];
#pragma unroll
            for (int k = 0; k < 4; ++k) {
                const int idx = tid + 512 * k, b = idx >> 8, t0 = (idx & 255) * 8;
                float x0v[8], zv[8];
#pragma unroll
                for (int rr = 0; rr < 3; ++rr) {
                    const bf16_t* row = UT + (size_t)(512 + 512 * rr + c) * M + (size_t)b * 2048;
                    const u32x4 w = *(const u32x4*)(row + t0);
                    float f[10];
                    f[0] = t0 > 0 ? bf2f(row[t0 - 1]) : 0.f; f[9] = t0 + 8 < SEQ ? bf2f(row[t0 + 8]) : 0.f;
                    f[1] = bf_lo(w.x); f[2] = bf_hi(w.x); f[3] = bf_lo(w.y); f[4] = bf_hi(w.y); f[5] = bf_lo(w.z); f[6] = bf_hi(w.z); f[7] = bf_lo(w.w); f[8] = bf_hi(w.w);
                    const float w0 = rr == 0 ? a0 : (rr == 1 ? b0 : c0), w1 = rr == 0 ? a1 : (rr == 1 ? b1 : c1), w2 = rr == 0 ? a2 : (rr == 1 ? b2 : c2), wb = rr == 0 ? ab : (rr == 1 ? bb : cb);
#pragma unroll
                    for (int e = 0; e < 8; ++e) {
                        const float v = f[e] * w0 + f[e + 1] * w1 + f[e + 2] * w2 + wb;
                        if (rr == 0) x0v[e] = v; else if (rr == 1) zv[e] = v; else zv[e] *= v;
                    }
                }
                *(LAS u32x4*)(ZT + b * ZRS + 2 * t0) = (u32x4){cvt_pk_bf16(zv[0], zv[1]), cvt_pk_bf16(zv[2], zv[3]), cvt_pk_bf16(zv[4], zv[5]), cvt_pk_bf16(zv[6], zv[7])};
                *(LAS u32x4*)(ZT + (8 + b) * ZRS + 2 * t0) = (u32x4){cvt_pk_bf16(x0v[0], x0v[1]), cvt_pk_bf16(x0v[2], x0v[3]), cvt_pk_bf16(x0v[4], x0v[5]), cvt_pk_bf16(x0v[6], x0v[7])};
            }
        }
        asum = wave_sum(asum);
        if (lane == 0) red[wv] = asum;
        __syncthreads();
        float kn = 0.f;
#pragma unroll
        for (int w = 0; w < 8; ++w) kn += red[w];
        bf16x8 ring[16]; f32x4 acc[16];
#pragma unroll
        for (int tau = 0; tau < 16; ++tau) { ring[tau] = *(const LAS bf16x8*)(FC + abase - 32 * tau); acc[tau] = (f32x4){0.f, 0.f, 0.f, 0.f}; }
        bf16x8 bcur = *(const LAS bf16x8*)(ZT + bbase);
        for (int s8 = 0; s8 < 8; ++s8) {
#pragma unroll
            for (int sp = 0; sp < 8; ++sp) {
                const int sn = min(8 * s8 + sp + 1, 63);
                const bf16x8 bnext = *(const LAS bf16x8*)(ZT + bbase + 64 * sn);
                const bf16x8 n0 = *(const LAS bf16x8*)(FC + abase + 64 * sn), n1 = *(const LAS bf16x8*)(FC + abase + 64 * sn - 32);
#pragma unroll
                for (int tau = 0; tau < 16; ++tau) acc[tau] = __builtin_amdgcn_mfma_f32_16x16x32_bf16(ring[(tau - 2 * sp) & 15], bcur, acc[tau], 0, 0, 0);
                ring[(0 - 2 * (sp + 1)) & 15] = n0; ring[(1 - 2 * (sp + 1)) & 15] = n1;
                bcur = bnext;
            }
        }
        if (i < 8) {
            const float ikn = 1.0f / kn, hb = hyb[c];
#pragma unroll
            for (int tau = 0; tau < 16; ++tau) {
                const int t = 256 * wv + 16 * tau + 4 * g;
                const u32x2 zz = *(const LAS u32x2*)(ZT + i * ZRS + 2 * t), xx = *(const LAS u32x2*)(ZT + (8 + i) * ZRS + 2 * t);
                const float y0 = bf_lo(xx.x) * (acc[tau][0] * ikn + bf_lo(zz.x) * hb), y1 = bf_hi(xx.x) * (acc[tau][1] * ikn + bf_hi(zz.x) * hb);
                const float y2 = bf_lo(xx.y) * (acc[tau][2] * ikn + bf_lo(zz.y) * hb), y3 = bf_hi(xx.y) * (acc[tau][3] * ikn + bf_hi(zz.y) * hb);
                *(u32x2*)(yhyT + (size_t)c * M + (size_t)i * 2048 + t) = (u32x2){cvt_pk_bf16(y0, y1), cvt_pk_bf16(y2, y3)};
            }
        }
    }
}

__device__ __forceinline__ void post_pass(int wv, LAS unsigned char* lds, const bf16_t* yna, const bf16_t* yhyT, bf16_t* yn) {
    LAS bf16_t* tile = (LAS bf16_t*)lds;
    const int tid = fresh_tid(wv), bx = fresh_bx(), lane = tid & 63, wave = tid >> 6;
    for (int it = bx; it < M / 32; it += gridDim.x) {
        const int tok0 = it * 32;
        __syncthreads();
        {
            const u32x4* src = (const u32x4*)(yhyT + (size_t)tid * M + tok0);
#pragma unroll
            for (int j = 0; j < 4; ++j) {
                const u32x4 v = src[j];
                tile[(8 * j + 0) * 520 + tid] = (bf16_t)(v.x & 0xffffu); tile[(8 * j + 1) * 520 + tid] = (bf16_t)(v.x >> 16);
                tile[(8 * j + 2) * 520 + tid] = (bf16_t)(v.y & 0xffffu); tile[(8 * j + 3) * 520 + tid] = (bf16_t)(v.y >> 16);
                tile[(8 * j + 4) * 520 + tid] = (bf16_t)(v.z & 0xffffu); tile[(8 * j + 5) * 520 + tid] = (bf16_t)(v.z >> 16);
                tile[(8 * j + 6) * 520 + tid] = (bf16_t)(v.w & 0xffffu); tile[(8 * j + 7) * 520 + tid] = (bf16_t)(v.w >> 16);
            }
        }
        __syncthreads();
#pragma unroll
        for (int q = 0; q < 4; ++q) {
            const int tk = 4 * wave + q; const size_t tok = (size_t)tok0 + tk;
#pragma unroll
            for (int half = 0; half < 2; ++half) {
                u32x4 v;
                if (half == 0) v = *(const u32x4*)(yna + tok * 512 + 8 * lane); else v = *(const LAS u32x4*)(tile + tk * 520 + 8 * lane);
                float f[8] = {bf_lo(v.x), bf_hi(v.x), bf_lo(v.y), bf_hi(v.y), bf_lo(v.z), bf_hi(v.z), bf_lo(v.w), bf_hi(v.w)};
                float s = 0.f;
#pragma unroll
                for (int e = 0; e < 8; ++e) s += f[e] * f[e];
                s = wave_sum(s);
                const float rs = rstd_of(s, 1.0f / 512.0f);
                *(u32x4*)(yn + tok * 1024 + half * 512 + 8 * lane) = (u32x4){cvt_pk_bf16(f[0] * rs, f[1] * rs), cvt_pk_bf16(f[2] * rs, f[3] * rs), cvt_pk_bf16(f[4] * rs, f[5] * rs), cvt_pk_bf16(f[6] * rs, f[7] * rs)};
            }
        }
    }
}

__global__ void __launch_bounds__(512, 2) hybrid_fwd(KP kparams_unused) {
    extern __shared__ __attribute__((aligned(16))) unsigned char lds_raw[];
    LAS unsigned char* lds = (LAS unsigned char*)lds_raw;
    cg::grid_group grid = cg::this_grid();
    const int wv = __builtin_amdgcn_readfirstlane((int)(threadIdx.x >> 6));
#define WSV() KPC p = KPARAMS(); unsigned char* ws = p->ws; float* ss = (float*)(ws + WS_CTL) + (size_t)(4 * layer) * M;   \
    bf16_t* xb = (bf16_t*)(ws + WS_XB); bf16_t* Hb = (bf16_t*)(ws + WS_R1); bf16_t* QK = (bf16_t*)(ws + WS_R1); bf16_t* UT = (bf16_t*)(ws + WS_R1 + 32 * MiB); \
    bf16_t* yna = (bf16_t*)(ws + WS_R2); bf16_t* yhyT = (bf16_t*)(ws + WS_R2 + 16 * MiB); bf16_t* yn = (bf16_t*)(ws + WS_R2 + 32 * MiB); float* PP = (float*)(ws + WS_R2); \
    bf16_t* pb = (bf16_t*)(ws + WS_PB); const float* FT = (const float*)(ws + WS_FT); unsigned char* Wb = ws + WS_W; float* X = p->out; \
    (void)ss; (void)xb; (void)Hb; (void)QK; (void)UT; (void)yna; (void)yhyT; (void)yn; (void)PP; (void)pb; (void)FT; (void)Wb; (void)X;

    { const int t0_ = fresh_tid(wv); if (t0_ < 4) ((volatile LAS unsigned*)(lds + LDS_BYTES - 16))[t0_] = 0u; __syncthreads(); }
    XcdBarrier xbar;
    { KPC p = KPARAMS(); xbar = xcd_barrier_post((unsigned*)(p->ws + WS_CTL + BAR_OFF), (volatile LAS unsigned*)(lds + LDS_BYTES - 16), wv); }
#define GSYNC() do { for (int rs_ = 0; rs_ < R_SYNC; ++rs_) xcd_barrier(xbar, wv); } while (0)
    for (int layer = 0; layer < 2; ++layer) {
#ifndef NO_PRO
        for (int rep_ = 0; rep_ < R_PRO; ++rep_) { WSV(); layer_prologue(wv, p, layer, lds); __syncthreads(); }
#endif
        if (layer == 0) grid.sync(); else GSYNC();
        for (int rep_ = 0; rep_ < R_UP; ++rep_) { WSV(); gemm_run(wv, lds, xb, (const bf16_t*)(Wb + W_GUA), M, 2 * FF, D, EpiSwiGLU{Hb, ss}); }
        GSYNC();
        { WSV(); gemm_run(wv, lds, Hb, (const bf16_t*)(Wb + W_DA), M, D, FF, EpiResid{layer == 0 ? p->in[0] : X, X, xb, ss + M, 0.5f}); }
        GSYNC();
        { WSV(); gemm_run(wv, lds, (const bf16_t*)(Wb + W_IN) + (size_t)1024 * D, xb, 2048, M, D, EpiScaleCol{UT, M, ss + M}); }
        { WSV(); gemm_run(wv, lds, xb, (const bf16_t*)(Wb + W_IN), M, 1024, D, EpiScaleRow{QK, 1024, ss + M}); }
        GSYNC();
#ifndef NO_ATTN
#if NAIVE_ATTN
        { WSV(); attn_naive(wv, p, layer, QK, UT, yna); }
#else
        for (int rep_ = 0; rep_ < R_ATTN; ++rep_) { WSV(); attn_mfma(wv, p, layer, QK, UT, yna); }
#endif
#endif
#ifndef NO_CONV
#if NAIVE_CONV
        { WSV(); conv_naive(wv, p, layer, lds, UT, FT, yhyT); }
#else
        for (int rep_ = 0; rep_ < R_CONV; ++rep_) { WSV(); conv_mfma(wv, p, layer, lds, UT, FT, yhyT); }
#endif
#endif
        GSYNC();
#ifndef NO_POST
        for (int rep_ = 0; rep_ < R_POST; ++rep_) { WSV(); post_pass(wv, lds, yna, yhyT, yn); }
#endif
        GSYNC();
        { WSV(); gemm_run(wv, lds, yn, (const bf16_t*)(Wb + W_OUT), M, D, D, EpiResid{X, X, xb, ss + 2 * M, 1.0f}); }
        GSYNC();
        { WSV(); gemm_run(wv, lds, pb + (size_t)layer * M * PLE, (const bf16_t*)(Wb + W_PP), M, D, PLE, EpiStoreF32{PP, D}); }
        { WSV(); gemm_run(wv, lds, xb, (const bf16_t*)(Wb + W_GUB), M, 2 * FF, D, EpiSwiGLU{Hb, ss + 2 * M}); }
        GSYNC();
        { WSV(); gemm_run(wv, lds, Hb, (const bf16_t*)(Wb + W_DB), M, D, FF, EpiResid{X, X, xb, ss + 3 * M, 0.5f}); }
        GSYNC();
        { WSV(); gemm_run(wv, lds, xb, (const bf16_t*)(Wb + W_PG), M, D, D, EpiPle{X, PP, ss + 3 * M, xb, ss + 4 * M}); }
        GSYNC();
    }
    {
        const int layer = 2; WSV();
        const int tid = fresh_tid(wv), bx = fresh_bx(), lane = tid & 63, wave = tid >> 6;
        const float* gf = p->in[29];
        for (int m = bx * 8 + wave; m < M; m += gridDim.x * 8) {
            const float rs = rstd_of(ss[m], 1.0f / D);
            f32x4* xr = (f32x4*)(X + (size_t)m * D) + lane; const f32x4* gr = (const f32x4*)gf + lane;
#pragma unroll
            for (int j = 0; j < 4; ++j) { f32x4 v = xr[64 * j]; const f32x4 g = gr[64 * j]; v = v * rs * g; xr[64 * j] = v; }
        }
    }
}

extern "C" void kernel_launch(void* const* d_in, const int* in_sizes, int n_in, void* d_out, int out_size, void* d_ws, size_t ws_size, hipStream_t stream) {
    static int grid = 0;
    if (grid == 0) {
        if (n_in != 30 || out_size != M * D || ws_size < WS_END) { fprintf(stderr, "kernel_launch: unexpected shapes: n_in %d out %d ws %zu (need %zu)\n", n_in, out_size, ws_size, (size_t)WS_END); grid = -1; return; }
        int dev = 0, cus = 0, per_cu = 0;
        hipGetDevice(&dev);
        hipDeviceGetAttribute(&cus, hipDeviceAttributeMultiprocessorCount, dev);
        if (hipFuncSetAttribute((const void*)hybrid_fwd, hipFuncAttributeMaxDynamicSharedMemorySize, LDS_BYTES) != hipSuccess) { fprintf(stderr, "kernel_launch: hipFuncSetAttribute failed\n"); }
        if (hipOccupancyMaxActiveBlocksPerMultiprocessor(&per_cu, (const void*)hybrid_fwd, 512, LDS_BYTES) != hipSuccess || per_cu < 1) { fprintf(stderr, "kernel_launch: occupancy query says %d\n", per_cu); per_cu = 1; }
        (void)hipGetLastError();
        grid = cus * per_cu;
        fprintf(stderr, "kernel_launch: grid %d (cus %d x %d)\n", grid, cus, per_cu);
    }
    if (grid < 0) return;
    (void)hipMemsetAsync((char*)d_ws + WS_CTL, 0, 1 * MiB, stream);
    KP hp{};
    for (int i = 0; i < 30; ++i) hp.in[i] = (const float*)d_in[i];
    hp.out = (float*)d_out; hp.ws = (unsigned char*)d_ws;
    void* args[] = {&hp};
    hipError_t e = hipLaunchCooperativeKernel((const void*)hybrid_fwd, dim3(grid), dim3(512), args, LDS_BYTES, stream);
    if (e != hipSuccess) fprintf(stderr, "kernel_launch: cooperative launch failed: %s (grid %d)\n", hipGetErrorString(e), grid);
}
```

```cpp
#include <hip/hip_runtime.h>
#include <hip/hip_cooperative_groups.h>
#include <cstdio>
#include <cstdint>
namespace cg = cooperative_groups;
namespace pg8 {
#define PG8_LAS __attribute__((address_space(3)))
typedef unsigned short bf16_t;
typedef short bf16x8 __attribute__((ext_vector_type(8)));
typedef float f32x4 __attribute__((ext_vector_type(4)));
typedef unsigned u32x4 __attribute__((ext_vector_type(4)));
constexpr int BM = 256, BK = 64, HALF = 128, HTB = HALF * BK * 2  , STAGE_BYTES = 8 * HTB, NXCD = 8, WGM = 8;

__host__ __device__ __forceinline__ int lds_byte(int r, int c) { const int st = (r >> 4) * 2 + (c >> 5), rr = r & 15, cc = c & 31, ob = rr * 64 + cc * 2; return st * 1024 + (ob ^ (((ob >> 9) & 1) << 5)); }
__host__ __device__ __forceinline__ void stage_rc(int b, int& R, int& C) { const int st = b / 1024, sb = b % 1024, swz = sb ^ (((sb >> 9) & 1) << 5); R = (st >> 1) * 16 + swz / 64; C = (st & 1) * 32 + (swz % 64) / 2; }
__host__ __device__ __forceinline__ int perm32(int rho) { const int n = rho >> 4, i = rho & 15; return 8 * (i >> 2) + 4 * n + (i & 3); }

struct Unit { int pm, pn; };
struct Gemm { const bf16_t* A; const bf16_t* Bt; int M, N, K; };

struct StaticOrder {
    int nM, nN, nwg, G, c;
    __host__ __device__ void init(int M, int N, int G_, int c_) { nM = M / BM; nN = N / BM; nwg = nM * nN; G = G_; c = c_; }
    __host__ __device__ bool next(int i, Unit& u) const {
        const long L = (long)i * G + c; if (L >= nwg) return false;
        int wgid = (int)L; { const int q = nwg / NXCD, r = nwg % NXCD, xcd = wgid % NXCD, off = wgid / NXCD; wgid = (xcd < r ? xcd * (q + 1) : r * (q + 1) + (xcd - r) * q) + off; }
        const int nig = WGM * nN, gid = wgid / nig, fm = gid * WGM, gsz = (nM - fm) < WGM ? (nM - fm) : WGM;
        u.pm = fm + ((wgid % nig) % gsz); u.pn = (wgid % nig) / gsz; return true;
    }
    __device__ __forceinline__ void a_ready(const Unit&) const {}
    __device__ __forceinline__ void done(const Unit&) const {}
};

template <class Epi, class Sched, bool ALIGN_EPI = false, bool SP2 = false>
__device__ __forceinline__ void gemm_phase(PG8_LAS unsigned char* lds, const Gemm g, const Sched& S, const Epi& E, int tid_in) {
    int tid_ = tid_in; asm volatile("" : "+v"(tid_)); const int tid = tid_, wid = __builtin_amdgcn_readfirstlane(tid >> 6), lane = tid & 63, wr = wid >> 2, wc = wid & 3, fr = lane & 15, fq = lane >> 4;
    const int K = g.K, nt = K / BK;
    unsigned voffA[2], voffB[2];
#pragma unroll
    for (int i = 0; i < 2; ++i) { int R, C; stage_rc(tid * 16 + i * 8192, R, C); const int Rb = Epi::PERM ? ((R & ~31) + perm32(R & 31)) : R;
        voffA[i] = (unsigned)(R * K + C) * 2u; voffB[i] = (unsigned)(Rb * K + C) * 2u; }
    const size_t kstep = (size_t)(BK * 2);
    const size_t hstep = (size_t)HALF * K * 2;
    const size_t tstep = 2 * hstep;
    const unsigned ldsw = (unsigned)wid * 1024u;
    const int aoff = lds_byte(wr * 64 + fr, fq * 8), boff = lds_byte(wc * 32 + fr, fq * 8);
#define PG8_SA(b, h) (((b) * 2 + (h)) * HTB)
#define PG8_SB(b, h) ((4 + (b) * 2 + (h)) * HTB)
#define PG8_STAGE(bufoff, gbase, voff) do { _Pragma("unroll") for (int _i = 0; _i < 2; ++_i) \
        __builtin_amdgcn_global_load_lds((const unsigned*)((const char*)(gbase) + (voff)[_i]), (PG8_LAS unsigned*)(lds + (bufoff) + ldsw + _i * 8192), 16, 0, 0); } while (0)
#define PG8_LDA(dst, b, h) do { _Pragma("unroll") for (int m = 0; m < 4; ++m) _Pragma("unroll") for (int k = 0; k < 2; ++k) dst[m][k] = *(const PG8_LAS bf16x8*)(lds + PG8_SA(b, h) + aoff + m * 2048 + k * 1024); } while (0)
#define PG8_LDB(dst, b, h) do { _Pragma("unroll") for (int n = 0; n < 2; ++n) _Pragma("unroll") for (int k = 0; k < 2; ++k) dst[n][k] = *(const PG8_LAS bf16x8*)(lds + PG8_SB(b, h) + boff + n * 2048 + k * 1024); } while (0)
#define PG8_MMA(ai, bj, At, Bt) do { __builtin_amdgcn_s_setprio(1); _Pragma("unroll") for (int m = 0; m < 4; ++m) _Pragma("unroll") for (int n = 0; n < 2; ++n) _Pragma("unroll") for (int k = 0; k < 2; ++k) \
        acc[ai][bj][m][n] = __builtin_amdgcn_mfma_f32_16x16x32_bf16(Bt[n][k], At[m][k], acc[ai][bj][m][n], 0, 0, 0); __builtin_amdgcn_s_setprio(0); } while (0)
#define PG8_WAIT_V(n) asm volatile("s_waitcnt vmcnt(" #n ")" ::: "memory")
#define PG8_WAIT_L(n) asm volatile("s_waitcnt lgkmcnt(" #n ")" ::: "memory")
#define PG8_BAR __builtin_amdgcn_s_barrier()
#define PG8_SCHED __builtin_amdgcn_sched_barrier(0)
    Unit cur, nxt; int ui = 0;
    if (!S.next(0, cur)) return;
    f32x4 acc[2][2][4][2];
#pragma unroll
    for (int a = 0; a < 2; ++a)
#pragma unroll
        for (int b = 0; b < 2; ++b)
#pragma unroll
            for (int m = 0; m < 4; ++m)
#pragma unroll
                for (int n = 0; n < 2; ++n) acc[a][b][m][n] = (f32x4){0.f, 0.f, 0.f, 0.f};
    bf16x8 At[4][2], B0[2][2], B1[2][2];
    const char* cA = (const char*)g.A + (size_t)cur.pm * tstep; const char* cB = (const char*)g.Bt + (size_t)cur.pn * tstep;
    S.a_ready(cur);
    if constexpr (SP2) {
        PG8_STAGE(PG8_SB(0, 0), cB, voffB); PG8_STAGE(PG8_SB(0, 1), cB + hstep, voffB); PG8_STAGE(PG8_SA(0, 0), cA, voffA); PG8_STAGE(PG8_SA(0, 1), cA + hstep, voffA);
        if (wr == 1) PG8_BAR;
        PG8_WAIT_V(2); PG8_BAR;
        PG8_STAGE(PG8_SB(1, 0), cB + kstep, voffB); PG8_STAGE(PG8_SA(1, 0), cA + kstep, voffA); PG8_STAGE(PG8_SB(1, 1), cB + hstep + kstep, voffB);
        PG8_WAIT_V(6); PG8_BAR;
    } else {
        PG8_STAGE(PG8_SB(0, 0), cB, voffB); PG8_STAGE(PG8_SA(0, 0), cA, voffA); PG8_STAGE(PG8_SB(0, 1), cB + hstep, voffB); PG8_STAGE(PG8_SA(0, 1), cA + hstep, voffA);
        if (wr == 1) PG8_BAR;
        PG8_WAIT_V(4); PG8_BAR;
        PG8_STAGE(PG8_SB(1, 0), cB + kstep, voffB); PG8_STAGE(PG8_SA(1, 0), cA + kstep, voffA); PG8_STAGE(PG8_SB(1, 1), cB + hstep + kstep, voffB);
        PG8_WAIT_V(6); PG8_BAR;
    }
    for (;;) {
        const bool has_next = S.next(ui + 1, nxt);
        const char* nA = has_next ? (const char*)g.A + (size_t)nxt.pm * tstep : cA; const char* nB = has_next ? (const char*)g.Bt + (size_t)nxt.pn * tstep : cB;
        for (int t = 0; t < nt; t += 2) {
            const bool last = (t == nt - 2);
            const char* a1 = cA + (size_t)(t + 1) * kstep;
            const char* a2 = last ? nA : cA + (size_t)(t + 2) * kstep; const char* b2 = last ? nB : cB + (size_t)(t + 2) * kstep;
            const char* a3 = a2 + kstep; const char* b3 = b2 + kstep;
            if (last && has_next) S.a_ready(nxt);
            if constexpr (SP2) {
            PG8_LDB(B0, 0, 0); PG8_LDB(B1, 0, 1); PG8_SCHED; PG8_LDA(At, 0, 0); PG8_STAGE(PG8_SA(1, 1), a1 + hstep, voffA);
            PG8_WAIT_V(8); PG8_WAIT_L(0); PG8_BAR; PG8_MMA(0, 0, At, B0); PG8_MMA(0, 1, At, B1); PG8_BAR; PG8_SCHED;
            PG8_LDA(At, 0, 1); PG8_STAGE(PG8_SB(0, 0), b2, voffB); PG8_STAGE(PG8_SB(0, 1), b2 + hstep, voffB); PG8_STAGE(PG8_SA(0, 0), a2, voffA);
            PG8_WAIT_V(8); PG8_WAIT_L(0); PG8_BAR; PG8_MMA(1, 0, At, B0); PG8_MMA(1, 1, At, B1); PG8_BAR; PG8_SCHED;
            PG8_LDB(B0, 1, 0); PG8_LDB(B1, 1, 1); PG8_SCHED; PG8_LDA(At, 1, 0); PG8_STAGE(PG8_SA(0, 1), a2 + hstep, voffA);
            PG8_WAIT_V(8); PG8_WAIT_L(0); PG8_BAR; PG8_MMA(0, 0, At, B0); PG8_MMA(0, 1, At, B1); PG8_BAR; PG8_SCHED;
            PG8_LDA(At, 1, 1); PG8_STAGE(PG8_SB(1, 0), b3, voffB); PG8_STAGE(PG8_SB(1, 1), b3 + hstep, voffB); PG8_STAGE(PG8_SA(1, 0), a3, voffA);
            PG8_WAIT_V(8); PG8_WAIT_L(0); PG8_BAR; PG8_MMA(1, 0, At, B0); PG8_MMA(1, 1, At, B1); PG8_BAR; PG8_SCHED;
            } else {
            PG8_LDB(B0, 0, 0); PG8_SCHED; PG8_LDA(At, 0, 0); PG8_STAGE(PG8_SA(1, 1), a1 + hstep, voffA);
            PG8_WAIT_L(8); PG8_BAR; PG8_WAIT_L(0); PG8_MMA(0, 0, At, B0); PG8_BAR; PG8_SCHED;
            PG8_LDB(B1, 0, 1); PG8_STAGE(PG8_SB(0, 0), b2, voffB);
            PG8_BAR; PG8_WAIT_L(0); PG8_MMA(0, 1, At, B1); PG8_BAR;
            PG8_LDA(At, 0, 1); PG8_STAGE(PG8_SA(0, 0), a2, voffA);
            PG8_BAR; PG8_WAIT_L(0); PG8_MMA(1, 0, At, B0); PG8_BAR; PG8_SCHED;
            PG8_STAGE(PG8_SB(0, 1), b2 + hstep, voffB);
            PG8_WAIT_V(6); PG8_BAR; PG8_MMA(1, 1, At, B1); PG8_BAR;
            PG8_LDB(B0, 1, 0); PG8_SCHED; PG8_LDA(At, 1, 0); PG8_STAGE(PG8_SA(0, 1), a2 + hstep, voffA);
            PG8_WAIT_L(8); PG8_BAR; PG8_WAIT_L(0); PG8_MMA(0, 0, At, B0); PG8_BAR; PG8_SCHED;
            PG8_LDB(B1, 1, 1); PG8_STAGE(PG8_SB(1, 0), b3, voffB);
            PG8_BAR; PG8_WAIT_L(0); PG8_MMA(0, 1, At, B1); PG8_BAR;
            PG8_LDA(At, 1, 1); PG8_STAGE(PG8_SA(1, 0), a3, voffA);
            PG8_BAR; PG8_WAIT_L(0); PG8_MMA(1, 0, At, B0); PG8_BAR; PG8_SCHED;
            PG8_STAGE(PG8_SB(1, 1), b3 + hstep, voffB);
            PG8_WAIT_V(6); PG8_BAR; PG8_MMA(1, 1, At, B1); PG8_BAR;
            }
        }
        if constexpr (ALIGN_EPI) { if (wr == 0) PG8_BAR; }
        if constexpr (!Epi::AFTER_DRAIN) { E(acc, cur, wr, wc, fr, fq); S.done(cur); }
        if (!has_next) break;
#pragma unroll
        for (int a = 0; a < 2; ++a)
#pragma unroll
            for (int b = 0; b < 2; ++b)
#pragma unroll
                for (int m = 0; m < 4; ++m)
#pragma unroll
                    for (int n = 0; n < 2; ++n) acc[a][b][m][n] = (f32x4){0.f, 0.f, 0.f, 0.f};
        cur = nxt; cA = nA; cB = nB; ++ui;
        if constexpr (ALIGN_EPI) { if (wr == 1) PG8_BAR; }
    }
    PG8_WAIT_V(0);
    if constexpr (!ALIGN_EPI) { if (wr == 0) PG8_BAR; }
    PG8_BAR;
    if constexpr (Epi::AFTER_DRAIN) { E.fused(acc, cur, wr, wc, fr, fq, lds, wid, lane); S.done(cur); }
#undef PG8_SA
#undef PG8_SB
#undef PG8_STAGE
#undef PG8_LDA
#undef PG8_LDB
#undef PG8_MMA
#undef PG8_WAIT_V
#undef PG8_WAIT_L
#undef PG8_BAR
#undef PG8_SCHED
}
}
using pg8::bf16_t; using pg8::bf16x8; using pg8::f32x4; using pg8::u32x4; using pg8::Unit; using pg8::Gemm; using pg8::StaticOrder;
typedef float f32x2 __attribute__((ext_vector_type(2)));
typedef unsigned u32x2 __attribute__((ext_vector_type(2)));
#define LAS __attribute__((address_space(3)))

#ifndef NAIVE_GEMM
#define NAIVE_GEMM 0
#endif
#ifndef R_PRO
#define R_PRO 1
#endif
#ifndef R_ATTN
#define R_ATTN 1
#endif
#ifndef R_CONV
#define R_CONV 1
#endif
#ifndef R_SYNC
#define R_SYNC 1
#endif
#ifndef R_UP
#define R_UP 1
#endif
#ifndef R_REST
#define R_REST 1
#endif
#ifndef R_POST
#define R_POST 1
#endif
#ifndef NAIVE_ATTN
#define NAIVE_ATTN 0
#endif
#ifndef NAIVE_CONV
#define NAIVE_CONV 0
#endif

constexpr int M = 16384, D = 1024, FF = 2816, SEQ = 2048, HC = 512, PLE = 256;
constexpr float EPS = 1e-6f;
constexpr size_t MiB = 1u << 20;
constexpr size_t WS_CTL = 0, WS_W = 1 * MiB, WS_FT = 45 * MiB, WS_PB = 53 * MiB, WS_XB = 69 * MiB, WS_R1 = 101 * MiB, WS_R2 = 197 * MiB, WS_END = 261 * MiB;
constexpr size_t W_GUA = 0, W_DA = 11 * MiB, W_IN = W_DA + 5767168, W_OUT = W_IN + 6 * MiB, W_GUB = W_OUT + 2 * MiB, W_DB = W_GUB + 11 * MiB, W_PG = W_DB + 5767168, W_PP = W_PG + 2 * MiB;
static_assert(W_PP + 512 * 1024 <= 44 * MiB, "weights");
constexpr int LDS_BYTES = 131072 + 4096;
constexpr size_t BAR_OFF = 640 * 1024;

struct KP { const float* in[30]; float* out; unsigned char* ws; };
typedef const __attribute__((address_space(4))) KP* KPC;
#define KPARAMS() ({ KPC q_ = (KPC)__builtin_amdgcn_kernarg_segment_ptr(); asm volatile("" : "+s"(q_)); q_; })

__device__ __forceinline__ unsigned cvt_pk_bf16(float lo, float hi) { unsigned r; asm volatile("v_cvt_pk_bf16_f32 %0, %1, %2" : "=v"(r) : "v"(lo), "v"(hi)); return r; }
__device__ __forceinline__ float bf_lo(unsigned w) { return __uint_as_float(w << 16); }
__device__ __forceinline__ float bf_hi(unsigned w) { return __uint_as_float(w & 0xffff0000u); }
__device__ __forceinline__ float bf2f(bf16_t b) { return __uint_as_float(((unsigned)b) << 16); }
__device__ __forceinline__ float wave_sum(float v) {
#pragma unroll
    for (int o = 1; o < 64; o <<= 1) v += __shfl_xor(v, o);
    return v;
}
__device__ __forceinline__ int fresh_tid(int wv) {
    int l; asm volatile("v_mbcnt_lo_u32_b32 %0, -1, 0\n\tv_mbcnt_hi_u32_b32 %0, -1, %0" : "=v"(l));
    return wv * 64 + l;
}
__device__ __forceinline__ int fresh_bx() { int b = blockIdx.x; asm volatile("" : "+s"(b)); return b; }
#define XB_TMO      128
#define XB_XCNT(j)  (256  + 64 * (j))
#define XB_XSUB(j)  (1280 + 64 * (j))
#define XB_XGEN(j)  (2304 + 64 * (j))
#define XB_TOP      3328
#define XB_TOPGEN   3392
#define XCD_BAR_WORDS 3456
#define XB_SPIN_CAP (1u << 18)

__device__ __forceinline__ unsigned xb_ld(unsigned* p)              { return __hip_atomic_load(p, __ATOMIC_RELAXED, __HIP_MEMORY_SCOPE_AGENT); }
__device__ __forceinline__ unsigned xb_add(unsigned* p, unsigned v) { return __hip_atomic_fetch_add(p, v, __ATOMIC_RELAXED, __HIP_MEMORY_SCOPE_AGENT); }
__device__ __forceinline__ unsigned xb_xcc_id() { return (unsigned)__builtin_amdgcn_s_getreg((3 << 11) | 20) & 0xFu; }
#define XB_SPIN(cond, bar) do { unsigned _sp = 0; while (cond) { __builtin_amdgcn_s_sleep(1); \
    if ((++_sp & 255u) == 0u) { if (xb_ld(&(bar)[XB_TMO])) break; if (_sp > XB_SPIN_CAP) { atomicAdd(&(bar)[XB_TMO], 1u); break; } } } } while (0)

struct XcdBarrier {
    unsigned* bar; unsigned x;
    volatile LAS unsigned* st;
};

__device__ __forceinline__ XcdBarrier xcd_barrier_post(unsigned* bar, volatile LAS unsigned* st, int wv) {
    XcdBarrier b; b.bar = bar; b.x = xb_xcc_id(); b.st = st;
    if (fresh_tid(wv) == 0) (void)xb_add(&bar[XB_XCNT(b.x)], 1u);
    return b;
}
__device__ __forceinline__ void xcd_barrier_complete(unsigned* bar, unsigned x, unsigned& nloc, unsigned& nx) {
    const unsigned G = gridDim.x * gridDim.y * gridDim.z;
    unsigned sum, cnt, mine, sp = 0u;
    for (;;) {
        sum = 0u; cnt = 0u; mine = 0u;
#pragma unroll
        for (unsigned j = 0; j < 16; ++j) { const unsigned c = xb_ld(&bar[XB_XCNT(j)]); sum += c; cnt += (c > 0u) ? 1u : 0u; mine = (j == x) ? c : mine; }
        if (sum == G) break;
        __builtin_amdgcn_s_sleep(1);
        if ((++sp & 255u) == 0u) { if (xb_ld(&bar[XB_TMO])) break; if (sp > XB_SPIN_CAP) { atomicAdd(&bar[XB_TMO], 1u); break; } }
    }
    nloc = mine > 0u ? mine : 1u; nx = cnt > 0u ? cnt : 1u;
}

__device__ __forceinline__ void xcd_barrier(const XcdBarrier& b, int wv) {
    asm volatile("s_waitcnt vmcnt(0)" ::: "memory");
    __syncthreads();
    if (fresh_tid(wv) == 0) {
        unsigned* bar = b.bar;
        __builtin_amdgcn_s_waitcnt(0);
        unsigned nloc = b.st[0], nx = b.st[1];
        if (nloc == 0u) { xcd_barrier_complete(bar, b.x, nloc, nx); b.st[0] = nloc; b.st[1] = nx; }
        const unsigned old = xb_add(&bar[XB_XSUB(b.x)], 1u);
        const unsigned gen = old / nloc;
        if (old + 1u == (gen + 1u) * nloc) {
            __builtin_amdgcn_fence(__ATOMIC_RELEASE, "agent");
            asm volatile("s_waitcnt vmcnt(0)" ::: "memory");
            const unsigned og = xb_add(&bar[XB_TOP], 1u);
            const unsigned tg = og / nx;
            if (og + 1u == (tg + 1u) * nx) xb_add(&bar[XB_TOPGEN], 1u);
            else XB_SPIN(xb_ld(&bar[XB_TOPGEN]) == tg, bar);
            __builtin_amdgcn_fence(__ATOMIC_ACQUIRE, "agent");
            xb_add(&bar[XB_XGEN(b.x)], 1u);
            asm volatile("s_waitcnt vmcnt(0)" ::: "memory");
        } else {
            XB_SPIN(xb_ld(&bar[XB_XGEN(b.x)]) == gen, bar);
            __builtin_amdgcn_fence(__ATOMIC_ACQUIRE, "agent");
            asm volatile("s_waitcnt vmcnt(0)" ::: "memory");
        }
    }
    __syncthreads();
}

__device__ __forceinline__ float rstd_of(float ss, float invn) { return rsqrtf(ss * invn + EPS); }

struct EpiSwiGLU {
    static constexpr bool PERM = true, AFTER_DRAIN = false;
    bf16_t* H; const float* ss;
    __device__ __forceinline__ void operator()(const f32x4 (&acc)[2][2][4][2], const Unit& u, int wr, int wc, int fr, int fq) const {
        const int row0 = u.pm * 256 + wr * 64 + fr, col0 = u.pn * 128 + wc * 32 + 8 * fq;
#pragma unroll
        for (int ai = 0; ai < 2; ++ai)
#pragma unroll
            for (int m = 0; m < 4; ++m) {
                const int row = row0 + ai * 128 + m * 16;
                const float rs = rstd_of(ss[row], 1.0f / D);
                unsigned w[4];
#pragma unroll
                for (int n = 0; n < 2; ++n) {
                    float hv[4];
#pragma unroll
                    for (int e = 0; e < 4; ++e) {
                        const float g = acc[ai][0][m][n][e] * rs, uu = acc[ai][1][m][n][e] * rs;
                        hv[e] = g * __builtin_amdgcn_rcpf(1.0f + __expf(-g)) * uu;
                    }
                    w[2 * n] = cvt_pk_bf16(hv[0], hv[1]); w[2 * n + 1] = cvt_pk_bf16(hv[2], hv[3]);
                }
                *(u32x4*)(H + (size_t)row * FF + col0) = (u32x4){w[0], w[1], w[2], w[3]};
            }
    }
};
struct EpiResid {
    static constexpr bool PERM = false, AFTER_DRAIN = false;
    const float* base; float* X; bf16_t* xb; float* ssn; float alpha;
    __device__ __forceinline__ void operator()(const f32x4 (&acc)[2][2][4][2], const Unit& u, int wr, int wc, int fr, int fq) const {
        const int row0 = u.pm * 256 + wr * 64 + fr, col0 = u.pn * 256 + wc * 32 + 4 * fq;
#pragma unroll
        for (int ai = 0; ai < 2; ++ai)
#pragma unroll
            for (int m = 0; m < 4; ++m) {
                const int row = row0 + ai * 128 + m * 16; float sq = 0.f;
#pragma unroll
                for (int bj = 0; bj < 2; ++bj)
#pragma unroll
                    for (int n = 0; n < 2; ++n) {
                        const size_t off = (size_t)row * D + col0 + bj * 128 + n * 16;
                        const f32x4 bs = *(const f32x4*)(base + off);
                        const f32x4 o = bs + acc[ai][bj][m][n] * alpha;
                        *(f32x4*)(X + off) = o;
                        *(u32x2*)(xb + off) = (u32x2){cvt_pk_bf16(o[0], o[1]), cvt_pk_bf16(o[2], o[3])};
                        sq += (o[0] * o[0] + o[1] * o[1]) + (o[2] * o[2] + o[3] * o[3]);
                    }
                sq += __shfl_xor(sq, 16); sq += __shfl_xor(sq, 32);
                if (fq == 0) unsafeAtomicAdd(ssn + row, sq);
                asm volatile("" ::: "memory");
            }
    }
};
struct EpiPle {
    static constexpr bool PERM = false, AFTER_DRAIN = false;
    float* X; const float* PP; const float* ss; bf16_t* xb; float* ssn;
    __device__ __forceinline__ void operator()(const f32x4 (&acc)[2][2][4][2], const Unit& u, int wr, int wc, int fr, int fq) const {
        const int row0 = u.pm * 256 + wr * 64 + fr, col0 = u.pn * 256 + wc * 32 + 4 * fq;
#pragma unroll
        for (int ai = 0; ai < 2; ++ai)
#pragma unroll
            for (int m = 0; m < 4; ++m) {
                const int row = row0 + ai * 128 + m * 16; float sq = 0.f;
                const float rs = rstd_of(ss[row], 1.0f / D);
#pragma unroll
                for (int bj = 0; bj < 2; ++bj)
#pragma unroll
                    for (int n = 0; n < 2; ++n) {
                        const size_t off = (size_t)row * D + col0 + bj * 128 + n * 16;
                        const f32x4 bs = *(const f32x4*)(X + off);
                        const f32x4 pp = *(const f32x4*)(PP + off);
                        f32x4 o;
#pragma unroll
                        for (int e = 0; e < 4; ++e) { const float a = acc[ai][bj][m][n][e] * rs; o[e] = bs[e] + __builtin_amdgcn_rcpf(1.0f + __expf(-a)) * pp[e]; }
                        *(f32x4*)(X + off) = o;
                        *(u32x2*)(xb + off) = (u32x2){cvt_pk_bf16(o[0], o[1]), cvt_pk_bf16(o[2], o[3])};
                        sq += (o[0] * o[0] + o[1] * o[1]) + (o[2] * o[2] + o[3] * o[3]);
                    }
                sq += __shfl_xor(sq, 16); sq += __shfl_xor(sq, 32);
                if (fq == 0) unsafeAtomicAdd(ssn + row, sq);
                asm volatile("" ::: "memory");
            }
    }
};
struct EpiScaleRow {
    static constexpr bool PERM = true, AFTER_DRAIN = false;
    bf16_t* O; int ldc; const float* ss;
    __device__ __forceinline__ void operator()(const f32x4 (&acc)[2][2][4][2], const Unit& u, int wr, int wc, int fr, int fq) const {
        const int row0 = u.pm * 256 + wr * 64 + fr, col0 = u.pn * 256 + wc * 32 + 8 * fq;
#pragma unroll
        for (int ai = 0; ai < 2; ++ai)
#pragma unroll
            for (int m = 0; m < 4; ++m) {
                const int row = row0 + ai * 128 + m * 16;
                const float rs = rstd_of(ss[row], 1.0f / D);
#pragma unroll
                for (int bj = 0; bj < 2; ++bj) {
                    const f32x4 v0 = acc[ai][bj][m][0] * rs, v1 = acc[ai][bj][m][1] * rs;
                    *(u32x4*)(O + (size_t)row * ldc + col0 + bj * 128) = (u32x4){cvt_pk_bf16(v0[0], v0[1]), cvt_pk_bf16(v0[2], v0[3]), cvt_pk_bf16(v1[0], v1[1]), cvt_pk_bf16(v1[2], v1[3])};
                }
            }
    }
};
struct EpiScaleCol {
    static constexpr bool PERM = true, AFTER_DRAIN = false;
    bf16_t* O; int ldc; const float* ss;
    __device__ __forceinline__ void operator()(const f32x4 (&acc)[2][2][4][2], const Unit& u, int wr, int wc, int fr, int fq) const {
        const int row0 = u.pm * 256 + wr * 64 + fr, col0 = u.pn * 256 + wc * 32 + 8 * fq;
#pragma unroll
        for (int bj = 0; bj < 2; ++bj) {
            float rs[8];
            {
                const f32x4 a = *(const f32x4*)(ss + col0 + bj * 128), b = *(const f32x4*)(ss + col0 + bj * 128 + 4);
#pragma unroll
                for (int e = 0; e < 4; ++e) { rs[e] = rstd_of(a[e], 1.0f / D); rs[4 + e] = rstd_of(b[e], 1.0f / D); }
            }
#pragma unroll
            for (int ai = 0; ai < 2; ++ai)
#pragma unroll
                for (int m = 0; m < 4; ++m) {
                    const int row = row0 + ai * 128 + m * 16;
                    const f32x4 v0 = acc[ai][bj][m][0], v1 = acc[ai][bj][m][1];
                    *(u32x4*)(O + (size_t)row * ldc + col0 + bj * 128) = (u32x4){cvt_pk_bf16(v0[0] * rs[0], v0[1] * rs[1]), cvt_pk_bf16(v0[2] * rs[2], v0[3] * rs[3]),
                                                                                  cvt_pk_bf16(v1[0] * rs[4], v1[1] * rs[5]), cvt_pk_bf16(v1[2] * rs[6], v1[3] * rs[7])};
                }
        }
    }
};
struct EpiStoreF32 {
    static constexpr bool PERM = false, AFTER_DRAIN = false;
    float* O; int ldc;
    __device__ __forceinline__ void operator()(const f32x4 (&acc)[2][2][4][2], const Unit& u, int wr, int wc, int fr, int fq) const {
        const int row0 = u.pm * 256 + wr * 64 + fr, col0 = u.pn * 256 + wc * 32 + 4 * fq;
#pragma unroll
        for (int ai = 0; ai < 2; ++ai)
#pragma unroll
            for (int m = 0; m < 4; ++m)
#pragma unroll
                for (int bj = 0; bj < 2; ++bj)
#pragma unroll
                    for (int n = 0; n < 2; ++n) *(f32x4*)(O + (size_t)(row0 + ai * 128 + m * 16) * ldc + col0 + bj * 128 + n * 16) = acc[ai][bj][m][n];
    }
};

struct EpiDry {
    static constexpr bool PERM = false, AFTER_DRAIN = false;
    __device__ __forceinline__ void operator()(const f32x4 (&acc)[2][2][4][2], const Unit& u, int wr, int wc, int fr, int fq) const {
#pragma unroll
        for (int ai = 0; ai < 2; ++ai)
#pragma unroll
            for (int bj = 0; bj < 2; ++bj)
#pragma unroll
                for (int m = 0; m < 4; ++m)
#pragma unroll
                    for (int n = 0; n < 2; ++n) asm volatile("" :: "v"(acc[ai][bj][m][n]));
    }
};
template <class Epi>
__device__ __forceinline__ void gemm_naive(int wv, const Gemm g, const StaticOrder& S, const Epi& E) {
    const int tid = fresh_tid(wv), wid = tid >> 6, lane = tid & 63, wr = wid >> 2, wc = wid & 3, fr = lane & 15, fq = lane >> 4;
    Unit u;
    for (int ui = 0; S.next(ui, u); ++ui) {
        f32x4 acc[2][2][4][2];
#pragma unroll
        for (int a = 0; a < 2; ++a)
#pragma unroll
            for (int b = 0; b < 2; ++b)
#pragma unroll
                for (int m = 0; m < 4; ++m)
#pragma unroll
                    for (int n = 0; n < 2; ++n) acc[a][b][m][n] = (f32x4){0.f, 0.f, 0.f, 0.f};
        for (int k0 = 0; k0 < g.K; k0 += 32) {
            bf16x8 Bf[2][2];
#pragma unroll
            for (int bj = 0; bj < 2; ++bj)
#pragma unroll
                for (int n = 0; n < 2; ++n) {
                    const int slot = 16 * n + fr; const int rr = Epi::PERM ? pg8::perm32(slot) : slot;
                    Bf[bj][n] = *(const bf16x8*)(g.Bt + (size_t)(u.pn * 256 + bj * 128 + wc * 32 + rr) * g.K + k0 + 8 * fq);
                }
#pragma unroll
            for (int ai = 0; ai < 2; ++ai)
#pragma unroll
                for (int m = 0; m < 4; ++m) {
                    const bf16x8 Af = *(const bf16x8*)(g.A + (size_t)(u.pm * 256 + ai * 128 + wr * 64 + m * 16 + fr) * g.K + k0 + 8 * fq);
#pragma unroll
                    for (int bj = 0; bj < 2; ++bj)
#pragma unroll
                        for (int n = 0; n < 2; ++n) acc[ai][bj][m][n] = __builtin_amdgcn_mfma_f32_16x16x32_bf16(Bf[bj][n], Af, acc[ai][bj][m][n], 0, 0, 0);
                }
        }
        E(acc, u, wr, wc, fr, fq);
    }
}
template <class Epi>
__device__ __forceinline__ void gemm_run(int wv, LAS unsigned char* lds, const bf16_t* A, const bf16_t* Bt, int Mm, int Nn, int Kk, const Epi& E) {
    int bx_ = blockIdx.x; asm volatile("" : "+s"(bx_));
    Gemm g{A, Bt, Mm, Nn, Kk}; StaticOrder S; S.init(Mm, Nn, (int)gridDim.x, bx_);
#if NAIVE_GEMM
    gemm_naive<Epi>(wv, g, S, E);
    __syncthreads();
#else
    pg8::gemm_phase<Epi, StaticOrder, true, true>(lds, g, S, E, fresh_tid(wv));
#endif
}

__device__ __forceinline__ void transpose_item(const float* W, int K, int N, const float* gain, bf16_t* WT, int mode, int row_off, LAS float* scr, int item, int lane) {
    const int nblk = N / 32, kb = item / nblk, nb = item % nblk, k0 = 64 * kb, n0 = 32 * nb;
    f32x4 v[8];
#pragma unroll
    for (int i = 0; i < 8; ++i) v[i] = *(const f32x4*)(W + (size_t)(k0 + (lane >> 3) + 8 * i) * N + n0 + 4 * (lane & 7));
#pragma unroll
    for (int i = 0; i < 8; ++i) {
        const int kk = (lane >> 3) + 8 * i; const float gg = gain ? gain[k0 + kk] : 1.0f;
        LAS float* d = scr + kk * 33 + 4 * (lane & 7);
        d[0] = v[i][0] * gg; d[1] = v[i][1] * gg; d[2] = v[i][2] * gg; d[3] = v[i][3] * gg;
    }
    asm volatile("s_waitcnt lgkmcnt(0)" ::: "memory");
    const int c = lane & 7;
#pragma unroll
    for (int j = 0; j < 4; ++j) {
        const int n = (lane >> 3) + 8 * j, ncol = n0 + n; const LAS float* s = scr + (8 * c) * 33 + n;
        const int row = (mode == 1) ? (256 * (ncol >> 7) + (ncol & 127) + row_off) : (row_off + ncol);
        const float sc = (mode == 2 && ncol < 512) ? 0.125f : 1.0f;
        u32x4 o; o.x = cvt_pk_bf16(s[0 * 33] * sc, s[1 * 33] * sc); o.y = cvt_pk_bf16(s[2 * 33] * sc, s[3 * 33] * sc); o.z = cvt_pk_bf16(s[4 * 33] * sc, s[5 * 33] * sc); o.w = cvt_pk_bf16(s[6 * 33] * sc, s[7 * 33] * sc);
        *(u32x4*)(WT + (size_t)row * K + k0 + 8 * c) = o;
    }
    asm volatile("s_waitcnt lgkmcnt(0)" ::: "memory");
}

constexpr float MIN_DECAY = -3.0701134573253946f, MAX_DECAY = -15.350567286626973f;
__device__ __forceinline__ float rdl(float v, int k) { return __shfl(v, k); }
__device__ __forceinline__ void filter_item(KPC p, int layer, int item, int lane, float* FT) {
    const float* wf1 = p->in[11] + layer * 33 * 64; const float* bf1 = p->in[12] + layer * 64;
    const float* wf2 = p->in[13] + layer * 4096;    const float* bf2 = p->in[14] + layer * 64;
    const float* wf3 = p->in[15] + layer * 4096;    const float* bf3 = p->in[16] + layer * 64;
    const float* wf4 = p->in[17] + layer * 64 * 1024; const float fq = p->in[18][layer * 64 + lane];
    const int i0 = item * 2;
    float h[2], wc[64];
#pragma unroll
    for (int k = 0; k < 33; ++k) wc[k] = wf1[k * 64 + lane];
    const float bb1 = bf1[lane], bb2 = bf2[lane], bb3 = bf3[lane];
#pragma unroll
    for (int q = 0; q < 2; ++q) {
        const int i = i0 + q;
        const float t = (float)i * (1.0f / 2047.0f), w = 6.283185307179586f * (float)i / 2048.0f;
        const int j = (lane - 1) & 15; const float f = 1e-4f + (float)j * ((15.0f - 1e-4f) / 15.0f);
        const float a = f * w;
        float zf = 0.f;
        if (lane == 0) zf = t; else if (lane <= 16) zf = __cosf(a); else if (lane <= 32) zf = -__sinf(a);
        float s = bb1;
#pragma unroll
        for (int k = 0; k < 33; ++k) s += rdl(zf, k) * wc[k];
        h[q] = __sinf(fq * s);
    }
#pragma unroll
    for (int k = 0; k < 64; ++k) wc[k] = wf2[k * 64 + lane];
#pragma unroll
    for (int q = 0; q < 2; ++q) {
        float s = bb2;
#pragma unroll
        for (int k = 0; k < 64; ++k) s += rdl(h[q], k) * wc[k];
        h[q] = __sinf(fq * s);
    }
#pragma unroll
    for (int k = 0; k < 64; ++k) wc[k] = wf3[k * 64 + lane];
#pragma unroll
    for (int q = 0; q < 2; ++q) {
        float s = bb3;
#pragma unroll
        for (int k = 0; k < 64; ++k) s += rdl(h[q], k) * wc[k];
        h[q] = __sinf(fq * s);
    }
    float acc[2][16];
#pragma unroll
    for (int q = 0; q < 2; ++q)
#pragma unroll
        for (int jj = 0; jj < 16; ++jj) acc[q][jj] = 0.f;
    for (int k0 = 0; k0 < 64; k0 += 4) {
        float w[4][16];
#pragma unroll
        for (int kk = 0; kk < 4; ++kk)
#pragma unroll
            for (int jj = 0; jj < 16; ++jj) w[kk][jj] = wf4[(k0 + kk) * 1024 + lane + 64 * jj];
#pragma unroll
        for (int kk = 0; kk < 4; ++kk) {
            const float h0 = rdl(h[0], k0 + kk), h1 = rdl(h[1], k0 + kk);
#pragma unroll
            for (int jj = 0; jj < 16; ++jj) { acc[0][jj] += h0 * w[kk][jj]; acc[1][jj] += h1 * w[kk][jj]; }
        }
    }
#pragma unroll
    for (int jj = 0; jj < 16; ++jj) {
        const int cf = lane + 64 * jj, dir = cf >> 9, c = cf & 511;
        const float delta = fabsf(MIN_DECAY + (float)c * ((MAX_DECAY - MIN_DECAY) / 511.0f));
        f32x2 o;
#pragma unroll
        for (int q = 0; q < 2; ++q) { const float t = (float)(i0 + q) * (1.0f / 2047.0f); o[q] = acc[q][jj] * __expf(-t * delta); }
        *(f32x2*)(FT + ((size_t)(dir * 512 + c)) * SEQ + i0) = o;
    }
}

__device__ __forceinline__ void layer_prologue(int wv, KPC p, int layer, LAS unsigned char* lds) {
    const int tid = fresh_tid(wv), bx = fresh_bx(), lane = tid & 63, wave = tid >> 6;
    LAS float* scr = (LAS float*)(lds + wave * 16384);
    const int gw = bx * 8 + wave, NGW = gridDim.x * 8;
    unsigned char* Wb = p->ws + WS_W;
    const size_t lf = (size_t)layer;
    constexpr int I_G = 16 * 88, I_D = 44 * 32, I_IN = 16 * 96, I_O = 16 * 32, I_PP = 4 * 32;
    constexpr int NITEMS = 6 * I_G + I_IN + 2 * I_O + I_PP;
    static_assert(I_G == I_D, "items");
    for (int it = gw; it < NITEMS + 1024; it += NGW) {
        if (it < 1024) { filter_item(p, layer, it, lane, (float*)(p->ws + WS_FT)); continue; }
        int r = it - 1024;
        int wi, gi = -1, K = D, N = FF, mode = 1, row_off = 0; size_t wo = W_GUA, wstride = (size_t)D * FF;
        if (r < I_G) { wi = 3; gi = 2; }
        else if ((r -= I_G) < I_G) { wi = 4; gi = 2; row_off = 128; }
        else if ((r -= I_G) < I_D) { wi = 5; K = FF; N = D; mode = 0; wo = W_DA; }
        else if ((r -= I_D) < I_IN) { wi = 7; gi = 6; N = 3072; mode = 2; wo = W_IN; wstride = (size_t)D * 3072; }
        else if ((r -= I_IN) < I_O) { wi = 21; gi = 20; N = D; mode = 0; wo = W_OUT; wstride = (size_t)D * D; }
        else if ((r -= I_O) < I_G) { wi = 23; gi = 22; wo = W_GUB; }
        else if ((r -= I_G) < I_G) { wi = 24; gi = 22; row_off = 128; wo = W_GUB; }
        else if ((r -= I_G) < I_D) { wi = 25; K = FF; N = D; mode = 0; wo = W_DB; }
        else if ((r -= I_D) < I_O) { wi = 27; gi = 26; N = D; mode = 0; wo = W_PG; wstride = (size_t)D * D; }
        else { r -= I_O; wi = 28; K = PLE; N = D; mode = 0; wo = W_PP; wstride = (size_t)PLE * D; }
        const float* gain = gi >= 0 ? p->in[gi] + lf * D : nullptr;
        transpose_item(p->in[wi] + lf * wstride, K, N, gain, (bf16_t*)(Wb + wo), mode, row_off, scr, r, lane);
    }
    if (layer == 0) {
        bf16_t* xb = (bf16_t*)(p->ws + WS_XB); float* ss0 = (float*)(p->ws + WS_CTL);
        for (int m = gw; m < M; m += NGW) {
            const f32x4* xr = (const f32x4*)(p->in[0] + (size_t)m * D) + lane;
            f32x4 v[4]; float s = 0.f;
#pragma unroll
            for (int j = 0; j < 4; ++j) { v[j] = xr[64 * j]; s += (v[j][0] * v[j][0] + v[j][1] * v[j][1]) + (v[j][2] * v[j][2] + v[j][3] * v[j][3]); }
            s = wave_sum(s);
            if (lane == 0) ss0[m] = s;
            u32x2* o8 = (u32x2*)(xb + (size_t)m * D) + lane;
#pragma unroll
            for (int j = 0; j < 4; ++j) o8[64 * j] = (u32x2){cvt_pk_bf16(v[j][0], v[j][1]), cvt_pk_bf16(v[j][2], v[j][3])};
        }
        bf16_t* pb = (bf16_t*)(p->ws + WS_PB);
        const size_t n8 = (size_t)2 * M * PLE / 8;
        for (size_t i = (size_t)bx * 512 + tid; i < n8; i += (size_t)gridDim.x * 512) {
            const f32x4 a = *(const f32x4*)(p->in[1] + i * 8), b = *(const f32x4*)(p->in[1] + i * 8 + 4);
            *(u32x4*)(pb + i * 8) = (u32x4){cvt_pk_bf16(a[0], a[1]), cvt_pk_bf16(a[2], a[3]), cvt_pk_bf16(b[0], b[1]), cvt_pk_bf16(b[2], b[3])};
        }
    }
}

__device__ __forceinline__ void attn_naive(int wv, KPC p, int layer, const bf16_t* QK, const bf16_t* UT, bf16_t* yna) {
    const float* rpb = p->in[8] + layer * 8 * 15 * 31;
    const int tid = fresh_tid(wv), bx = fresh_bx();
    for (int it = bx * 512 + tid; it < M * 8; it += gridDim.x * 512) {
        const int h = it / M, tok = it % M;
        const int b = tok >> 11, l = tok & 2047, r = l >> 6, qc = l & 63;
        const int rs = min(max(r - 4, 0), 24), qcs = min(max(qc - 8, 0), 48);
        float o[64]; u32x4 qp[8];
#pragma unroll
        for (int j = 0; j < 8; ++j) qp[j] = *(const u32x4*)(QK + (size_t)tok * 1024 + 64 * h + 8 * j);
#pragma unroll
        for (int d = 0; d < 64; ++d) o[d] = 0.f;
        float mx = -3.0e38f, ls = 0.f;
        for (int kr = 0; kr < 8; ++kr)
            for (int kx = 0; kx < 16; ++kx) {
                const int krow = rs + kr, kc = qcs + kx; const size_t ktok = (size_t)b * 2048 + krow * 64 + kc;
                float s = 0.f;
#pragma unroll
                for (int j = 0; j < 8; ++j) {
                    const u32x4 v = *(const u32x4*)(QK + ktok * 1024 + 512 + 64 * h + 8 * j);
                    const u32x4 qq = qp[j];
                    s += bf_lo(qq.x) * bf_lo(v.x) + bf_hi(qq.x) * bf_hi(v.x) + bf_lo(qq.y) * bf_lo(v.y) + bf_hi(qq.y) * bf_hi(v.y)
                       + bf_lo(qq.z) * bf_lo(v.z) + bf_hi(qq.z) * bf_hi(v.z) + bf_lo(qq.w) * bf_lo(v.w) + bf_hi(qq.w) * bf_hi(v.w);
                }
                s += rpb[(h * 15 + (krow - r + 7)) * 31 + (kc - qc + 15)];
                const float mn = fmaxf(mx, s), corr = __expf(mx - mn), pe = __expf(s - mn);
                ls = ls * corr + pe; mx = mn;
#pragma unroll
                for (int d = 0; d < 64; ++d) o[d] = o[d] * corr + pe * bf2f(UT[(size_t)(64 * h + d) * M + ktok]);
            }
        const float inv = 1.0f / ls;
#pragma unroll
        for (int j = 0; j < 8; ++j)
            *(u32x4*)(yna + (size_t)tok * 512 + 64 * h + 8 * j) = (u32x4){cvt_pk_bf16(o[8 * j] * inv, o[8 * j + 1] * inv), cvt_pk_bf16(o[8 * j + 2] * inv, o[8 * j + 3] * inv),
                                                                         cvt_pk_bf16(o[8 * j + 4] * inv, o[8 * j + 5] * inv), cvt_pk_bf16(o[8 * j + 6] * inv, o[8 * j + 7] * inv)};
    }
}

__device__ __forceinline__ float sconv(const bf16_t* row, int t, float w0, float w1, float w2, float bb) {
    const float a = t > 0 ? bf2f(row[t - 1]) : 0.f, b = bf2f(row[t]), c = t < SEQ - 1 ? bf2f(row[t + 1]) : 0.f;
    return a * w0 + b * w1 + c * w2 + bb;
}
__device__ __forceinline__ void conv_naive(int wv, KPC p, int layer, LAS unsigned char* lds, const bf16_t* UT, const float* FT, bf16_t* yhyT) {
    LAS float* karr = (LAS float*)lds; LAS float* zf = karr + 4096; LAS float* x0f = zf + 2048; LAS float* red = x0f + 2048;
    const float* wsc = p->in[9] + layer * 3 * 1536; const float* bsc = p->in[10] + layer * 1536; const float* hyb = p->in[19] + layer * 512;
    const int tid = fresh_tid(wv), bx = fresh_bx(), lane = tid & 63, wave = tid >> 6;
    for (int it = bx; it < 512 * 8; it += gridDim.x) {
        const int c = it >> 3, b = it & 7;
        __syncthreads();
        float asum = 0.f;
        for (int d = tid; d < 4096; d += 512) {
            const int dd = d - 2048; float v;
            if (dd == -2048) v = 0.f; else if (dd == 0) v = FT[(size_t)c * SEQ] + FT[(size_t)(512 + c) * SEQ]; else if (dd > 0) v = FT[(size_t)c * SEQ + dd]; else v = FT[(size_t)(512 + c) * SEQ - dd];
            karr[d] = v; asum += fabsf(v);
        }
        {
            const bf16_t* r0 = UT + (size_t)(512 + c) * M + b * 2048; const bf16_t* r1 = UT + (size_t)(1024 + c) * M + b * 2048; const bf16_t* r2 = UT + (size_t)(1536 + c) * M + b * 2048;
            const float a0 = wsc[c], a1 = wsc[1536 + c], a2 = wsc[3072 + c], ab = bsc[c];
            const float b0 = wsc[512 + c], b1 = wsc[1536 + 512 + c], b2 = wsc[3072 + 512 + c], bb = bsc[512 + c];
            const float c0 = wsc[1024 + c], c1 = wsc[1536 + 1024 + c], c2 = wsc[3072 + 1024 + c], cb = bsc[1024 + c];
            for (int t = tid; t < 2048; t += 512) {
                x0f[t] = sconv(r0, t, a0, a1, a2, ab);
                zf[t] = sconv(r1, t, b0, b1, b2, bb) * sconv(r2, t, c0, c1, c2, cb);
            }
        }
        asum = wave_sum(asum);
        if (lane == 0) red[wave] = asum;
        __syncthreads();
        float kn = 0.f;
#pragma unroll
        for (int w = 0; w < 8; ++w) kn += red[w];
        const float ikn = 1.0f / kn, hb = hyb[c];
#pragma unroll
        for (int e = 0; e < 4; ++e) {
            const int t = tid + 512 * e; float acc = 0.f;
            for (int s = 0; s < 2048; ++s) acc += karr[t - s + 2048] * zf[s];
            const float y = x0f[t] * (acc * ikn + zf[t] * hb);
            yhyT[(size_t)c * M + b * 2048 + t] = (bf16_t)(cvt_pk_bf16(y, 0.f) & 0xffffu);
        }
    }
}


__device__ __forceinline__ void attn_mfma(int wv, KPC p, int layer, const bf16_t* QK, const bf16_t* UT, bf16_t* yna) {
    const float* rpb = p->in[8] + layer * 8 * 15 * 31;
    const int tid = fresh_tid(wv), bx = fresh_bx(), lane = tid & 63, qi = lane & 15, g = lane >> 4;
    for (int it = bx * 8 + wv; it < 8192; it += gridDim.x * 8) {
        const int h = it & 7, j = (it >> 3) & 3, r = (it >> 5) & 31, b = it >> 10;
        const int rs = min(max(r - 4, 0), 24), bc0 = min(max(16 * j - 8, 0), 32);
        const int qc = 16 * j + qi, qcs = min(max(qc - 8, 0), 48);
        const size_t qtok = (size_t)b * 2048 + r * 64 + qc;
        const bf16x8 qf0 = *(const bf16x8*)(QK + qtok * 1024 + 64 * h + 8 * g), qf1 = *(const bf16x8*)(QK + qtok * 1024 + 64 * h + 32 + 8 * g);
        f32x4 s[16];
#pragma unroll
        for (int T = 0; T < 16; ++T) {
            const size_t ktok = (size_t)b * 2048 + (rs + (T >> 1)) * 64 + bc0 + 8 * (qi >> 2) + 4 * (T & 1) + (qi & 3);
            const bf16x8 k0 = *(const bf16x8*)(QK + ktok * 1024 + 512 + 64 * h + 8 * g), k1 = *(const bf16x8*)(QK + ktok * 1024 + 512 + 64 * h + 32 + 8 * g);
            f32x4 z = (f32x4){0.f, 0.f, 0.f, 0.f};
            z = __builtin_amdgcn_mfma_f32_16x16x32_bf16(k0, qf0, z, 0, 0, 0);
            z = __builtin_amdgcn_mfma_f32_16x16x32_bf16(k1, qf1, z, 0, 0, 0);
            s[T] = z;
        }
        float mx = -3.0e38f;
#pragma unroll
        for (int T = 0; T < 16; ++T)
#pragma unroll
            for (int e = 0; e < 4; ++e) {
                const int kc = bc0 + 8 * g + 4 * (T & 1) + e, kr = rs + (T >> 1);
                const bool valid = (kc >= qcs) && (kc < qcs + 16);
                float v = -3.0e38f;
                if (valid) v = s[T][e] + rpb[(h * 15 + kr - r + 7) * 31 + kc - qc + 15];
                s[T][e] = v; mx = fmaxf(mx, v);
            }
        mx = fmaxf(mx, __shfl_xor(mx, 16)); mx = fmaxf(mx, __shfl_xor(mx, 32));
        float ls = 0.f;
#pragma unroll
        for (int T = 0; T < 16; ++T)
#pragma unroll
            for (int e = 0; e < 4; ++e) { const float pe = __expf(s[T][e] - mx); s[T][e] = pe; ls += pe; }
        ls += __shfl_xor(ls, 16); ls += __shfl_xor(ls, 32);
        f32x4 o[4];
#pragma unroll
        for (int dt = 0; dt < 4; ++dt) o[dt] = (f32x4){0.f, 0.f, 0.f, 0.f};
#pragma unroll
        for (int kr = 0; kr < 8; ++kr) {
            const u32x4 pw = (u32x4){cvt_pk_bf16(s[2 * kr][0], s[2 * kr][1]), cvt_pk_bf16(s[2 * kr][2], s[2 * kr][3]), cvt_pk_bf16(s[2 * kr + 1][0], s[2 * kr + 1][1]), cvt_pk_bf16(s[2 * kr + 1][2], s[2 * kr + 1][3])};
            const bf16x8 pf = __builtin_bit_cast(bf16x8, pw);
#pragma unroll
            for (int dt = 0; dt < 4; ++dt) {
                const bf16x8 vf = *(const bf16x8*)(UT + (size_t)(64 * h + 16 * dt + qi) * M + (size_t)b * 2048 + (rs + kr) * 64 + bc0 + 8 * g);
                o[dt] = __builtin_amdgcn_mfma_f32_16x16x32_bf16(vf, pf, o[dt], 0, 0, 0);
            }
        }
        const float inv = 1.0f / ls;
#pragma unroll
        for (int dt = 0; dt < 4; ++dt)
            *(u32x2*)(yna + qtok * 512 + 64 * h + 16 * dt + 4 * g) = (u32x2){cvt_pk_bf16(o[dt][0] * inv, o[dt][1] * inv), cvt_pk_bf16(o[dt][2] * inv, o[dt][3] * inv)};
    }
}

__device__ __forceinline__ void conv_mfma(int wv, KPC p, int layer, LAS unsigned char* lds, const bf16_t* UT, const float* FT, bf16_t* yhyT) {
    constexpr int CPS = 8224, ZRS = 4112;
    LAS unsigned char* FC = lds; LAS unsigned char* ZT = lds + 8 * CPS; LAS float* red = (LAS float*)(ZT + 16 * ZRS);
    const float* wsc = p->in[9] + layer * 3 * 1536; const float* bsc = p->in[10] + layer * 1536; const float* hyb = p->in[19] + layer * 512;
    const int tid = fresh_tid(wv), bx = fresh_bx(), lane = tid & 63, i = lane & 15, g = lane >> 4;
    const int rho = (8 - (i & 7)) & 7;
    const int abase = rho * CPS + 2 * (2048 - i + 8 * g - rho) - 512 * wv;
    const int bbase = i * ZRS + 16 * g;
    for (int c = bx; c < 512; c += gridDim.x) {
        __syncthreads();
        float asum = 0.f;
#pragma unroll
        for (int k = 0; k < 8; ++k) {
            const int m = tid + 512 * k; float v;
            if (m == 0) v = 0.f; else if (m < 2048) v = FT[(size_t)c * SEQ + 2048 - m]; else if (m == 2048) v = FT[(size_t)c * SEQ] + FT[(size_t)(512 + c) * SEQ]; else v = FT[(size_t)(512 + c) * SEQ + m - 2048];
            asum += fabsf(v);
            const bf16_t vb = (bf16_t)(cvt_pk_bf16(v, 0.f) & 0xffffu);
#pragma unroll
            for (int r8 = 0; r8 < 8; ++r8) if (m - r8 >= 0) *(LAS bf16_t*)(FC + r8 * CPS + 2 * (m - r8)) = vb;
        }
        {
            const float a0 = wsc[c], a1 = wsc[1536 + c], a2 = wsc[3072 + c], ab = bsc[c];
            const float b0 = wsc[512 + c], b1 = wsc[1536 + 512 + c], b2 = wsc[3072 + 512 + c], bb = bsc[512 + c];
            const float c0 = wsc[1024 + c], c1 = wsc[1536 + 1024 + c], c2 = wsc[3072 + 1024 + c], cb = bsc[1024 + c];
#pragma unroll
            for (int k = 0; k < 4; ++k) {
                const int idx = tid + 512 * k, b = idx >> 8, t0 = (idx & 255) * 8;
                float x0v[8], zv[8];
#pragma unroll
                for (int rr = 0; rr < 3; ++rr) {
                    const bf16_t* row = UT + (size_t)(512 + 512 * rr + c) * M + (size_t)b * 2048;
                    const u32x4 w = *(const u32x4*)(row + t0);
                    float f[10];
                    f[0] = t0 > 0 ? bf2f(row[t0 - 1]) : 0.f; f[9] = t0 + 8 < SEQ ? bf2f(row[t0 + 8]) : 0.f;
                    f[1] = bf_lo(w.x); f[2] = bf_hi(w.x); f[3] = bf_lo(w.y); f[4] = bf_hi(w.y); f[5] = bf_lo(w.z); f[6] = bf_hi(w.z); f[7] = bf_lo(w.w); f[8] = bf_hi(w.w);
                    const float w0 = rr == 0 ? a0 : (rr == 1 ? b0 : c0), w1 = rr == 0 ? a1 : (rr == 1 ? b1 : c1), w2 = rr == 0 ? a2 : (rr == 1 ? b2 : c2), wb = rr == 0 ? ab : (rr == 1 ? bb : cb);
#pragma unroll
                    for (int e = 0; e < 8; ++e) {
                        const float v = f[e] * w0 + f[e + 1] * w1 + f[e + 2] * w2 + wb;
                        if (rr == 0) x0v[e] = v; else if (rr == 1) zv[e] = v; else zv[e] *= v;
                    }
                }
                *(LAS u32x4*)(ZT + b * ZRS + 2 * t0) = (u32x4){cvt_pk_bf16(zv[0], zv[1]), cvt_pk_bf16(zv[2], zv[3]), cvt_pk_bf16(zv[4], zv[5]), cvt_pk_bf16(zv[6], zv[7])};
                *(LAS u32x4*)(ZT + (8 + b) * ZRS + 2 * t0) = (u32x4){cvt_pk_bf16(x0v[0], x0v[1]), cvt_pk_bf16(x0v[2], x0v[3]), cvt_pk_bf16(x0v[4], x0v[5]), cvt_pk_bf16(x0v[6], x0v[7])};
            }
        }
        asum = wave_sum(asum);
        if (lane == 0) red[wv] = asum;
        __syncthreads();
        float kn = 0.f;
#pragma unroll
        for (int w = 0; w < 8; ++w) kn += red[w];
        bf16x8 ring[16]; f32x4 acc[16];
#pragma unroll
        for (int tau = 0; tau < 16; ++tau) { ring[tau] = *(const LAS bf16x8*)(FC + abase - 32 * tau); acc[tau] = (f32x4){0.f, 0.f, 0.f, 0.f}; }
        bf16x8 bcur = *(const LAS bf16x8*)(ZT + bbase);
        for (int s8 = 0; s8 < 8; ++s8) {
#pragma unroll
            for (int sp = 0; sp < 8; ++sp) {
                const int sn = min(8 * s8 + sp + 1, 63);
                const bf16x8 bnext = *(const LAS bf16x8*)(ZT + bbase + 64 * sn);
                const bf16x8 n0 = *(const LAS bf16x8*)(FC + abase + 64 * sn), n1 = *(const LAS bf16x8*)(FC + abase + 64 * sn - 32);
#pragma unroll
                for (int tau = 0; tau < 16; ++tau) acc[tau] = __builtin_amdgcn_mfma_f32_16x16x32_bf16(ring[(tau - 2 * sp) & 15], bcur, acc[tau], 0, 0, 0);
                ring[(0 - 2 * (sp + 1)) & 15] = n0; ring[(1 - 2 * (sp + 1)) & 15] = n1;
                bcur = bnext;
            }
        }
        if (i < 8) {
            const float ikn = 1.0f / kn, hb = hyb[c];
#pragma unroll
            for (int tau = 0; tau < 16; ++tau) {
                const int t = 256 * wv + 16 * tau + 4 * g;
                const u32x2 zz = *(const LAS u32x2*)(ZT + i * ZRS + 2 * t), xx = *(const LAS u32x2*)(ZT + (8 + i) * ZRS + 2 * t);
                const float y0 = bf_lo(xx.x) * (acc[tau][0] * ikn + bf_lo(zz.x) * hb), y1 = bf_hi(xx.x) * (acc[tau][1] * ikn + bf_hi(zz.x) * hb);
                const float y2 = bf_lo(xx.y) * (acc[tau][2] * ikn + bf_lo(zz.y) * hb), y3 = bf_hi(xx.y) * (acc[tau][3] * ikn + bf_hi(zz.y) * hb);
                *(u32x2*)(yhyT + (size_t)c * M + (size_t)i * 2048 + t) = (u32x2){cvt_pk_bf16(y0, y1), cvt_pk_bf16(y2, y3)};
            }
        }
    }
}

__device__ __forceinline__ void post_pass(int wv, LAS unsigned char* lds, const bf16_t* yna, const bf16_t* yhyT, bf16_t* yn) {
    LAS bf16_t* tile = (LAS bf16_t*)lds;
    const int tid = fresh_tid(wv), bx = fresh_bx(), lane = tid & 63, wave = tid >> 6;
    for (int it = bx; it < M / 32; it += gridDim.x) {
        const int tok0 = it * 32;
        __syncthreads();
        {
            const u32x4* src = (const u32x4*)(yhyT + (size_t)tid * M + tok0);
#pragma unroll
            for (int j = 0; j < 4; ++j) {
                const u32x4 v = src[j];
                tile[(8 * j + 0) * 520 + tid] = (bf16_t)(v.x & 0xffffu); tile[(8 * j + 1) * 520 + tid] = (bf16_t)(v.x >> 16);
                tile[(8 * j + 2) * 520 + tid] = (bf16_t)(v.y & 0xffffu); tile[(8 * j + 3) * 520 + tid] = (bf16_t)(v.y >> 16);
                tile[(8 * j + 4) * 520 + tid] = (bf16_t)(v.z & 0xffffu); tile[(8 * j + 5) * 520 + tid] = (bf16_t)(v.z >> 16);
                tile[(8 * j + 6) * 520 + tid] = (bf16_t)(v.w & 0xffffu); tile[(8 * j + 7) * 520 + tid] = (bf16_t)(v.w >> 16);
            }
        }
        __syncthreads();
#pragma unroll
        for (int q = 0; q < 4; ++q) {
            const int tk = 4 * wave + q; const size_t tok = (size_t)tok0 + tk;
#pragma unroll
            for (int half = 0; half < 2; ++half) {
                u32x4 v;
                if (half == 0) v = *(const u32x4*)(yna + tok * 512 + 8 * lane); else v = *(const LAS u32x4*)(tile + tk * 520 + 8 * lane);
                float f[8] = {bf_lo(v.x), bf_hi(v.x), bf_lo(v.y), bf_hi(v.y), bf_lo(v.z), bf_hi(v.z), bf_lo(v.w), bf_hi(v.w)};
                float s = 0.f;
#pragma unroll
                for (int e = 0; e < 8; ++e) s += f[e] * f[e];
                s = wave_sum(s);
                const float rs = rstd_of(s, 1.0f / 512.0f);
                *(u32x4*)(yn + tok * 1024 + half * 512 + 8 * lane) = (u32x4){cvt_pk_bf16(f[0] * rs, f[1] * rs), cvt_pk_bf16(f[2] * rs, f[3] * rs), cvt_pk_bf16(f[4] * rs, f[5] * rs), cvt_pk_bf16(f[6] * rs, f[7] * rs)};
            }
        }
    }
}

__global__ void __launch_bounds__(512, 2) hybrid_fwd(KP kparams_unused) {
    extern __shared__ __attribute__((aligned(16))) unsigned char lds_raw[];
    LAS unsigned char* lds = (LAS unsigned char*)lds_raw;
    cg::grid_group grid = cg::this_grid();
    const int wv = __builtin_amdgcn_readfirstlane((int)(threadIdx.x >> 6));
#define WSV() KPC p = KPARAMS(); unsigned char* ws = p->ws; float* ss = (float*)(ws + WS_CTL) + (size_t)(4 * layer) * M;   \
    bf16_t* xb = (bf16_t*)(ws + WS_XB); bf16_t* Hb = (bf16_t*)(ws + WS_R1); bf16_t* QK = (bf16_t*)(ws + WS_R1); bf16_t* UT = (bf16_t*)(ws + WS_R1 + 32 * MiB); \
    bf16_t* yna = (bf16_t*)(ws + WS_R2); bf16_t* yhyT = (bf16_t*)(ws + WS_R2 + 16 * MiB); bf16_t* yn = (bf16_t*)(ws + WS_R2 + 32 * MiB); float* PP = (float*)(ws + WS_R2); \
    bf16_t* pb = (bf16_t*)(ws + WS_PB); const float* FT = (const float*)(ws + WS_FT); unsigned char* Wb = ws + WS_W; float* X = p->out; \
    (void)ss; (void)xb; (void)Hb; (void)QK; (void)UT; (void)yna; (void)yhyT; (void)yn; (void)PP; (void)pb; (void)FT; (void)Wb; (void)X;

    { const int t0_ = fresh_tid(wv); if (t0_ < 4) ((volatile LAS unsigned*)(lds + LDS_BYTES - 16))[t0_] = 0u; __syncthreads(); }
    XcdBarrier xbar;
    { KPC p = KPARAMS(); xbar = xcd_barrier_post((unsigned*)(p->ws + WS_CTL + BAR_OFF), (volatile LAS unsigned*)(lds + LDS_BYTES - 16), wv); }
#define GSYNC() do { for (int rs_ = 0; rs_ < R_SYNC; ++rs_) xcd_barrier(xbar, wv); } while (0)
    for (int layer = 0; layer < 2; ++layer) {
#ifndef NO_PRO
        for (int rep_ = 0; rep_ < R_PRO; ++rep_) { WSV(); layer_prologue(wv, p, layer, lds); __syncthreads(); }
#endif
        if (layer == 0) grid.sync(); else GSYNC();
        for (int rep_ = 0; rep_ < R_UP; ++rep_) { WSV(); gemm_run(wv, lds, xb, (const bf16_t*)(Wb + W_GUA), M, 2 * FF, D, EpiSwiGLU{Hb, ss}); }
        GSYNC();
        { WSV(); gemm_run(wv, lds, Hb, (const bf16_t*)(Wb + W_DA), M, D, FF, EpiResid{layer == 0 ? p->in[0] : X, X, xb, ss + M, 0.5f}); }
        for (int rep_ = 1; rep_ < R_REST; ++rep_) { WSV(); gemm_run(wv, lds, Hb, (const bf16_t*)(Wb + W_DA), M, D, FF, EpiDry{}); }
        GSYNC();
        { WSV(); gemm_run(wv, lds, (const bf16_t*)(Wb + W_IN) + (size_t)1024 * D, xb, 2048, M, D, EpiScaleCol{UT, M, ss + M}); }
        for (int rep_ = 1; rep_ < R_REST; ++rep_) { WSV(); gemm_run(wv, lds, (const bf16_t*)(Wb + W_IN) + (size_t)1024 * D, xb, 2048, M, D, EpiScaleCol{UT, M, ss + M}); }
        { WSV(); gemm_run(wv, lds, xb, (const bf16_t*)(Wb + W_IN), M, 1024, D, EpiScaleRow{QK, 1024, ss + M}); }
        for (int rep_ = 1; rep_ < R_REST; ++rep_) { WSV(); gemm_run(wv, lds, xb, (const bf16_t*)(Wb + W_IN), M, 1024, D, EpiScaleRow{QK, 1024, ss + M}); }
        GSYNC();
#ifndef NO_ATTN
#if NAIVE_ATTN
        { WSV(); attn_naive(wv, p, layer, QK, UT, yna); }
#else
        for (int rep_ = 0; rep_ < R_ATTN; ++rep_) { WSV(); attn_mfma(wv, p, layer, QK, UT, yna); }
#endif
#endif
#ifndef NO_CONV
#if NAIVE_CONV
        { WSV(); conv_naive(wv, p, layer, lds, UT, FT, yhyT); }
#else
        for (int rep_ = 0; rep_ < R_CONV; ++rep_) { WSV(); conv_mfma(wv, p, layer, lds, UT, FT, yhyT); }
#endif
#endif
        GSYNC();
#ifndef NO_POST
        for (int rep_ = 0; rep_ < R_POST; ++rep_) { WSV(); post_pass(wv, lds, yna, yhyT, yn); }
#endif
        GSYNC();
        { WSV(); gemm_run(wv, lds, yn, (const bf16_t*)(Wb + W_OUT), M, D, D, EpiResid{X, X, xb, ss + 2 * M, 1.0f}); }
        for (int rep_ = 1; rep_ < R_REST; ++rep_) { WSV(); gemm_run(wv, lds, yn, (const bf16_t*)(Wb + W_OUT), M, D, D, EpiDry{}); }
        GSYNC();
        { WSV(); gemm_run(wv, lds, pb + (size_t)layer * M * PLE, (const bf16_t*)(Wb + W_PP), M, D, PLE, EpiStoreF32{PP, D}); }
        for (int rep_ = 1; rep_ < R_REST; ++rep_) { WSV(); gemm_run(wv, lds, pb + (size_t)layer * M * PLE, (const bf16_t*)(Wb + W_PP), M, D, PLE, EpiStoreF32{PP, D}); }
        { WSV(); gemm_run(wv, lds, xb, (const bf16_t*)(Wb + W_GUB), M, 2 * FF, D, EpiSwiGLU{Hb, ss + 2 * M}); }
        for (int rep_ = 1; rep_ < R_REST; ++rep_) { WSV(); gemm_run(wv, lds, xb, (const bf16_t*)(Wb + W_GUB), M, 2 * FF, D, EpiSwiGLU{Hb, ss + 2 * M}); }
        GSYNC();
        { WSV(); gemm_run(wv, lds, Hb, (const bf16_t*)(Wb + W_DB), M, D, FF, EpiResid{X, X, xb, ss + 3 * M, 0.5f}); }
        for (int rep_ = 1; rep_ < R_REST; ++rep_) { WSV(); gemm_run(wv, lds, Hb, (const bf16_t*)(Wb + W_DB), M, D, FF, EpiDry{}); }
        GSYNC();
        { WSV(); gemm_run(wv, lds, xb, (const bf16_t*)(Wb + W_PG), M, D, D, EpiPle{X, PP, ss + 3 * M, xb, ss + 4 * M}); }
        for (int rep_ = 1; rep_ < R_REST; ++rep_) { WSV(); gemm_run(wv, lds, xb, (const bf16_t*)(Wb + W_PG), M, D, D, EpiDry{}); }
        GSYNC();
    }
    {
        const int layer = 2; WSV();
        const int tid = fresh_tid(wv), bx = fresh_bx(), lane = tid & 63, wave = tid >> 6;
        const float* gf = p->in[29];
        for (int m = bx * 8 + wave; m < M; m += gridDim.x * 8) {
            const float rs = rstd_of(ss[m], 1.0f / D);
            f32x4* xr = (f32x4*)(X + (size_t)m * D) + lane; const f32x4* gr = (const f32x4*)gf + lane;
#pragma unroll
            for (int j = 0; j < 4; ++j) { f32x4 v = xr[64 * j]; const f32x4 g = gr[64 * j]; v = v * rs * g; xr[64 * j] = v; }
        }
    }
}

extern "C" void kernel_launch(void* const* d_in, const int* in_sizes, int n_in, void* d_out, int out_size, void* d_ws, size_t ws_size, hipStream_t stream) {
    static int grid = 0;
    if (grid == 0) {
        if (n_in != 30 || out_size != M * D || ws_size < WS_END) { fprintf(stderr, "kernel_launch: unexpected shapes: n_in %d out %d ws %zu (need %zu)\n", n_in, out_size, ws_size, (size_t)WS_END); grid = -1; return; }
        int dev = 0, cus = 0, per_cu = 0;
        hipGetDevice(&dev);
        hipDeviceGetAttribute(&cus, hipDeviceAttributeMultiprocessorCount, dev);
        if (hipFuncSetAttribute((const void*)hybrid_fwd, hipFuncAttributeMaxDynamicSharedMemorySize, LDS_BYTES) != hipSuccess) { fprintf(stderr, "kernel_launch: hipFuncSetAttribute failed\n"); }
        if (hipOccupancyMaxActiveBlocksPerMultiprocessor(&per_cu, (const void*)hybrid_fwd, 512, LDS_BYTES) != hipSuccess || per_cu < 1) { fprintf(stderr, "kernel_launch: occupancy query says %d\n", per_cu); per_cu = 1; }
        (void)hipGetLastError();
        grid = cus * per_cu;
        fprintf(stderr, "kernel_launch: grid %d (cus %d x %d)\n", grid, cus, per_cu);
    }
    if (grid < 0) return;
    (void)hipMemsetAsync((char*)d_ws + WS_CTL, 0, 1 * MiB, stream);
    KP hp{};
    for (int i = 0; i < 30; ++i) hp.in[i] = (const float*)d_in[i];
    hp.out = (float*)d_out; hp.ws = (unsigned char*)d_ws;
    void* args[] = {&hp};
    hipError_t e = hipLaunchCooperativeKernel((const void*)hybrid_fwd, dim3(grid), dim3(512), args, LDS_BYTES, stream);
    if (e != hipSuccess) fprintf(stderr, "kernel_launch: cooperative launch failed: %s (grid %d)\n", hipGetErrorString(e), grid);
}
```

```cpp
#include <hip/hip_runtime.h>
#include <hip/hip_cooperative_groups.h>
#include <cstdio>
#include <cstdint>
namespace cg = cooperative_groups;
namespace pg8 {
#define PG8_LAS __attribute__((address_space(3)))
typedef unsigned short bf16_t;
typedef short bf16x8 __attribute__((ext_vector_type(8)));
typedef float f32x4 __attribute__((ext_vector_type(4)));
typedef unsigned u32x4 __attribute__((ext_vector_type(4)));
constexpr int BM = 256, BK = 64, HALF = 128, HTB = HALF * BK * 2  , STAGE_BYTES = 8 * HTB, NXCD = 8, WGM = 8;

__host__ __device__ __forceinline__ int lds_byte(int r, int c) { const int st = (r >> 4) * 2 + (c >> 5), rr = r & 15, cc = c & 31, ob = rr * 64 + cc * 2; return st * 1024 + (ob ^ (((ob >> 9) & 1) << 5)); }
__host__ __device__ __forceinline__ void stage_rc(int b, int& R, int& C) { const int st = b / 1024, sb = b % 1024, swz = sb ^ (((sb >> 9) & 1) << 5); R = (st >> 1) * 16 + swz / 64; C = (st & 1) * 32 + (swz % 64) / 2; }
__host__ __device__ __forceinline__ int perm32(int rho) { const int n = rho >> 4, i = rho & 15; return 8 * (i >> 2) + 4 * n + (i & 3); }

struct Unit { int pm, pn; };
struct Gemm { const bf16_t* A; const bf16_t* Bt; int M, N, K; };

struct StaticOrder {
    int nM, nN, nwg, G, c;
    __host__ __device__ void init(int M, int N, int G_, int c_) { nM = M / BM; nN = N / BM; nwg = nM * nN; G = G_; c = c_; }
    __host__ __device__ bool next(int i, Unit& u) const {
        const long L = (long)i * G + c; if (L >= nwg) return false;
        int wgid = (int)L; { const int q = nwg / NXCD, r = nwg % NXCD, xcd = wgid % NXCD, off = wgid / NXCD; wgid = (xcd < r ? xcd * (q + 1) : r * (q + 1) + (xcd - r) * q) + off; }
        const int nig = WGM * nN, gid = wgid / nig, fm = gid * WGM, gsz = (nM - fm) < WGM ? (nM - fm) : WGM;
        u.pm = fm + ((wgid % nig) % gsz); u.pn = (wgid % nig) / gsz; return true;
    }
    __device__ __forceinline__ void a_ready(const Unit&) const {}
    __device__ __forceinline__ void done(const Unit&) const {}
};

template <class Epi, class Sched, bool ALIGN_EPI = false, bool SP2 = false>
__device__ __forceinline__ void gemm_phase(PG8_LAS unsigned char* lds, const Gemm g, const Sched& S, const Epi& E, int tid_in) {
    int tid_ = tid_in; asm volatile("" : "+v"(tid_)); const int tid = tid_, wid = __builtin_amdgcn_readfirstlane(tid >> 6), lane = tid & 63, wr = wid >> 2, wc = wid & 3, fr = lane & 15, fq = lane >> 4;
    const int K = g.K, nt = K / BK;
    unsigned voffA[2], voffB[2];
#pragma unroll
    for (int i = 0; i < 2; ++i) { int R, C; stage_rc(tid * 16 + i * 8192, R, C); const int Rb = Epi::PERM ? ((R & ~31) + perm32(R & 31)) : R;
        voffA[i] = (unsigned)(R * K + C) * 2u; voffB[i] = (unsigned)(Rb * K + C) * 2u; }
    const size_t kstep = (size_t)(BK * 2);
    const size_t hstep = (size_t)HALF * K * 2;
    const size_t tstep = 2 * hstep;
    const unsigned ldsw = (unsigned)wid * 1024u;
    const int aoff = lds_byte(wr * 64 + fr, fq * 8), boff = lds_byte(wc * 32 + fr, fq * 8);
#define PG8_SA(b, h) (((b) * 2 + (h)) * HTB)
#define PG8_SB(b, h) ((4 + (b) * 2 + (h)) * HTB)
#define PG8_STAGE(bufoff, gbase, voff) do { _Pragma("unroll") for (int _i = 0; _i < 2; ++_i) \
        __builtin_amdgcn_global_load_lds((const unsigned*)((const char*)(gbase) + (voff)[_i]), (PG8_LAS unsigned*)(lds + (bufoff) + ldsw + _i * 8192), 16, 0, 0); } while (0)
#define PG8_LDA(dst, b, h) do { _Pragma("unroll") for (int m = 0; m < 4; ++m) _Pragma("unroll") for (int k = 0; k < 2; ++k) dst[m][k] = *(const PG8_LAS bf16x8*)(lds + PG8_SA(b, h) + aoff + m * 2048 + k * 1024); } while (0)
#define PG8_LDB(dst, b, h) do { _Pragma("unroll") for (int n = 0; n < 2; ++n) _Pragma("unroll") for (int k = 0; k < 2; ++k) dst[n][k] = *(const PG8_LAS bf16x8*)(lds + PG8_SB(b, h) + boff + n * 2048 + k * 1024); } while (0)
#define PG8_MMA(ai, bj, At, Bt) do { __builtin_amdgcn_s_setprio(1); _Pragma("unroll") for (int m = 0; m < 4; ++m) _Pragma("unroll") for (int n = 0; n < 2; ++n) _Pragma("unroll") for (int k = 0; k < 2; ++k) \
        acc[ai][bj][m][n] = __builtin_amdgcn_mfma_f32_16x16x32_bf16(Bt[n][k], At[m][k], acc[ai][bj][m][n], 0, 0, 0); __builtin_amdgcn_s_setprio(0); } while (0)
#define PG8_WAIT_V(n) asm volatile("s_waitcnt vmcnt(" #n ")" ::: "memory")
#define PG8_WAIT_L(n) asm volatile("s_waitcnt lgkmcnt(" #n ")" ::: "memory")
#define PG8_BAR __builtin_amdgcn_s_barrier()
#define PG8_SCHED __builtin_amdgcn_sched_barrier(0)
    Unit cur, nxt; int ui = 0;
    if (!S.next(0, cur)) return;
    f32x4 acc[2][2][4][2];
#pragma unroll
    for (int a = 0; a < 2; ++a)
#pragma unroll
        for (int b = 0; b < 2; ++b)
#pragma unroll
            for (int m = 0; m < 4; ++m)
#pragma unroll
                for (int n = 0; n < 2; ++n) acc[a][b][m][n] = (f32x4){0.f, 0.f, 0.f, 0.f};
    bf16x8 At[4][2], B0[2][2], B1[2][2];
    const char* cA = (const char*)g.A + (size_t)cur.pm * tstep; const char* cB = (const char*)g.Bt + (size_t)cur.pn * tstep;
    S.a_ready(cur);
    if constexpr (SP2) {
        PG8_STAGE(PG8_SB(0, 0), cB, voffB); PG8_STAGE(PG8_SB(0, 1), cB + hstep, voffB); PG8_STAGE(PG8_SA(0, 0), cA, voffA); PG8_STAGE(PG8_SA(0, 1), cA + hstep, voffA);
        if (wr == 1) PG8_BAR;
        PG8_WAIT_V(2); PG8_BAR;
        PG8_STAGE(PG8_SB(1, 0), cB + kstep, voffB); PG8_STAGE(PG8_SA(1, 0), cA + kstep, voffA); PG8_STAGE(PG8_SB(1, 1), cB + hstep + kstep, voffB);
        PG8_WAIT_V(6); PG8_BAR;
    } else {
        PG8_STAGE(PG8_SB(0, 0), cB, voffB); PG8_STAGE(PG8_SA(0, 0), cA, voffA); PG8_STAGE(PG8_SB(0, 1), cB + hstep, voffB); PG8_STAGE(PG8_SA(0, 1), cA + hstep, voffA);
        if (wr == 1) PG8_BAR;
        PG8_WAIT_V(4); PG8_BAR;
        PG8_STAGE(PG8_SB(1, 0), cB + kstep, voffB); PG8_STAGE(PG8_SA(1, 0), cA + kstep, voffA); PG8_STAGE(PG8_SB(1, 1), cB + hstep + kstep, voffB);
        PG8_WAIT_V(6); PG8_BAR;
    }
    for (;;) {
        const bool has_next = S.next(ui + 1, nxt);
        const char* nA = has_next ? (const char*)g.A + (size_t)nxt.pm * tstep : cA; const char* nB = has_next ? (const char*)g.Bt + (size_t)nxt.pn * tstep : cB;
        for (int t = 0; t < nt; t += 2) {
            const bool last = (t == nt - 2);
            const char* a1 = cA + (size_t)(t + 1) * kstep;
            const char* a2 = last ? nA : cA + (size_t)(t + 2) * kstep; const char* b2 = last ? nB : cB + (size_t)(t + 2) * kstep;
            const char* a3 = a2 + kstep; const char* b3 = b2 + kstep;
            if (last && has_next) S.a_ready(nxt);
            if constexpr (SP2) {
            PG8_LDB(B0, 0, 0); PG8_LDB(B1, 0, 1); PG8_SCHED; PG8_LDA(At, 0, 0); PG8_STAGE(PG8_SA(1, 1), a1 + hstep, voffA);
            PG8_WAIT_V(8); PG8_WAIT_L(0); PG8_BAR; PG8_MMA(0, 0, At, B0); PG8_MMA(0, 1, At, B1); PG8_BAR; PG8_SCHED;
            PG8_LDA(At, 0, 1); PG8_STAGE(PG8_SB(0, 0), b2, voffB); PG8_STAGE(PG8_SB(0, 1), b2 + hstep, voffB); PG8_STAGE(PG8_SA(0, 0), a2, voffA);
            PG8_WAIT_V(8); PG8_WAIT_L(0); PG8_BAR; PG8_MMA(1, 0, At, B0); PG8_MMA(1, 1, At, B1); PG8_BAR; PG8_SCHED;
            PG8_LDB(B0, 1, 0); PG8_LDB(B1, 1, 1); PG8_SCHED; PG8_LDA(At, 1, 0); PG8_STAGE(PG8_SA(0, 1), a2 + hstep, voffA);
            PG8_WAIT_V(8); PG8_WAIT_L(0); PG8_BAR; PG8_MMA(0, 0, At, B0); PG8_MMA(0, 1, At, B1); PG8_BAR; PG8_SCHED;
            PG8_LDA(At, 1, 1); PG8_STAGE(PG8_SB(1, 0), b3, voffB); PG8_STAGE(PG8_SB(1, 1), b3 + hstep, voffB); PG8_STAGE(PG8_SA(1, 0), a3, voffA);
            PG8_WAIT_V(8); PG8_WAIT_L(0); PG8_BAR; PG8_MMA(1, 0, At, B0); PG8_MMA(1, 1, At, B1); PG8_BAR; PG8_SCHED;
            } else {
            PG8_LDB(B0, 0, 0); PG8_SCHED; PG8_LDA(At, 0, 0); PG8_STAGE(PG8_SA(1, 1), a1 + hstep, voffA);
            PG8_WAIT_L(8); PG8_BAR; PG8_WAIT_L(0); PG8_MMA(0, 0, At, B0); PG8_BAR; PG8_SCHED;
            PG8_LDB(B1, 0, 1); PG8_STAGE(PG8_SB(0, 0), b2, voffB);
            PG8_BAR; PG8_WAIT_L(0); PG8_MMA(0, 1, At, B1); PG8_BAR;
            PG8_LDA(At, 0, 1); PG8_STAGE(PG8_SA(0, 0), a2, voffA);
            PG8_BAR; PG8_WAIT_L(0); PG8_MMA(1, 0, At, B0); PG8_BAR; PG8_SCHED;
            PG8_STAGE(PG8_SB(0, 1), b2 + hstep, voffB);
            PG8_WAIT_V(6); PG8_BAR; PG8_MMA(1, 1, At, B1); PG8_BAR;
            PG8_LDB(B0, 1, 0); PG8_SCHED; PG8_LDA(At, 1, 0); PG8_STAGE(PG8_SA(0, 1), a2 + hstep, voffA);
            PG8_WAIT_L(8); PG8_BAR; PG8_WAIT_L(0); PG8_MMA(0, 0, At, B0); PG8_BAR; PG8_SCHED;
            PG8_LDB(B1, 1, 1); PG8_STAGE(PG8_SB(1, 0), b3, voffB);
            PG8_BAR; PG8_WAIT_L(0); PG8_MMA(0, 1, At, B1); PG8_BAR;
            PG8_LDA(At, 1, 1); PG8_STAGE(PG8_SA(1, 0), a3, voffA);
            PG8_BAR; PG8_WAIT_L(0); PG8_MMA(1, 0, At, B0); PG8_BAR; PG8_SCHED;
            PG8_STAGE(PG8_SB(1, 1), b3 + hstep, voffB);
            PG8_WAIT_V(6); PG8_BAR; PG8_MMA(1, 1, At, B1); PG8_BAR;
            }
        }
        if constexpr (ALIGN_EPI) { if (wr == 0) PG8_BAR; }
        if constexpr (!Epi::AFTER_DRAIN) { E(acc, cur, wr, wc, fr, fq); S.done(cur); }
        if (!has_next) break;
#pragma unroll
        for (int a = 0; a < 2; ++a)
#pragma unroll
            for (int b = 0; b < 2; ++b)
#pragma unroll
                for (int m = 0; m < 4; ++m)
#pragma unroll
                    for (int n = 0; n < 2; ++n) acc[a][b][m][n] = (f32x4){0.f, 0.f, 0.f, 0.f};
        cur = nxt; cA = nA; cB = nB; ++ui;
        if constexpr (ALIGN_EPI) { if (wr == 1) PG8_BAR; }
    }
    PG8_WAIT_V(0);
    if constexpr (!ALIGN_EPI) { if (wr == 0) PG8_BAR; }
    PG8_BAR;
    if constexpr (Epi::AFTER_DRAIN) { E.fused(acc, cur, wr, wc, fr, fq, lds, wid, lane); S.done(cur); }
#undef PG8_SA
#undef PG8_SB
#undef PG8_STAGE
#undef PG8_LDA
#undef PG8_LDB
#undef PG8_MMA
#undef PG8_WAIT_V
#undef PG8_WAIT_L
#undef PG8_BAR
#undef PG8_SCHED
}
}
using pg8::bf16_t; using pg8::bf16x8; using pg8::f32x4; using pg8::u32x4; using pg8::Unit; using pg8::Gemm; using pg8::StaticOrder;
typedef float f32x2 __attribute__((ext_vector_type(2)));
typedef unsigned u32x2 __attribute__((ext_vector_type(2)));
#define LAS __attribute__((address_space(3)))

#ifndef NAIVE_GEMM
#define NAIVE_GEMM 0
#endif
#ifndef R_PRO
#define R_PRO 1
#endif
#ifndef R_ATTN
#define R_ATTN 1
#endif
#ifndef R_CONV
#define R_CONV 1
#endif
#ifndef R_SYNC
#define R_SYNC 1
#endif
#ifndef R_UP
#define R_UP 1
#endif
#ifndef R_REST
#define R_REST 1
#endif
#ifndef R_POST
#define R_POST 1
#endif
#ifndef NAIVE_ATTN
#define NAIVE_ATTN 0
#endif
#ifndef NAIVE_CONV
#define NAIVE_CONV 0
#endif

constexpr int M = 16384, D = 1024, FF = 2816, SEQ = 2048, HC = 512, PLE = 256;
constexpr float EPS = 1e-6f;
constexpr size_t MiB = 1u << 20;
constexpr size_t WS_CTL = 0, WS_W = 1 * MiB, WS_FT = 45 * MiB, WS_PB = 53 * MiB, WS_XB = 69 * MiB, WS_R1 = 101 * MiB, WS_R2 = 197 * MiB, WS_END = 261 * MiB;
constexpr size_t W_GUA = 0, W_DA = 11 * MiB, W_IN = W_DA + 5767168, W_OUT = W_IN + 6 * MiB, W_GUB = W_OUT + 2 * MiB, W_DB = W_GUB + 11 * MiB, W_PG = W_DB + 5767168, W_PP = W_PG + 2 * MiB;
static_assert(W_PP + 512 * 1024 <= 44 * MiB, "weights");
constexpr int LDS_BYTES = 131072 + 4096;
constexpr size_t BAR_OFF = 640 * 1024;

struct KP { const float* in[30]; float* out; unsigned char* ws; };
typedef const __attribute__((address_space(4))) KP* KPC;
#define KPARAMS() ({ KPC q_ = (KPC)__builtin_amdgcn_kernarg_segment_ptr(); asm volatile("" : "+s"(q_)); q_; })

__device__ __forceinline__ unsigned cvt_pk_bf16(float lo, float hi) { unsigned r; asm volatile("v_cvt_pk_bf16_f32 %0, %1, %2" : "=v"(r) : "v"(lo), "v"(hi)); return r; }
__device__ __forceinline__ float bf_lo(unsigned w) { return __uint_as_float(w << 16); }
__device__ __forceinline__ float bf_hi(unsigned w) { return __uint_as_float(w & 0xffff0000u); }
__device__ __forceinline__ float bf2f(bf16_t b) { return __uint_as_float(((unsigned)b) << 16); }
__device__ __forceinline__ float wave_sum(float v) {
#pragma unroll
    for (int o = 1; o < 64; o <<= 1) v += __shfl_xor(v, o);
    return v;
}
__device__ __forceinline__ int fresh_tid(int wv) {
    int l; asm volatile("v_mbcnt_lo_u32_b32 %0, -1, 0\n\tv_mbcnt_hi_u32_b32 %0, -1, %0" : "=v"(l));
    return wv * 64 + l;
}
__device__ __forceinline__ int fresh_bx() { int b = blockIdx.x; asm volatile("" : "+s"(b)); return b; }
#define XB_TMO      128
#define XB_XCNT(j)  (256  + 64 * (j))
#define XB_XSUB(j)  (1280 + 64 * (j))
#define XB_XGEN(j)  (2304 + 64 * (j))
#define XB_TOP      3328
#define XB_TOPGEN   3392
#define XCD_BAR_WORDS 3456
#define XB_SPIN_CAP (1u << 18)

__device__ __forceinline__ unsigned xb_ld(unsigned* p)              { return __hip_atomic_load(p, __ATOMIC_RELAXED, __HIP_MEMORY_SCOPE_AGENT); }
__device__ __forceinline__ unsigned xb_add(unsigned* p, unsigned v) { return __hip_atomic_fetch_add(p, v, __ATOMIC_RELAXED, __HIP_MEMORY_SCOPE_AGENT); }
__device__ __forceinline__ unsigned xb_xcc_id() { return (unsigned)__builtin_amdgcn_s_getreg((3 << 11) | 20) & 0xFu; }
#define XB_SPIN(cond, bar) do { unsigned _sp = 0; while (cond) { __builtin_amdgcn_s_sleep(1); \
    if ((++_sp & 255u) == 0u) { if (xb_ld(&(bar)[XB_TMO])) break; if (_sp > XB_SPIN_CAP) { atomicAdd(&(bar)[XB_TMO], 1u); break; } } } } while (0)

struct XcdBarrier {
    unsigned* bar; unsigned x;
    volatile LAS unsigned* st;
};

__device__ __forceinline__ XcdBarrier xcd_barrier_post(unsigned* bar, volatile LAS unsigned* st, int wv) {
    XcdBarrier b; b.bar = bar; b.x = xb_xcc_id(); b.st = st;
    if (fresh_tid(wv) == 0) (void)xb_add(&bar[XB_XCNT(b.x)], 1u);
    return b;
}
__device__ __forceinline__ void xcd_barrier_complete(unsigned* bar, unsigned x, unsigned& nloc, unsigned& nx) {
    const unsigned G = gridDim.x * gridDim.y * gridDim.z;
    unsigned sum, cnt, mine, sp = 0u;
    for (;;) {
        sum = 0u; cnt = 0u; mine = 0u;
#pragma unroll
        for (unsigned j = 0; j < 16; ++j) { const unsigned c = xb_ld(&bar[XB_XCNT(j)]); sum += c; cnt += (c > 0u) ? 1u : 0u; mine = (j == x) ? c : mine; }
        if (sum == G) break;
        __builtin_amdgcn_s_sleep(1);
        if ((++sp & 255u) == 0u) { if (xb_ld(&bar[XB_TMO])) break; if (sp > XB_SPIN_CAP) { atomicAdd(&bar[XB_TMO], 1u); break; } }
    }
    nloc = mine > 0u ? mine : 1u; nx = cnt > 0u ? cnt : 1u;
}

__device__ __forceinline__ void xcd_barrier(const XcdBarrier& b, int wv) {
    asm volatile("s_waitcnt vmcnt(0)" ::: "memory");
    __syncthreads();
    if (fresh_tid(wv) == 0) {
        unsigned* bar = b.bar;
        __builtin_amdgcn_s_waitcnt(0);
        unsigned nloc = b.st[0], nx = b.st[1];
        if (nloc == 0u) { xcd_barrier_complete(bar, b.x, nloc, nx); b.st[0] = nloc; b.st[1] = nx; }
        const unsigned old = xb_add(&bar[XB_XSUB(b.x)], 1u);
        const unsigned gen = old / nloc;
        if (old + 1u == (gen + 1u) * nloc) {
            __builtin_amdgcn_fence(__ATOMIC_RELEASE, "agent");
            asm volatile("s_waitcnt vmcnt(0)" ::: "memory");
            const unsigned og = xb_add(&bar[XB_TOP], 1u);
            const unsigned tg = og / nx;
            if (og + 1u == (tg + 1u) * nx) xb_add(&bar[XB_TOPGEN], 1u);
            else XB_SPIN(xb_ld(&bar[XB_TOPGEN]) == tg, bar);
            __builtin_amdgcn_fence(__ATOMIC_ACQUIRE, "agent");
            xb_add(&bar[XB_XGEN(b.x)], 1u);
            asm volatile("s_waitcnt vmcnt(0)" ::: "memory");
        } else {
            XB_SPIN(xb_ld(&bar[XB_XGEN(b.x)]) == gen, bar);
            __builtin_amdgcn_fence(__ATOMIC_ACQUIRE, "agent");
            asm volatile("s_waitcnt vmcnt(0)" ::: "memory");
        }
    }
    __syncthreads();
}

__device__ __forceinline__ float rstd_of(float ss, float invn) { return rsqrtf(ss * invn + EPS); }

#ifndef NT_STORES
#define NT_STORES 0
#endif
#if NT_STORES
#define ST(ptr, val) __builtin_nontemporal_store((val), (ptr))
#else
#define ST(ptr, val) (*(ptr) = (val))
#endif
struct EpiSwiGLU {
    static constexpr bool PERM = true, AFTER_DRAIN = false;
    bf16_t* H; const float* ss;
    __device__ __forceinline__ void operator()(const f32x4 (&acc)[2][2][4][2], const Unit& u, int wr, int wc, int fr, int fq) const {
        const int row0 = u.pm * 256 + wr * 64 + fr, col0 = u.pn * 128 + wc * 32 + 8 * fq;
        float rsv[2][4];
#pragma unroll
        for (int ai = 0; ai < 2; ++ai)
#pragma unroll
            for (int m = 0; m < 4; ++m) rsv[ai][m] = ss[row0 + ai * 128 + m * 16];
#pragma unroll
        for (int ai = 0; ai < 2; ++ai)
#pragma unroll
            for (int m = 0; m < 4; ++m) {
                const int row = row0 + ai * 128 + m * 16;
                const float rs = rstd_of(rsv[ai][m], 1.0f / D);
                unsigned w[4];
#pragma unroll
                for (int n = 0; n < 2; ++n) {
                    float hv[4];
#pragma unroll
                    for (int e = 0; e < 4; ++e) {
                        const float g = acc[ai][0][m][n][e] * rs, uu = acc[ai][1][m][n][e] * rs;
                        hv[e] = g * __builtin_amdgcn_rcpf(1.0f + __expf(-g)) * uu;
                    }
                    w[2 * n] = cvt_pk_bf16(hv[0], hv[1]); w[2 * n + 1] = cvt_pk_bf16(hv[2], hv[3]);
                }
                ST((u32x4*)(H + (size_t)row * FF + col0), ((u32x4){w[0], w[1], w[2], w[3]}));
            }
    }
};
struct EpiResid {
    static constexpr bool PERM = false, AFTER_DRAIN = false;
    const float* base; float* X; bf16_t* xb; float* ssn; float alpha;
    __device__ __forceinline__ void operator()(const f32x4 (&acc)[2][2][4][2], const Unit& u, int wr, int wc, int fr, int fq) const {
        const int row0 = u.pm * 256 + wr * 64 + fr, col0 = u.pn * 256 + wc * 32 + 4 * fq;
        f32x4 buf[2][2][2][2];
#define ER_LOAD(c) do { _Pragma("unroll") for (int mm = 0; mm < 2; ++mm) _Pragma("unroll") for (int bj = 0; bj < 2; ++bj) _Pragma("unroll") for (int n = 0; n < 2; ++n) \
            buf[(c) & 1][mm][bj][n] = *(const f32x4*)(base + (size_t)(row0 + ((c) >> 1) * 128 + (((c) & 1) * 2 + mm) * 16) * D + col0 + bj * 128 + n * 16); } while (0)
        ER_LOAD(0);
#pragma unroll
        for (int c = 0; c < 4; ++c) {
            if (c < 3) ER_LOAD(c + 1);
#pragma unroll
            for (int mm = 0; mm < 2; ++mm) {
                const int ai = c >> 1, m = (c & 1) * 2 + mm, row = row0 + ai * 128 + m * 16; float sq = 0.f;
#pragma unroll
                for (int bj = 0; bj < 2; ++bj)
#pragma unroll
                    for (int n = 0; n < 2; ++n) {
                        const size_t off = (size_t)row * D + col0 + bj * 128 + n * 16;
                        const f32x4 o = buf[c & 1][mm][bj][n] + acc[ai][bj][m][n] * alpha;
                        ST((f32x4*)(X + off), o);
                        ST((u32x2*)(xb + off), ((u32x2){cvt_pk_bf16(o[0], o[1]), cvt_pk_bf16(o[2], o[3])}));
                        sq += (o[0] * o[0] + o[1] * o[1]) + (o[2] * o[2] + o[3] * o[3]);
                    }
                sq += __shfl_xor(sq, 16); sq += __shfl_xor(sq, 32);
                if (fq == 0) unsafeAtomicAdd(ssn + row, sq);
            }
            asm volatile("" ::: "memory");
        }
#undef ER_LOAD
    }
};
struct EpiPle {
    static constexpr bool PERM = false, AFTER_DRAIN = false;
    float* X; const bf16_t* PP; const float* ss; bf16_t* xb; float* ssn;
    __device__ __forceinline__ void operator()(const f32x4 (&acc)[2][2][4][2], const Unit& u, int wr, int wc, int fr, int fq) const {
        int l_; asm volatile("v_mbcnt_lo_u32_b32 %0, -1, 0\n\tv_mbcnt_hi_u32_b32 %0, -1, %0" : "=v"(l_)); const int fr_ = l_ & 15, fq_ = l_ >> 4;
        const int row0 = u.pm * 256 + wr * 64 + fr_, col0 = u.pn * 256 + wc * 32 + 4 * fq_;
        f32x4 bx_[2][2][2]; u32x2 bp_[2][2][2]; float rsn_[2];
#define EP_LOAD(c) do { rsn_[(c) & 1] = ss[row0 + ((c) >> 2) * 128 + ((c) & 3) * 16]; _Pragma("unroll") for (int bj = 0; bj < 2; ++bj) _Pragma("unroll") for (int n = 0; n < 2; ++n) { \
            const size_t off_ = (size_t)(row0 + ((c) >> 2) * 128 + ((c) & 3) * 16) * D + col0 + bj * 128 + n * 16; bx_[(c) & 1][bj][n] = *(const f32x4*)(X + off_); bp_[(c) & 1][bj][n] = *(const u32x2*)(PP + off_); } } while (0)
        EP_LOAD(0);
#pragma unroll
        for (int c = 0; c < 8; ++c) {
            if (c < 7) EP_LOAD(c + 1);
            const int ai = c >> 2, m = c & 3, row = row0 + ai * 128 + m * 16; float sq = 0.f;
            const float rs = rstd_of(rsn_[c & 1], 1.0f / D);
#pragma unroll
            for (int bj = 0; bj < 2; ++bj)
#pragma unroll
                for (int n = 0; n < 2; ++n) {
                    const size_t off = (size_t)row * D + col0 + bj * 128 + n * 16;
                    const f32x4 bs = bx_[c & 1][bj][n]; const u32x2 pw = bp_[c & 1][bj][n]; const f32x4 pp = (f32x4){bf_lo(pw.x), bf_hi(pw.x), bf_lo(pw.y), bf_hi(pw.y)};
                    f32x4 o;
#pragma unroll
                    for (int e = 0; e < 4; ++e) { const float a = acc[ai][bj][m][n][e] * rs; o[e] = bs[e] + __builtin_amdgcn_rcpf(1.0f + __expf(-a)) * pp[e]; }
                    ST((f32x4*)(X + off), o);
                    if (xb) ST((u32x2*)(xb + off), ((u32x2){cvt_pk_bf16(o[0], o[1]), cvt_pk_bf16(o[2], o[3])}));
                    sq += (o[0] * o[0] + o[1] * o[1]) + (o[2] * o[2] + o[3] * o[3]);
                }
            sq += __shfl_xor(sq, 16); sq += __shfl_xor(sq, 32);
            if (fq_ == 0) unsafeAtomicAdd(ssn + row, sq);
            asm volatile("" ::: "memory");
        }
#undef EP_LOAD
    }
};
struct EpiScaleRow {
    static constexpr bool PERM = true, AFTER_DRAIN = false;
    bf16_t* O; int ldc; const float* ss;
    __device__ __forceinline__ void operator()(const f32x4 (&acc)[2][2][4][2], const Unit& u, int wr, int wc, int fr, int fq) const {
        const int row0 = u.pm * 256 + wr * 64 + fr, col0 = u.pn * 256 + wc * 32 + 8 * fq;
        float rsv[2][4];
#pragma unroll
        for (int ai = 0; ai < 2; ++ai)
#pragma unroll
            for (int m = 0; m < 4; ++m) rsv[ai][m] = ss[row0 + ai * 128 + m * 16];
#pragma unroll
        for (int ai = 0; ai < 2; ++ai)
#pragma unroll
            for (int m = 0; m < 4; ++m) {
                const int row = row0 + ai * 128 + m * 16;
                const float rs = rstd_of(rsv[ai][m], 1.0f / D);
#pragma unroll
                for (int bj = 0; bj < 2; ++bj) {
                    const f32x4 v0 = acc[ai][bj][m][0] * rs, v1 = acc[ai][bj][m][1] * rs;
                    ST((u32x4*)(O + (size_t)row * ldc + col0 + bj * 128), ((u32x4){cvt_pk_bf16(v0[0], v0[1]), cvt_pk_bf16(v0[2], v0[3]), cvt_pk_bf16(v1[0], v1[1]), cvt_pk_bf16(v1[2], v1[3])}));
                }
            }
    }
};
struct EpiScaleCol {
    static constexpr bool PERM = true, AFTER_DRAIN = false;
    bf16_t* O; int ldc; const float* ss;
    __device__ __forceinline__ void operator()(const f32x4 (&acc)[2][2][4][2], const Unit& u, int wr, int wc, int fr, int fq) const {
        const int row0 = u.pm * 256 + wr * 64 + fr, col0 = u.pn * 256 + wc * 32 + 8 * fq;
        const f32x4 sa0 = *(const f32x4*)(ss + col0), sb0 = *(const f32x4*)(ss + col0 + 4), sa1 = *(const f32x4*)(ss + col0 + 128), sb1 = *(const f32x4*)(ss + col0 + 132);
#pragma unroll
        for (int bj = 0; bj < 2; ++bj) {
            float rs[8];
            {
                const f32x4 a = bj == 0 ? sa0 : sa1, b = bj == 0 ? sb0 : sb1;
#pragma unroll
                for (int e = 0; e < 4; ++e) { rs[e] = rstd_of(a[e], 1.0f / D); rs[4 + e] = rstd_of(b[e], 1.0f / D); }
            }
#pragma unroll
            for (int ai = 0; ai < 2; ++ai)
#pragma unroll
                for (int m = 0; m < 4; ++m) {
                    const int row = row0 + ai * 128 + m * 16;
                    const f32x4 v0 = acc[ai][bj][m][0], v1 = acc[ai][bj][m][1];
                    ST((u32x4*)(O + (size_t)row * ldc + col0 + bj * 128), ((u32x4){cvt_pk_bf16(v0[0] * rs[0], v0[1] * rs[1]), cvt_pk_bf16(v0[2] * rs[2], v0[3] * rs[3]),
                                                                                  cvt_pk_bf16(v1[0] * rs[4], v1[1] * rs[5]), cvt_pk_bf16(v1[2] * rs[6], v1[3] * rs[7])}));
                }
        }
    }
};
struct EpiStoreBf16 {
    static constexpr bool PERM = false, AFTER_DRAIN = false;
    bf16_t* O; int ldc;
    __device__ __forceinline__ void operator()(const f32x4 (&acc)[2][2][4][2], const Unit& u, int wr, int wc, int fr, int fq) const {
        int l_; asm volatile("v_mbcnt_lo_u32_b32 %0, -1, 0\n\tv_mbcnt_hi_u32_b32 %0, -1, %0" : "=v"(l_)); const int fr_ = l_ & 15, fq_ = l_ >> 4;
        const int row0 = u.pm * 256 + wr * 64 + fr_, col0 = u.pn * 256 + wc * 32 + 4 * fq_;
#pragma unroll
        for (int ai = 0; ai < 2; ++ai)
#pragma unroll
            for (int m = 0; m < 4; ++m)
#pragma unroll
                for (int bj = 0; bj < 2; ++bj)
#pragma unroll
                    for (int n = 0; n < 2; ++n) { const f32x4 v = acc[ai][bj][m][n]; ST((u32x2*)(O + (size_t)(row0 + ai * 128 + m * 16) * ldc + col0 + bj * 128 + n * 16), ((u32x2){cvt_pk_bf16(v[0], v[1]), cvt_pk_bf16(v[2], v[3])})); }
    }
};
struct EpiStoreF32 {
    static constexpr bool PERM = false, AFTER_DRAIN = false;
    float* O; int ldc;
    __device__ __forceinline__ void operator()(const f32x4 (&acc)[2][2][4][2], const Unit& u, int wr, int wc, int fr, int fq) const {
        const int row0 = u.pm * 256 + wr * 64 + fr, col0 = u.pn * 256 + wc * 32 + 4 * fq;
#pragma unroll
        for (int ai = 0; ai < 2; ++ai)
#pragma unroll
            for (int m = 0; m < 4; ++m)
#pragma unroll
                for (int bj = 0; bj < 2; ++bj)
#pragma unroll
                    for (int n = 0; n < 2; ++n) ST((f32x4*)(O + (size_t)(row0 + ai * 128 + m * 16) * ldc + col0 + bj * 128 + n * 16), acc[ai][bj][m][n]);
    }
};

struct EpiDry {
    static constexpr bool PERM = false, AFTER_DRAIN = false;
    __device__ __forceinline__ void operator()(const f32x4 (&acc)[2][2][4][2], const Unit& u, int wr, int wc, int fr, int fq) const {
#pragma unroll
        for (int ai = 0; ai < 2; ++ai)
#pragma unroll
            for (int bj = 0; bj < 2; ++bj)
#pragma unroll
                for (int m = 0; m < 4; ++m)
#pragma unroll
                    for (int n = 0; n < 2; ++n) asm volatile("" :: "v"(acc[ai][bj][m][n]));
    }
};
template <class Epi>
__device__ __forceinline__ void gemm_naive(int wv, const Gemm g, const StaticOrder& S, const Epi& E) {
    const int tid = fresh_tid(wv), wid = tid >> 6, lane = tid & 63, wr = wid >> 2, wc = wid & 3, fr = lane & 15, fq = lane >> 4;
    Unit u;
    for (int ui = 0; S.next(ui, u); ++ui) {
        f32x4 acc[2][2][4][2];
#pragma unroll
        for (int a = 0; a < 2; ++a)
#pragma unroll
            for (int b = 0; b < 2; ++b)
#pragma unroll
                for (int m = 0; m < 4; ++m)
#pragma unroll
                    for (int n = 0; n < 2; ++n) acc[a][b][m][n] = (f32x4){0.f, 0.f, 0.f, 0.f};
        for (int k0 = 0; k0 < g.K; k0 += 32) {
            bf16x8 Bf[2][2];
#pragma unroll
            for (int bj = 0; bj < 2; ++bj)
#pragma unroll
                for (int n = 0; n < 2; ++n) {
                    const int slot = 16 * n + fr; const int rr = Epi::PERM ? pg8::perm32(slot) : slot;
                    Bf[bj][n] = *(const bf16x8*)(g.Bt + (size_t)(u.pn * 256 + bj * 128 + wc * 32 + rr) * g.K + k0 + 8 * fq);
                }
#pragma unroll
            for (int ai = 0; ai < 2; ++ai)
#pragma unroll
                for (int m = 0; m < 4; ++m) {
                    const bf16x8 Af = *(const bf16x8*)(g.A + (size_t)(u.pm * 256 + ai * 128 + wr * 64 + m * 16 + fr) * g.K + k0 + 8 * fq);
#pragma unroll
                    for (int bj = 0; bj < 2; ++bj)
#pragma unroll
                        for (int n = 0; n < 2; ++n) acc[ai][bj][m][n] = __builtin_amdgcn_mfma_f32_16x16x32_bf16(Bf[bj][n], Af, acc[ai][bj][m][n], 0, 0, 0);
                }
        }
        E(acc, u, wr, wc, fr, fq);
    }
}
template <class Epi>
__device__ __forceinline__ void gemm_run(int wv, LAS unsigned char* lds, const bf16_t* A, const bf16_t* Bt, int Mm, int Nn, int Kk, const Epi& E, bool upper_half_only = false) {
    int bx_ = blockIdx.x; asm volatile("" : "+s"(bx_));
    int G_ = (int)gridDim.x;
    if (upper_half_only) { const int lo = G_ / 2; if (bx_ >= lo) { bx_ -= lo; G_ -= lo; } else bx_ = 1 << 28; }
    Gemm g{A, Bt, Mm, Nn, Kk}; StaticOrder S; S.init(Mm, Nn, G_, bx_);
#if NAIVE_GEMM
    gemm_naive<Epi>(wv, g, S, E);
    __syncthreads();
#else
    pg8::gemm_phase<Epi, StaticOrder, true, true>(lds, g, S, E, fresh_tid(wv));
#endif
}

__device__ __forceinline__ void transpose_item(const float* W, int K, int N, const float* gain, bf16_t* WT, int mode, int row_off, LAS float* scr, int item, int lane) {
    const int nblk = N / 32, kb = item / nblk, nb = item % nblk, k0 = 64 * kb, n0 = 32 * nb;
    f32x4 v[8];
#pragma unroll
    for (int i = 0; i < 8; ++i) v[i] = *(const f32x4*)(W + (size_t)(k0 + (lane >> 3) + 8 * i) * N + n0 + 4 * (lane & 7));
#pragma unroll
    for (int i = 0; i < 8; ++i) {
        const int kk = (lane >> 3) + 8 * i; const float gg = gain ? gain[k0 + kk] : 1.0f;
        LAS float* d = scr + kk * 33 + 4 * (lane & 7);
        d[0] = v[i][0] * gg; d[1] = v[i][1] * gg; d[2] = v[i][2] * gg; d[3] = v[i][3] * gg;
    }
    asm volatile("s_waitcnt lgkmcnt(0)" ::: "memory");
    const int c = lane & 7;
#pragma unroll
    for (int j = 0; j < 4; ++j) {
        const int n = (lane >> 3) + 8 * j, ncol = n0 + n; const LAS float* s = scr + (8 * c) * 33 + n;
        const int row = (mode == 1) ? (256 * (ncol >> 7) + (ncol & 127) + row_off) : (row_off + ncol);
        const float sc = (mode == 2 && ncol < 512) ? 0.125f : 1.0f;
        u32x4 o; o.x = cvt_pk_bf16(s[0 * 33] * sc, s[1 * 33] * sc); o.y = cvt_pk_bf16(s[2 * 33] * sc, s[3 * 33] * sc); o.z = cvt_pk_bf16(s[4 * 33] * sc, s[5 * 33] * sc); o.w = cvt_pk_bf16(s[6 * 33] * sc, s[7 * 33] * sc);
        *(u32x4*)(WT + (size_t)row * K + k0 + 8 * c) = o;
    }
    asm volatile("s_waitcnt lgkmcnt(0)" ::: "memory");
}

constexpr float MIN_DECAY = -3.0701134573253946f, MAX_DECAY = -15.350567286626973f;
__device__ __forceinline__ float rdl(float v, int k) { return __shfl(v, k); }
__device__ __forceinline__ void filter_item(KPC p, int layer, int item, int lane, float* FT) {
    const float* wf1 = p->in[11] + layer * 33 * 64; const float* bf1 = p->in[12] + layer * 64;
    const float* wf2 = p->in[13] + layer * 4096;    const float* bf2 = p->in[14] + layer * 64;
    const float* wf3 = p->in[15] + layer * 4096;    const float* bf3 = p->in[16] + layer * 64;
    const float* wf4 = p->in[17] + layer * 64 * 1024; const float fq = p->in[18][layer * 64 + lane];
    const int i0 = item * 2;
    float h[2], wc[64];
#pragma unroll
    for (int k = 0; k < 33; ++k) wc[k] = wf1[k * 64 + lane];
    const float bb1 = bf1[lane], bb2 = bf2[lane], bb3 = bf3[lane];
#pragma unroll
    for (int q = 0; q < 2; ++q) {
        const int i = i0 + q;
        const float t = (float)i * (1.0f / 2047.0f), w = 6.283185307179586f * (float)i / 2048.0f;
        const int j = (lane - 1) & 15; const float f = 1e-4f + (float)j * ((15.0f - 1e-4f) / 15.0f);
        const float a = f * w;
        float zf = 0.f;
        if (lane == 0) zf = t; else if (lane <= 16) zf = __cosf(a); else if (lane <= 32) zf = -__sinf(a);
        float s = bb1;
#pragma unroll
        for (int k = 0; k < 33; ++k) s += rdl(zf, k) * wc[k];
        h[q] = __sinf(fq * s);
    }
#pragma unroll
    for (int k = 0; k < 64; ++k) wc[k] = wf2[k * 64 + lane];
#pragma unroll
    for (int q = 0; q < 2; ++q) {
        float s = bb2;
#pragma unroll
        for (int k = 0; k < 64; ++k) s += rdl(h[q], k) * wc[k];
        h[q] = __sinf(fq * s);
    }
#pragma unroll
    for (int k = 0; k < 64; ++k) wc[k] = wf3[k * 64 + lane];
#pragma unroll
    for (int q = 0; q < 2; ++q) {
        float s = bb3;
#pragma unroll
        for (int k = 0; k < 64; ++k) s += rdl(h[q], k) * wc[k];
        h[q] = __sinf(fq * s);
    }
    float acc[2][16];
#pragma unroll
    for (int q = 0; q < 2; ++q)
#pragma unroll
        for (int jj = 0; jj < 16; ++jj) acc[q][jj] = 0.f;
    for (int k0 = 0; k0 < 64; k0 += 4) {
        float w[4][16];
#pragma unroll
        for (int kk = 0; kk < 4; ++kk)
#pragma unroll
            for (int jj = 0; jj < 16; ++jj) w[kk][jj] = wf4[(k0 + kk) * 1024 + lane + 64 * jj];
#pragma unroll
        for (int kk = 0; kk < 4; ++kk) {
            const float h0 = rdl(h[0], k0 + kk), h1 = rdl(h[1], k0 + kk);
#pragma unroll
            for (int jj = 0; jj < 16; ++jj) { acc[0][jj] += h0 * w[kk][jj]; acc[1][jj] += h1 * w[kk][jj]; }
        }
    }
#pragma unroll
    for (int jj = 0; jj < 16; ++jj) {
        const int cf = lane + 64 * jj, dir = cf >> 9, c = cf & 511;
        const float delta = fabsf(MIN_DECAY + (float)c * ((MAX_DECAY - MIN_DECAY) / 511.0f));
        f32x2 o;
#pragma unroll
        for (int q = 0; q < 2; ++q) { const float t = (float)(i0 + q) * (1.0f / 2047.0f); o[q] = acc[q][jj] * __expf(-t * delta); }
        *(f32x2*)(FT + ((size_t)(dir * 512 + c)) * SEQ + i0) = o;
    }
}

__device__ __forceinline__ void filter_block(KPC p, int layer, int item, int lane, int tid, LAS unsigned char* lds, float* FT) {
    const float* wf1 = p->in[11] + layer * 33 * 64; const float* bf1 = p->in[12] + layer * 64;
    const float* wf2 = p->in[13] + layer * 4096;    const float* bf2 = p->in[14] + layer * 64;
    const float* wf3 = p->in[15] + layer * 4096;    const float* bf3 = p->in[16] + layer * 64;
    const float* wf4 = p->in[17] + layer * 64 * 1024; const float fq = p->in[18][layer * 64 + lane];
    const int i0 = item * 2;
    float h[2], wc[64];
#pragma unroll
    for (int k = 0; k < 33; ++k) wc[k] = wf1[k * 64 + lane];
    const float bb1 = bf1[lane], bb2 = bf2[lane], bb3 = bf3[lane];
#pragma unroll
    for (int q = 0; q < 2; ++q) {
        const int i = i0 + q;
        const float t = (float)i * (1.0f / 2047.0f), w = 6.283185307179586f * (float)i / 2048.0f;
        const int j = (lane - 1) & 15; const float f = 1e-4f + (float)j * ((15.0f - 1e-4f) / 15.0f);
        const float a = f * w;
        float zf = 0.f;
        if (lane == 0) zf = t; else if (lane <= 16) zf = __cosf(a); else if (lane <= 32) zf = -__sinf(a);
        float s = bb1;
#pragma unroll
        for (int k = 0; k < 33; ++k) s += rdl(zf, k) * wc[k];
        h[q] = __sinf(fq * s);
    }
#pragma unroll
    for (int k = 0; k < 64; ++k) wc[k] = wf2[k * 64 + lane];
#pragma unroll
    for (int q = 0; q < 2; ++q) {
        float s = bb2;
#pragma unroll
        for (int k = 0; k < 64; ++k) s += rdl(h[q], k) * wc[k];
        h[q] = __sinf(fq * s);
    }
#pragma unroll
    for (int k = 0; k < 64; ++k) wc[k] = wf3[k * 64 + lane];
#pragma unroll
    for (int q = 0; q < 2; ++q) {
        float s = bb3;
#pragma unroll
        for (int k = 0; k < 64; ++k) s += rdl(h[q], k) * wc[k];
        h[q] = __sinf(fq * s);
    }
    float acc[2][16];
#pragma unroll
    for (int q = 0; q < 2; ++q)
#pragma unroll
        for (int jj = 0; jj < 16; ++jj) acc[q][jj] = 0.f;
    LAS float* WL = (LAS float*)lds;
    for (int ck = 0; ck < 4; ++ck) {
        __syncthreads();
        f32x4 t[8];
#pragma unroll
        for (int u = 0; u < 8; ++u) t[u] = *(const f32x4*)(wf4 + (size_t)ck * 16384 + (size_t)(tid + 512 * u) * 4);
#pragma unroll
        for (int u = 0; u < 8; ++u) *(LAS f32x4*)(WL + (tid + 512 * u) * 4) = t[u];
        __syncthreads();
#pragma unroll 1
        for (int kk = 0; kk < 16; ++kk) {
            const float h0 = rdl(h[0], ck * 16 + kk), h1 = rdl(h[1], ck * 16 + kk);
#pragma unroll
            for (int jj = 0; jj < 16; ++jj) { const float w = WL[kk * 1024 + lane + 64 * jj]; acc[0][jj] += h0 * w; acc[1][jj] += h1 * w; }
        }
    }
    __syncthreads();
    LAS float* OUTL = (LAS float*)lds;
    const int wvq = (item & 7) * 2;
#pragma unroll
    for (int jj = 0; jj < 16; ++jj) {
        const int cf = lane + 64 * jj, c = cf & 511;
        const float delta = fabsf(MIN_DECAY + (float)c * ((MAX_DECAY - MIN_DECAY) / 511.0f));
#pragma unroll
        for (int q = 0; q < 2; ++q) { const float t = (float)(i0 + q) * (1.0f / 2047.0f); OUTL[(wvq + q) * 1024 + cf] = acc[q][jj] * __expf(-t * delta); }
    }
    __syncthreads();
    {
        const int ib = (item >> 3) * 16;
#pragma unroll
        for (int u = 0; u < 8; ++u) {
            const int id = tid + 512 * u, cf = id >> 2, part = id & 3;
            const f32x4 v = (f32x4){OUTL[(4 * part + 0) * 1024 + cf], OUTL[(4 * part + 1) * 1024 + cf], OUTL[(4 * part + 2) * 1024 + cf], OUTL[(4 * part + 3) * 1024 + cf]};
            *(f32x4*)(FT + (size_t)cf * SEQ + ib + 4 * part) = v;
        }
    }
    __syncthreads();
}

constexpr int TI_G = 16 * 88, TI_D = 44 * 32, TI_IN = 16 * 96, TI_O = 16 * 32, TI_PP = 4 * 32;
constexpr int TI_ALL = 6 * TI_G + TI_IN + 2 * TI_O + TI_PP, TI_EARLY = TI_ALL - 3072;
__device__ __forceinline__ void do_transpose(KPC p, size_t lf, unsigned char* Wb, LAS float* scr, int r, int lane) {
    constexpr int I_G = TI_G, I_D = TI_D, I_IN = TI_IN, I_O = TI_O;
    int wi, gi = -1, K = D, N = FF, mode = 1, row_off = 0; size_t wo = W_GUA, wstride = (size_t)D * FF;
    if (r < I_G) { wi = 3; gi = 2; }
    else if ((r -= I_G) < I_G) { wi = 4; gi = 2; row_off = 128; }
    else if ((r -= I_G) < I_D) { wi = 5; K = FF; N = D; mode = 0; wo = W_DA; }
    else if ((r -= I_D) < I_IN) { wi = 7; gi = 6; N = 3072; mode = 2; wo = W_IN; wstride = (size_t)D * 3072; }
    else if ((r -= I_IN) < I_O) { wi = 21; gi = 20; N = D; mode = 0; wo = W_OUT; wstride = (size_t)D * D; }
    else if ((r -= I_O) < I_G) { wi = 23; gi = 22; wo = W_GUB; }
    else if ((r -= I_G) < I_G) { wi = 24; gi = 22; row_off = 128; wo = W_GUB; }
    else if ((r -= I_G) < I_D) { wi = 25; K = FF; N = D; mode = 0; wo = W_DB; }
    else if ((r -= I_D) < I_O) { wi = 27; gi = 26; N = D; mode = 0; wo = W_PG; wstride = (size_t)D * D; }
    else { r -= I_O; wi = 28; K = PLE; N = D; mode = 0; wo = W_PP; wstride = (size_t)PLE * D; }
    const float* gain = gi >= 0 ? p->in[gi] + lf * D : nullptr;
    transpose_item(p->in[wi] + lf * wstride, K, N, gain, (bf16_t*)(Wb + wo), mode, row_off, scr, r, lane);
}
__device__ __forceinline__ void late_transposes(int wv, KPC p, int layer, LAS unsigned char* lds) {
    const int tid = fresh_tid(wv), bx = fresh_bx(), lane = tid & 63, G = gridDim.x;
    if (G * 8 != 2048 || bx < G / 2) return;
    LAS float* scr = (LAS float*)(lds + wv * 16384);
    unsigned char* Wb = p->ws + WS_W;
    const int gw = (bx - G / 2) * 8 + wv, NGW = (G - G / 2) * 8;
    const int tie = TI_ALL - (layer == 0 ? 2048 : 4096);
    for (int r = tie + gw; r < TI_ALL; r += NGW) do_transpose(p, (size_t)layer, Wb, scr, r, lane);
    if (layer == 0) {
        bf16_t* pb = (bf16_t*)(p->ws + WS_PB);
        const size_t n8 = (size_t)2 * M * PLE / 8;
        for (size_t i = (size_t)(bx - G / 2) * 512 + tid; i < n8; i += (size_t)(G - G / 2) * 512) {
            const f32x4 a = *(const f32x4*)(p->in[1] + i * 8), b = *(const f32x4*)(p->in[1] + i * 8 + 4);
            *(u32x4*)(pb + i * 8) = (u32x4){cvt_pk_bf16(a[0], a[1]), cvt_pk_bf16(a[2], a[3]), cvt_pk_bf16(b[0], b[1]), cvt_pk_bf16(b[2], b[3])};
        }
    }
}
__device__ __forceinline__ void layer_prologue(int wv, KPC p, int layer, LAS unsigned char* lds) {
    const int tid = fresh_tid(wv), bx = fresh_bx(), lane = tid & 63, wave = wv;
    LAS float* scr = (LAS float*)(lds + wave * 16384);
    const int gw = bx * 8 + wave, NGW = gridDim.x * 8;
    unsigned char* Wb = p->ws + WS_W;
    const size_t lf = (size_t)layer;
    constexpr int I_G = 16 * 88, I_D = 44 * 32, I_IN = 16 * 96, I_O = 16 * 32, I_PP = 4 * 32;
    constexpr int NITEMS = 6 * I_G + I_IN + 2 * I_O + I_PP;
    static_assert(I_G == I_D, "items");
    const int tie = TI_ALL - (layer == 0 ? 2048 : 4096);
    const bool std_grid = (NGW == 2048), fw = gw < 1024;
    const int per = fw ? 1 : 3, base = fw ? gw : 1024 + 3 * (gw - 1024);
    for (int k = 0; ; ++k) {
        int r;
        if (std_grid) {
            if (fw && k == 0) { filter_block(p, layer, gw, lane, tid, lds, (float*)(p->ws + WS_FT)); continue; }
            const int kk = fw ? k - 1 : k, rd = kk / per, sub = kk % per; r = rd * 4096 + base + sub; if (rd * 4096 >= tie) break; if (r >= tie) continue;
        } else break;
        do_transpose(p, lf, Wb, scr, r, lane);
    }
    if (layer == 0) {
        bf16_t* xb = (bf16_t*)(p->ws + WS_XB); float* ss0 = (float*)(p->ws + WS_CTL);
        for (int m = gw; m < M; m += NGW) {
            const f32x4* xr = (const f32x4*)(p->in[0] + (size_t)m * D) + lane;
            f32x4 v[4]; float s = 0.f;
#pragma unroll
            for (int j = 0; j < 4; ++j) { v[j] = xr[64 * j]; s += (v[j][0] * v[j][0] + v[j][1] * v[j][1]) + (v[j][2] * v[j][2] + v[j][3] * v[j][3]); }
            s = wave_sum(s);
            if (lane == 0) ss0[m] = s;
            u32x2* o8 = (u32x2*)(xb + (size_t)m * D) + lane;
#pragma unroll
            for (int j = 0; j < 4; ++j) o8[64 * j] = (u32x2){cvt_pk_bf16(v[j][0], v[j][1]), cvt_pk_bf16(v[j][2], v[j][3])};
        }
    }
}

__device__ __forceinline__ void attn_naive(int wv, KPC p, int layer, const bf16_t* QK, const bf16_t* UT, bf16_t* yna) {
    const float* rpb = p->in[8] + layer * 8 * 15 * 31;
    const int tid = fresh_tid(wv), bx = fresh_bx();
    for (int it = bx * 512 + tid; it < M * 8; it += gridDim.x * 512) {
        const int h = it / M, tok = it % M;
        const int b = tok >> 11, l = tok & 2047, r = l >> 6, qc = l & 63;
        const int rs = min(max(r - 4, 0), 24), qcs = min(max(qc - 8, 0), 48);
        float o[64]; u32x4 qp[8];
#pragma unroll
        for (int j = 0; j < 8; ++j) qp[j] = *(const u32x4*)(QK + (size_t)tok * 1024 + 64 * h + 8 * j);
#pragma unroll
        for (int d = 0; d < 64; ++d) o[d] = 0.f;
        float mx = -3.0e38f, ls = 0.f;
        for (int kr = 0; kr < 8; ++kr)
            for (int kx = 0; kx < 16; ++kx) {
                const int krow = rs + kr, kc = qcs + kx; const size_t ktok = (size_t)b * 2048 + krow * 64 + kc;
                float s = 0.f;
#pragma unroll
                for (int j = 0; j < 8; ++j) {
                    const u32x4 v = *(const u32x4*)(QK + ktok * 1024 + 512 + 64 * h + 8 * j);
                    const u32x4 qq = qp[j];
                    s += bf_lo(qq.x) * bf_lo(v.x) + bf_hi(qq.x) * bf_hi(v.x) + bf_lo(qq.y) * bf_lo(v.y) + bf_hi(qq.y) * bf_hi(v.y)
                       + bf_lo(qq.z) * bf_lo(v.z) + bf_hi(qq.z) * bf_hi(v.z) + bf_lo(qq.w) * bf_lo(v.w) + bf_hi(qq.w) * bf_hi(v.w);
                }
                s += rpb[(h * 15 + (krow - r + 7)) * 31 + (kc - qc + 15)];
                const float mn = fmaxf(mx, s), corr = __expf(mx - mn), pe = __expf(s - mn);
                ls = ls * corr + pe; mx = mn;
#pragma unroll
                for (int d = 0; d < 64; ++d) o[d] = o[d] * corr + pe * bf2f(UT[(size_t)(64 * h + d) * M + ktok]);
            }
        const float inv = 1.0f / ls;
#pragma unroll
        for (int j = 0; j < 8; ++j)
            *(u32x4*)(yna + (size_t)tok * 512 + 64 * h + 8 * j) = (u32x4){cvt_pk_bf16(o[8 * j] * inv, o[8 * j + 1] * inv), cvt_pk_bf16(o[8 * j + 2] * inv, o[8 * j + 3] * inv),
                                                                         cvt_pk_bf16(o[8 * j + 4] * inv, o[8 * j + 5] * inv), cvt_pk_bf16(o[8 * j + 6] * inv, o[8 * j + 7] * inv)};
    }
}

__device__ __forceinline__ float sconv(const bf16_t* row, int t, float w0, float w1, float w2, float bb) {
    const float a = t > 0 ? bf2f(row[t - 1]) : 0.f, b = bf2f(row[t]), c = t < SEQ - 1 ? bf2f(row[t + 1]) : 0.f;
    return a * w0 + b * w1 + c * w2 + bb;
}
__device__ __forceinline__ void conv_naive(int wv, KPC p, int layer, LAS unsigned char* lds, const bf16_t* UT, const float* FT, bf16_t* yhyT) {
    LAS float* karr = (LAS float*)lds; LAS float* zf = karr + 4096; LAS float* x0f = zf + 2048; LAS float* red = x0f + 2048;
    const float* wsc = p->in[9] + layer * 3 * 1536; const float* bsc = p->in[10] + layer * 1536; const float* hyb = p->in[19] + layer * 512;
    const int tid = fresh_tid(wv), bx = fresh_bx(), lane = tid & 63, wave = wv;
    for (int it = bx; it < 512 * 8; it += gridDim.x) {
        const int c = it >> 3, b = it & 7;
        __syncthreads();
        float asum = 0.f;
        for (int d = tid; d < 4096; d += 512) {
            const int dd = d - 2048; float v;
            if (dd == -2048) v = 0.f; else if (dd == 0) v = FT[(size_t)c * SEQ] + FT[(size_t)(512 + c) * SEQ]; else if (dd > 0) v = FT[(size_t)c * SEQ + dd]; else v = FT[(size_t)(512 + c) * SEQ - dd];
            karr[d] = v; asum += fabsf(v);
        }
        {
            const bf16_t* r0 = UT + (size_t)(512 + c) * M + b * 2048; const bf16_t* r1 = UT + (size_t)(1024 + c) * M + b * 2048; const bf16_t* r2 = UT + (size_t)(1536 + c) * M + b * 2048;
            const float a0 = wsc[c], a1 = wsc[1536 + c], a2 = wsc[3072 + c], ab = bsc[c];
            const float b0 = wsc[512 + c], b1 = wsc[1536 + 512 + c], b2 = wsc[3072 + 512 + c], bb = bsc[512 + c];
            const float c0 = wsc[1024 + c], c1 = wsc[1536 + 1024 + c], c2 = wsc[3072 + 1024 + c], cb = bsc[1024 + c];
            for (int t = tid; t < 2048; t += 512) {
                x0f[t] = sconv(r0, t, a0, a1, a2, ab);
                zf[t] = sconv(r1, t, b0, b1, b2, bb) * sconv(r2, t, c0, c1, c2, cb);
            }
        }
        asum = wave_sum(asum);
        if (lane == 0) red[wave] = asum;
        __syncthreads();
        float kn = 0.f;
#pragma unroll
        for (int w = 0; w < 8; ++w) kn += red[w];
        const float ikn = 1.0f / kn, hb = hyb[c];
#pragma unroll
        for (int e = 0; e < 4; ++e) {
            const int t = tid + 512 * e; float acc = 0.f;
            for (int s = 0; s < 2048; ++s) acc += karr[t - s + 2048] * zf[s];
            const float y = x0f[t] * (acc * ikn + zf[t] * hb);
            yhyT[(size_t)c * M + b * 2048 + t] = (bf16_t)(cvt_pk_bf16(y, 0.f) & 0xffffu);
        }
    }
}


__device__ __forceinline__ void attn_mfma(int wv, KPC p, int layer, const bf16_t* QK, const bf16_t* UT, bf16_t* yna) {
    const float* rpb = p->in[8] + layer * 8 * 15 * 31;
    const int tid = fresh_tid(wv), bx = fresh_bx(), lane = tid & 63, qi = lane & 15, g = lane >> 4;
    for (int it = bx * 8 + wv; it < 8192; it += gridDim.x * 8) {
        const int h = it & 7, j = (it >> 3) & 3, r = (it >> 5) & 31, b = it >> 10;
        const int rs = min(max(r - 4, 0), 24), bc0 = min(max(16 * j - 8, 0), 32);
        const int qc = 16 * j + qi, qcs = min(max(qc - 8, 0), 48);
        const size_t qtok = (size_t)b * 2048 + r * 64 + qc;
        const bf16x8 qf0 = *(const bf16x8*)(QK + qtok * 1024 + 64 * h + 8 * g), qf1 = *(const bf16x8*)(QK + qtok * 1024 + 64 * h + 32 + 8 * g);
        f32x4 s[16];
#pragma unroll
        for (int T = 0; T < 16; ++T) {
            const size_t ktok = (size_t)b * 2048 + (rs + (T >> 1)) * 64 + bc0 + 8 * (qi >> 2) + 4 * (T & 1) + (qi & 3);
            const bf16x8 k0 = *(const bf16x8*)(QK + ktok * 1024 + 512 + 64 * h + 8 * g), k1 = *(const bf16x8*)(QK + ktok * 1024 + 512 + 64 * h + 32 + 8 * g);
            f32x4 z = (f32x4){0.f, 0.f, 0.f, 0.f};
            z = __builtin_amdgcn_mfma_f32_16x16x32_bf16(k0, qf0, z, 0, 0, 0);
            z = __builtin_amdgcn_mfma_f32_16x16x32_bf16(k1, qf1, z, 0, 0, 0);
            s[T] = z;
        }
        float mx = -3.0e38f;
#pragma unroll
        for (int T = 0; T < 16; ++T)
#pragma unroll
            for (int e = 0; e < 4; ++e) {
                const int kc = bc0 + 8 * g + 4 * (T & 1) + e, kr = rs + (T >> 1);
                const bool valid = (kc >= qcs) && (kc < qcs + 16);
                float v = -3.0e38f;
                if (valid) v = s[T][e] + rpb[(h * 15 + kr - r + 7) * 31 + kc - qc + 15];
                s[T][e] = v; mx = fmaxf(mx, v);
            }
        mx = fmaxf(mx, __shfl_xor(mx, 16)); mx = fmaxf(mx, __shfl_xor(mx, 32));
        float ls = 0.f;
#pragma unroll
        for (int T = 0; T < 16; ++T)
#pragma unroll
            for (int e = 0; e < 4; ++e) { const float pe = __expf(s[T][e] - mx); s[T][e] = pe; ls += pe; }
        ls += __shfl_xor(ls, 16); ls += __shfl_xor(ls, 32);
        f32x4 o[4];
#pragma unroll
        for (int dt = 0; dt < 4; ++dt) o[dt] = (f32x4){0.f, 0.f, 0.f, 0.f};
#pragma unroll
        for (int kr = 0; kr < 8; ++kr) {
            const u32x4 pw = (u32x4){cvt_pk_bf16(s[2 * kr][0], s[2 * kr][1]), cvt_pk_bf16(s[2 * kr][2], s[2 * kr][3]), cvt_pk_bf16(s[2 * kr + 1][0], s[2 * kr + 1][1]), cvt_pk_bf16(s[2 * kr + 1][2], s[2 * kr + 1][3])};
            const bf16x8 pf = __builtin_bit_cast(bf16x8, pw);
#pragma unroll
            for (int dt = 0; dt < 4; ++dt) {
                const bf16x8 vf = *(const bf16x8*)(UT + (size_t)(64 * h + 16 * dt + qi) * M + (size_t)b * 2048 + (rs + kr) * 64 + bc0 + 8 * g);
                o[dt] = __builtin_amdgcn_mfma_f32_16x16x32_bf16(vf, pf, o[dt], 0, 0, 0);
            }
        }
        const float inv = 1.0f / ls;
#pragma unroll
        for (int dt = 0; dt < 4; ++dt)
            *(u32x2*)(yna + qtok * 512 + 64 * h + 16 * dt + 4 * g) = (u32x2){cvt_pk_bf16(o[dt][0] * inv, o[dt][1] * inv), cvt_pk_bf16(o[dt][2] * inv, o[dt][3] * inv)};
    }
}


__device__ __forceinline__ void attn_lds(int wv, KPC p, int layer, LAS unsigned char* lds, const bf16_t* QK, const bf16_t* UT, bf16_t* yna) {
    constexpr int KTS = 144, VRS = 976;
    LAS unsigned char* KL = lds; LAS unsigned char* VL = lds + 480 * KTS; LAS float* BL = (LAS float*)(VL + 64 * VRS);
    const float* rpb = p->in[8] + layer * 8 * 15 * 31;
    const int tid = fresh_tid(wv), bx = fresh_bx(), lane = tid & 63, qi = lane & 15, g = lane >> 4;
    u32x4 kst[8], vst[8]; float bst = 0.f; bf16x8 qn0, qn1;
#define ATT_DECODE(bi_) const int rho = (bi_) & 3, j = ((bi_) >> 2) & 3, h = ((bi_) >> 4) & 7, b = (bi_) >> 7; \
        const int krow0 = min(max(8 * rho - 4, 0), 24), nrows = min(max(8 * rho + 3, 0), 24) + 8 - krow0; const int bc0 = min(max(16 * j - 8, 0), 32);
#define ATT_LOAD(bi_) do { ATT_DECODE(bi_);   \
        _Pragma("unroll") for (int k = 0; k < 8; ++k) { const int idx = min(tid + 512 * k, nrows * 256 - 1); const int tl = idx >> 3, ch = idx & 7; \
            kst[k] = *(const u32x4*)(QK + ((size_t)b * 2048 + (krow0 + (tl >> 5)) * 64 + bc0 + (tl & 31)) * 1024 + 512 + 64 * h + 8 * ch); } \
        _Pragma("unroll") for (int k = 0; k < 8; ++k) { const int e = min((tid & 7) + 8 * k, nrows * 4 - 1); const int lr = e >> 2, ch = e & 3; \
            vst[k] = *(const u32x4*)(UT + (size_t)(64 * h + (tid >> 3)) * M + (size_t)b * 2048 + (krow0 + lr) * 64 + bc0 + 8 * ch); } \
        bst = rpb[h * 465 + min(tid, 464)]; \
        { const size_t qt_ = (size_t)b * 2048 + (8 * rho + wv) * 64 + 16 * j + qi; qn0 = *(const bf16x8*)(QK + qt_ * 1024 + 64 * h + 8 * g); qn1 = *(const bf16x8*)(QK + qt_ * 1024 + 64 * h + 32 + 8 * g); } } while (0)
    const int G_ = gridDim.x, vb = (G_ % 8 == 0) ? (bx & 7) * (G_ >> 3) + (bx >> 3) : bx;
    if (vb < 1024) ATT_LOAD(vb);
    for (int bi = vb; bi < 1024; bi += G_) {
        ATT_DECODE(bi);
        __syncthreads();
#pragma unroll
        for (int k = 0; k < 8; ++k) { const int idx = min(tid + 512 * k, nrows * 256 - 1); *(LAS u32x4*)(KL + (idx >> 3) * KTS + 16 * (idx & 7)) = kst[k]; }
#pragma unroll
        for (int k = 0; k < 8; ++k) { const int e = min((tid & 7) + 8 * k, nrows * 4 - 1); *(LAS u32x4*)(VL + (tid >> 3) * VRS + ((e >> 2) * 32 + 8 * (e & 3)) * 2) = vst[k]; }
        if (tid < 465) BL[tid] = bst;
        const bf16x8 qf0 = qn0, qf1 = qn1;
        __syncthreads();
        if (bi + G_ < 1024) ATT_LOAD(bi + G_);
        const int r = 8 * rho + wv, rs = min(max(r - 4, 0), 24), lr0 = rs - krow0;
        const int qc = 16 * j + qi, qcs = min(max(qc - 8, 0), 48);
        const size_t qtok = (size_t)b * 2048 + r * 64 + qc;
        f32x4 s[16];
#pragma unroll
        for (int T = 0; T < 16; ++T) {
            const int tl = (lr0 + (T >> 1)) * 32 + 8 * (qi >> 2) + 4 * (T & 1) + (qi & 3);
            const bf16x8 k0 = *(const LAS bf16x8*)(KL + tl * KTS + 16 * g), k1 = *(const LAS bf16x8*)(KL + tl * KTS + 64 + 16 * g);
            f32x4 z = (f32x4){0.f, 0.f, 0.f, 0.f};
            z = __builtin_amdgcn_mfma_f32_16x16x32_bf16(k0, qf0, z, 0, 0, 0);
            z = __builtin_amdgcn_mfma_f32_16x16x32_bf16(k1, qf1, z, 0, 0, 0);
            s[T] = z;
        }
        float mx = -3.0e38f;
#pragma unroll
        for (int T = 0; T < 16; ++T)
#pragma unroll
            for (int e = 0; e < 4; ++e) {
                const int kc = bc0 + 8 * g + 4 * (T & 1) + e, kr = rs + (T >> 1);
                const bool valid = (kc >= qcs) && (kc < qcs + 16);
                float v = -3.0e38f;
                if (valid) v = s[T][e] + BL[(kr - r + 7) * 31 + kc - qc + 15];
                s[T][e] = v; mx = fmaxf(mx, v);
            }
        mx = fmaxf(mx, __shfl_xor(mx, 16)); mx = fmaxf(mx, __shfl_xor(mx, 32));
        float ls = 0.f;
#pragma unroll
        for (int T = 0; T < 16; ++T)
#pragma unroll
            for (int e = 0; e < 4; ++e) { const float pe = __expf(s[T][e] - mx); s[T][e] = pe; ls += pe; }
        ls += __shfl_xor(ls, 16); ls += __shfl_xor(ls, 32);
        f32x4 o[4];
#pragma unroll
        for (int dt = 0; dt < 4; ++dt) o[dt] = (f32x4){0.f, 0.f, 0.f, 0.f};
#pragma unroll
        for (int kr = 0; kr < 8; ++kr) {
            const u32x4 pw = (u32x4){cvt_pk_bf16(s[2 * kr][0], s[2 * kr][1]), cvt_pk_bf16(s[2 * kr][2], s[2 * kr][3]), cvt_pk_bf16(s[2 * kr + 1][0], s[2 * kr + 1][1]), cvt_pk_bf16(s[2 * kr + 1][2], s[2 * kr + 1][3])};
            const bf16x8 pf = __builtin_bit_cast(bf16x8, pw);
#pragma unroll
            for (int dt = 0; dt < 4; ++dt) {
                const bf16x8 vf = *(const LAS bf16x8*)(VL + (16 * dt + qi) * VRS + ((lr0 + kr) * 32 + 8 * g) * 2);
                o[dt] = __builtin_amdgcn_mfma_f32_16x16x32_bf16(vf, pf, o[dt], 0, 0, 0);
            }
        }
        const float inv = 1.0f / ls;
#pragma unroll
        for (int dt = 0; dt < 4; ++dt)
            *(u32x2*)(yna + qtok * 512 + 64 * h + 16 * dt + 4 * g) = (u32x2){cvt_pk_bf16(o[dt][0] * inv, o[dt][1] * inv), cvt_pk_bf16(o[dt][2] * inv, o[dt][3] * inv)};
    }
}

__device__ __forceinline__ void conv_mfma(int wv, KPC p, int layer, LAS unsigned char* lds, const bf16_t* UT, const float* FT, bf16_t* yhyT, unsigned long long* tloop = nullptr) {
    constexpr int CPS = 8224, ZRS = 4112;
    LAS unsigned char* FC = lds; LAS unsigned char* ZT = lds + 8 * CPS; LAS float* red = (LAS float*)(ZT + 16 * ZRS);
    const float* wsc = p->in[9] + layer * 3 * 1536; const float* bsc = p->in[10] + layer * 1536; const float* hyb = p->in[19] + layer * 512;
    const int tid = fresh_tid(wv), bx = fresh_bx(), lane = tid & 63, i = lane & 15, g = lane >> 4;
    const int rho = (8 - (i & 7)) & 7;
    const int abase = rho * CPS + 2 * (2048 - i + 8 * g - rho) - 512 * wv;
    const int bbase = i * ZRS + 16 * g;
    for (int c = bx; c < 512; c += gridDim.x) {
        __syncthreads();
        float asum = 0.f;
        {
            float fv[8]; const float hf0 = FT[(size_t)c * SEQ];
#pragma unroll
            for (int k = 0; k < 8; ++k) {
                const int m = tid + 512 * k;
                const size_t idx = (m < 2048) ? ((size_t)c * SEQ + (size_t)(2048 - max(m, 1))) : ((size_t)(512 + c) * SEQ + (size_t)(m - 2048));
                fv[k] = FT[idx];
            }
#pragma unroll
            for (int k = 0; k < 8; ++k) {
                const int m = tid + 512 * k;
                float v = fv[k]; v = (m == 0) ? 0.f : v; v = (m == 2048) ? v + hf0 : v;
                asum += fabsf(v);
                const bf16_t vb = (bf16_t)(cvt_pk_bf16(v, 0.f) & 0xffffu);
#pragma unroll
                for (int r8 = 0; r8 < 8; ++r8) if (m - r8 >= 0) *(LAS bf16_t*)(FC + r8 * CPS + 2 * (m - r8)) = vb;
            }
        }
        {
            const float a0 = wsc[c], a1 = wsc[1536 + c], a2 = wsc[3072 + c], ab = bsc[c];
            const float b0 = wsc[512 + c], b1 = wsc[1536 + 512 + c], b2 = wsc[3072 + 512 + c], bb = bsc[512 + c];
            const float c0 = wsc[1024 + c], c1 = wsc[1536 + 1024 + c], c2 = wsc[3072 + 1024 + c], cb = bsc[1024 + c];
#pragma unroll
            for (int k = 0; k < 4; ++k) {
                const int idx = tid + 512 * k, b = idx >> 8, t0 = (idx & 255) * 8;
                float x0v[8], zv[8];
#pragma unroll
                for (int rr = 0; rr < 3; ++rr) {
                    const bf16_t* row = UT + (size_t)(512 + 512 * rr + c) * M + (size_t)b * 2048;
                    const u32x4 w = *(const u32x4*)(row + t0);
                    float f[10];
                    { const float fl = bf2f(row[max(t0 - 1, 0)]), fr2 = bf2f(row[min(t0 + 8, SEQ - 1)]); f[0] = t0 > 0 ? fl : 0.f; f[9] = t0 + 8 < SEQ ? fr2 : 0.f; }
                    f[1] = bf_lo(w.x); f[2] = bf_hi(w.x); f[3] = bf_lo(w.y); f[4] = bf_hi(w.y); f[5] = bf_lo(w.z); f[6] = bf_hi(w.z); f[7] = bf_lo(w.w); f[8] = bf_hi(w.w);
                    const float w0 = rr == 0 ? a0 : (rr == 1 ? b0 : c0), w1 = rr == 0 ? a1 : (rr == 1 ? b1 : c1), w2 = rr == 0 ? a2 : (rr == 1 ? b2 : c2), wb = rr == 0 ? ab : (rr == 1 ? bb : cb);
#pragma unroll
                    for (int e = 0; e < 8; ++e) {
                        const float v = f[e] * w0 + f[e + 1] * w1 + f[e + 2] * w2 + wb;
                        if (rr == 0) x0v[e] = v; else if (rr == 1) zv[e] = v; else zv[e] *= v;
                    }
                }
                *(LAS u32x4*)(ZT + b * ZRS + 2 * t0) = (u32x4){cvt_pk_bf16(zv[0], zv[1]), cvt_pk_bf16(zv[2], zv[3]), cvt_pk_bf16(zv[4], zv[5]), cvt_pk_bf16(zv[6], zv[7])};
                *(LAS u32x4*)(ZT + (8 + b) * ZRS + 2 * t0) = (u32x4){cvt_pk_bf16(x0v[0], x0v[1]), cvt_pk_bf16(x0v[2], x0v[3]), cvt_pk_bf16(x0v[4], x0v[5]), cvt_pk_bf16(x0v[6], x0v[7])};
            }
        }
        asum = wave_sum(asum);
        if (lane == 0) red[wv] = asum;
        __syncthreads();
        float kn = 0.f;
#pragma unroll
        for (int w = 0; w < 8; ++w) kn += red[w];
        unsigned long long tl0_ = 0; if (tloop) tl0_ = __builtin_amdgcn_s_memrealtime();
        bf16x8 ring[16]; f32x4 acc[16];
#pragma unroll
        for (int tau = 0; tau < 16; ++tau) { ring[tau] = *(const LAS bf16x8*)(FC + abase - 32 * tau); acc[tau] = (f32x4){0.f, 0.f, 0.f, 0.f}; }
        bf16x8 bcur = *(const LAS bf16x8*)(ZT + bbase);
        for (int s8 = 0; s8 < 8; ++s8) {
#pragma unroll
            for (int sp = 0; sp < 8; ++sp) {
                const int sn = min(8 * s8 + sp + 1, 63);
                const bf16x8 bnext = *(const LAS bf16x8*)(ZT + bbase + 64 * sn);
                const bf16x8 n0 = *(const LAS bf16x8*)(FC + abase + 64 * sn), n1 = *(const LAS bf16x8*)(FC + abase + 64 * sn - 32);
#pragma unroll
                for (int tau = 0; tau < 16; ++tau) acc[tau] = __builtin_amdgcn_mfma_f32_16x16x32_bf16(ring[(tau - 2 * sp) & 15], bcur, acc[tau], 0, 0, 0);
                ring[(0 - 2 * (sp + 1)) & 15] = n0; ring[(1 - 2 * (sp + 1)) & 15] = n1;
                bcur = bnext;
            }
        }
        if (tloop) { asm volatile("" :: "v"(acc[0]), "v"(acc[15])); *tloop += __builtin_amdgcn_s_memrealtime() - tl0_; }
        if (i < 8) {
            const float ikn = 1.0f / kn, hb = hyb[c];
#pragma unroll
            for (int tau = 0; tau < 16; ++tau) {
                const int t = 256 * wv + 16 * tau + 4 * g;
                const u32x2 zz = *(const LAS u32x2*)(ZT + i * ZRS + 2 * t), xx = *(const LAS u32x2*)(ZT + (8 + i) * ZRS + 2 * t);
                const float y0 = bf_lo(xx.x) * (acc[tau][0] * ikn + bf_lo(zz.x) * hb), y1 = bf_hi(xx.x) * (acc[tau][1] * ikn + bf_hi(zz.x) * hb);
                const float y2 = bf_lo(xx.y) * (acc[tau][2] * ikn + bf_lo(zz.y) * hb), y3 = bf_hi(xx.y) * (acc[tau][3] * ikn + bf_hi(zz.y) * hb);
                *(u32x2*)(yhyT + (size_t)c * M + (size_t)i * 2048 + t) = (u32x2){cvt_pk_bf16(y0, y1), cvt_pk_bf16(y2, y3)};
            }
        }
    }
}

__device__ __forceinline__ void post_pass(int wv, LAS unsigned char* lds, const bf16_t* yna, const bf16_t* yhyT, bf16_t* yn) {
    LAS bf16_t* tile = (LAS bf16_t*)lds;
    const int tid = fresh_tid(wv), bx = fresh_bx(), lane = tid & 63, wave = wv;
    for (int it = bx; it < M / 64; it += gridDim.x) {
        const int tok0 = it * 64;
        u32x4 ynav[8];
#pragma unroll
        for (int q = 0; q < 8; ++q) ynav[q] = *(const u32x4*)(yna + ((size_t)tok0 + 8 * wave + q) * 512 + 8 * lane);
        __syncthreads();
        {
            const u32x4* src = (const u32x4*)(yhyT + (size_t)tid * M + tok0);
            u32x4 v[8];
#pragma unroll
            for (int j = 0; j < 8; ++j) v[j] = src[j];
#pragma unroll
            for (int j = 0; j < 8; ++j) {
                tile[(8 * j + 0) * 520 + tid] = (bf16_t)(v[j].x & 0xffffu); tile[(8 * j + 1) * 520 + tid] = (bf16_t)(v[j].x >> 16);
                tile[(8 * j + 2) * 520 + tid] = (bf16_t)(v[j].y & 0xffffu); tile[(8 * j + 3) * 520 + tid] = (bf16_t)(v[j].y >> 16);
                tile[(8 * j + 4) * 520 + tid] = (bf16_t)(v[j].z & 0xffffu); tile[(8 * j + 5) * 520 + tid] = (bf16_t)(v[j].z >> 16);
                tile[(8 * j + 6) * 520 + tid] = (bf16_t)(v[j].w & 0xffffu); tile[(8 * j + 7) * 520 + tid] = (bf16_t)(v[j].w >> 16);
            }
        }
        __syncthreads();
#pragma unroll
        for (int q = 0; q < 8; ++q) {
            const int tk = 8 * wave + q; const size_t tok = (size_t)tok0 + tk;
#pragma unroll
            for (int half = 0; half < 2; ++half) {
                u32x4 v;
                if (half == 0) v = ynav[q]; else v = *(const LAS u32x4*)(tile + tk * 520 + 8 * lane);
                float f[8] = {bf_lo(v.x), bf_hi(v.x), bf_lo(v.y), bf_hi(v.y), bf_lo(v.z), bf_hi(v.z), bf_lo(v.w), bf_hi(v.w)};
                float s = 0.f;
#pragma unroll
                for (int e = 0; e < 8; ++e) s += f[e] * f[e];
                s = wave_sum(s);
                const float rs = rstd_of(s, 1.0f / 512.0f);
                *(u32x4*)(yn + tok * 1024 + half * 512 + 8 * lane) = (u32x4){cvt_pk_bf16(f[0] * rs, f[1] * rs), cvt_pk_bf16(f[2] * rs, f[3] * rs), cvt_pk_bf16(f[4] * rs, f[5] * rs), cvt_pk_bf16(f[6] * rs, f[7] * rs)};
            }
        }
    }
}

__global__ void __launch_bounds__(512, 2) hybrid_fwd(KP kparams_unused) {
    extern __shared__ __attribute__((aligned(16))) unsigned char lds_raw[];
    LAS unsigned char* lds = (LAS unsigned char*)lds_raw;
    cg::grid_group grid = cg::this_grid();
    const int wv = __builtin_amdgcn_readfirstlane((int)(threadIdx.x >> 6));
#define WSV() KPC p = KPARAMS(); unsigned char* ws = p->ws; float* ss = (float*)(ws + WS_CTL) + (size_t)(4 * layer) * M;   \
    bf16_t* xb = (bf16_t*)(ws + WS_XB); bf16_t* xb2 = (bf16_t*)(ws + WS_R2 + 32 * MiB);   bf16_t* Hb = (bf16_t*)(ws + WS_R1); bf16_t* QK = (bf16_t*)(ws + WS_R1); bf16_t* UT = (bf16_t*)(ws + WS_R1 + 32 * MiB); \
    bf16_t* yna = (bf16_t*)(ws + WS_R2); bf16_t* yhyT = (bf16_t*)(ws + WS_R2 + 16 * MiB); bf16_t* yn = (bf16_t*)(ws + WS_R2 + 32 * MiB); bf16_t* PP = (bf16_t*)(ws + WS_R2); \
    bf16_t* pb = (bf16_t*)(ws + WS_PB); const float* FT = (const float*)(ws + WS_FT); unsigned char* Wb = ws + WS_W; float* X = p->out; \
    (void)ss; (void)xb; (void)xb2; (void)Hb; (void)QK; (void)UT; (void)yna; (void)yhyT; (void)yn; (void)PP; (void)pb; (void)FT; (void)Wb; (void)X;

    { const int t0_ = fresh_tid(wv); if (t0_ < 4) ((volatile LAS unsigned*)(lds + LDS_BYTES - 16))[t0_] = 0u; __syncthreads(); }
    XcdBarrier xbar;
    { KPC p = KPARAMS(); xbar = xcd_barrier_post((unsigned*)(p->ws + WS_CTL + BAR_OFF), (volatile LAS unsigned*)(lds + LDS_BYTES - 16), wv); }
#if defined(TPROBE) && TPROBE == 8
#define CONV_TL (&tacc_)
#else
#define CONV_TL nullptr
#endif
#ifdef TPROBE
    unsigned long long tacc_ = 0, tt0_ = 0;
#define TP(n, ...) do { if (TPROBE == (n)) tt0_ = __builtin_amdgcn_s_memrealtime(); __VA_ARGS__; if (TPROBE == (n)) tacc_ += __builtin_amdgcn_s_memrealtime() - tt0_; } while (0)
#else
#define TP(n, ...) do { __VA_ARGS__; } while (0)
#endif
#define GSYNC() TP(1, for (int rs_ = 0; rs_ < R_SYNC; ++rs_) xcd_barrier(xbar, wv))
    for (int layer = 0; layer < 2; ++layer) {
#ifndef NO_PRO
        TP(2, for (int rep_ = 0; rep_ < R_PRO; ++rep_) { WSV(); layer_prologue(wv, p, layer, lds); __syncthreads(); });
#endif
        if (layer == 0) TP(1, grid.sync()); else GSYNC();
        TP(7, for (int rep_ = 0; rep_ < R_UP; ++rep_) { WSV(); gemm_run(wv, lds, layer == 0 ? xb : xb2, (const bf16_t*)(Wb + W_GUA), M, 2 * FF, D, EpiSwiGLU{Hb, ss}); });
        { WSV(); late_transposes(wv, p, layer, lds); }
        GSYNC();
        TP(7, { WSV(); gemm_run(wv, lds, Hb, (const bf16_t*)(Wb + W_DA), M, D, FF, EpiResid{layer == 0 ? p->in[0] : X, X, xb, ss + M, 0.5f}); });
        for (int rep_ = 1; rep_ < R_REST; ++rep_) { WSV(); gemm_run(wv, lds, Hb, (const bf16_t*)(Wb + W_DA), M, D, FF, EpiDry{}); }
        GSYNC();
        TP(7, { WSV(); gemm_run(wv, lds, (const bf16_t*)(Wb + W_IN) + (size_t)1024 * D, xb, 2048, M, D, EpiScaleCol{UT, M, ss + M}); });
        for (int rep_ = 1; rep_ < R_REST; ++rep_) { WSV(); gemm_run(wv, lds, (const bf16_t*)(Wb + W_IN) + (size_t)1024 * D, xb, 2048, M, D, EpiScaleCol{UT, M, ss + M}); }
        TP(7, { WSV(); gemm_run(wv, lds, xb, (const bf16_t*)(Wb + W_IN), M, 1024, D, EpiScaleRow{QK, 1024, ss + M}); });
        for (int rep_ = 1; rep_ < R_REST; ++rep_) { WSV(); gemm_run(wv, lds, xb, (const bf16_t*)(Wb + W_IN), M, 1024, D, EpiScaleRow{QK, 1024, ss + M}); }
        GSYNC();
#ifndef NO_ATTN
#if NAIVE_ATTN
        { WSV(); attn_naive(wv, p, layer, QK, UT, yna); }
#else
        TP(3, for (int rep_ = 0; rep_ < R_ATTN; ++rep_) { WSV(); attn_lds(wv, p, layer, lds, QK, UT, yna); });
#endif
#endif
#ifndef NO_CONV
#if NAIVE_CONV
        { WSV(); conv_naive(wv, p, layer, lds, UT, FT, yhyT); }
#else
        TP(4, for (int rep_ = 0; rep_ < R_CONV; ++rep_) { WSV(); conv_mfma(wv, p, layer, lds, UT, FT, yhyT, CONV_TL); });
#endif
#endif
        GSYNC();
#ifndef NO_POST
        TP(5, for (int rep_ = 0; rep_ < R_POST; ++rep_) { WSV(); post_pass(wv, lds, yna, yhyT, yn); });
#endif
        GSYNC();
        TP(7, { WSV(); gemm_run(wv, lds, yn, (const bf16_t*)(Wb + W_OUT), M, D, D, EpiResid{X, X, xb, ss + 2 * M, 1.0f}); });
        for (int rep_ = 1; rep_ < R_REST; ++rep_) { WSV(); gemm_run(wv, lds, yn, (const bf16_t*)(Wb + W_OUT), M, D, D, EpiDry{}); }
        GSYNC();
        TP(7, { WSV(); gemm_run(wv, lds, pb + (size_t)layer * M * PLE, (const bf16_t*)(Wb + W_PP), M, D, PLE, EpiStoreBf16{PP, D}, true); });
        for (int rep_ = 1; rep_ < R_REST; ++rep_) { WSV(); gemm_run(wv, lds, pb + (size_t)layer * M * PLE, (const bf16_t*)(Wb + W_PP), M, D, PLE, EpiStoreBf16{PP, D}, true); }
        TP(7, { WSV(); gemm_run(wv, lds, xb, (const bf16_t*)(Wb + W_GUB), M, 2 * FF, D, EpiSwiGLU{Hb, ss + 2 * M}); });
        for (int rep_ = 1; rep_ < R_REST; ++rep_) { WSV(); gemm_run(wv, lds, xb, (const bf16_t*)(Wb + W_GUB), M, 2 * FF, D, EpiSwiGLU{Hb, ss + 2 * M}); }
        GSYNC();
        TP(7, { WSV(); gemm_run(wv, lds, Hb, (const bf16_t*)(Wb + W_DB), M, D, FF, EpiResid{X, X, xb, ss + 3 * M, 0.5f}); });
        for (int rep_ = 1; rep_ < R_REST; ++rep_) { WSV(); gemm_run(wv, lds, Hb, (const bf16_t*)(Wb + W_DB), M, D, FF, EpiDry{}); }
        GSYNC();
        TP(7, { WSV(); gemm_run(wv, lds, xb, (const bf16_t*)(Wb + W_PG), M, D, D, EpiPle{X, PP, ss + 3 * M, layer == 0 ? xb2 : (bf16_t*)nullptr, ss + 4 * M}); });
        for (int rep_ = 1; rep_ < R_REST; ++rep_) { WSV(); gemm_run(wv, lds, xb, (const bf16_t*)(Wb + W_PG), M, D, D, EpiDry{}); }
        if (layer == 1) GSYNC();
    }
#ifdef TPROBE
    if (TPROBE == 6) tt0_ = __builtin_amdgcn_s_memrealtime();
#endif
    {
        const int layer = 2; WSV();
        const int tid = fresh_tid(wv), bx = fresh_bx(), lane = tid & 63, wave = wv;
        const float* gf = p->in[29];
        const int NGWf = gridDim.x * 8;
        f32x4 gq[4];
#pragma unroll
        for (int j = 0; j < 4; ++j) gq[j] = ((const f32x4*)gf)[lane + 64 * j];
        for (int m = bx * 8 + wave; m < M; m += 2 * NGWf) {
            const int m2 = m + NGWf < M ? m + NGWf : m;
            const float rs = rstd_of(ss[m], 1.0f / D), rs2 = rstd_of(ss[m2], 1.0f / D);
            f32x4* xr = (f32x4*)(X + (size_t)m * D) + lane; f32x4* xr2 = (f32x4*)(X + (size_t)m2 * D) + lane;
            f32x4 v[4], w[4];
#pragma unroll
            for (int j = 0; j < 4; ++j) { v[j] = xr[64 * j]; w[j] = xr2[64 * j]; }
#pragma unroll
            for (int j = 0; j < 4; ++j) { v[j] = v[j] * rs * gq[j]; w[j] = w[j] * rs2 * gq[j]; }
#pragma unroll
            for (int j = 0; j < 4; ++j) xr[64 * j] = v[j];
            if (m2 != m) {
#pragma unroll
                for (int j = 0; j < 4; ++j) xr2[64 * j] = w[j];
            }
        }
    }
#ifdef TPROBE
    if (TPROBE == 6) tacc_ += __builtin_amdgcn_s_memrealtime() - tt0_;
    if (fresh_bx() == 0) { const unsigned long long te_ = __builtin_amdgcn_s_memrealtime(); while (__builtin_amdgcn_s_memrealtime() - te_ < (unsigned long long)TAMP * tacc_) __builtin_amdgcn_s_sleep(8); }
#endif
}

extern "C" void kernel_launch(void* const* d_in, const int* in_sizes, int n_in, void* d_out, int out_size, void* d_ws, size_t ws_size, hipStream_t stream) {
    static int grid = 0;
    if (grid == 0) {
        if (n_in != 30 || out_size != M * D || ws_size < WS_END) { fprintf(stderr, "kernel_launch: unexpected shapes: n_in %d out %d ws %zu (need %zu)\n", n_in, out_size, ws_size, (size_t)WS_END); grid = -1; return; }
        int dev = 0, cus = 0, per_cu = 0;
        hipGetDevice(&dev);
        hipDeviceGetAttribute(&cus, hipDeviceAttributeMultiprocessorCount, dev);
        if (hipFuncSetAttribute((const void*)hybrid_fwd, hipFuncAttributeMaxDynamicSharedMemorySize, LDS_BYTES) != hipSuccess) { fprintf(stderr, "kernel_launch: hipFuncSetAttribute failed\n"); }
        if (hipOccupancyMaxActiveBlocksPerMultiprocessor(&per_cu, (const void*)hybrid_fwd, 512, LDS_BYTES) != hipSuccess || per_cu < 1) { fprintf(stderr, "kernel_launch: occupancy query says %d\n", per_cu); per_cu = 1; }
        (void)hipGetLastError();
        grid = cus * per_cu;
        if (grid != 256) { fprintf(stderr, "kernel_launch: this build is laid out for 256 co-resident workgroups (256 CUs x 1); got %d x %d; nothing launched\n", cus, per_cu); grid = -1; return; }
        fprintf(stderr, "kernel_launch: grid %d (cus %d x %d)\n", grid, cus, per_cu);
    }
    if (grid < 0) return;
    static_assert(9 * (size_t)M * 4 <= BAR_OFF && BAR_OFF + XCD_BAR_WORDS * 4 <= 672 * 1024, "control words inside the zeroed range");
    (void)hipMemsetAsync((char*)d_ws + WS_CTL, 0, 672 * 1024, stream);
    KP hp{};
    for (int i = 0; i < 30; ++i) hp.in[i] = (const float*)d_in[i];
    hp.out = (float*)d_out; hp.ws = (unsigned char*)d_ws;
    void* args[] = {&hp};
    hipError_t e = hipLaunchCooperativeKernel((const void*)hybrid_fwd, dim3(grid), dim3(512), args, LDS_BYTES, stream);
    if (e != hipSuccess) fprintf(stderr, "kernel_launch: cooperative launch failed: %s (grid %d)\n", hipGetErrorString(e), grid);
}
```

```cpp
#include <hip/hip_runtime.h>
#include <hip/hip_cooperative_groups.h>
#include <cstdio>
#include <cstdint>
namespace cg = cooperative_groups;
namespace pg8 {
#define PG8_LAS __attribute__((address_space(3)))
typedef unsigned short bf16_t;
typedef short bf16x8 __attribute__((ext_vector_type(8)));
typedef float f32x4 __attribute__((ext_vector_type(4)));
typedef unsigned u32x4 __attribute__((ext_vector_type(4)));
constexpr int BM = 256, BK = 64, HALF = 128, HTB = HALF * BK * 2  , STAGE_BYTES = 8 * HTB, NXCD = 8, WGM = 8;

__host__ __device__ __forceinline__ int lds_byte(int r, int c) { const int st = (r >> 4) * 2 + (c >> 5), rr = r & 15, cc = c & 31, ob = rr * 64 + cc * 2; return st * 1024 + (ob ^ (((ob >> 9) & 1) << 5)); }
__host__ __device__ __forceinline__ void stage_rc(int b, int& R, int& C) { const int st = b / 1024, sb = b % 1024, swz = sb ^ (((sb >> 9) & 1) << 5); R = (st >> 1) * 16 + swz / 64; C = (st & 1) * 32 + (swz % 64) / 2; }
__host__ __device__ __forceinline__ int perm32(int rho) { const int n = rho >> 4, i = rho & 15; return 8 * (i >> 2) + 4 * n + (i & 3); }

struct Unit { int pm, pn; };
struct Gemm { const bf16_t* A; const bf16_t* Bt; int M, N, K; };

struct StaticOrder {
    int nM, nN, nwg, G, c;
    __host__ __device__ void init(int M, int N, int G_, int c_) { nM = M / BM; nN = N / BM; nwg = nM * nN; G = G_; c = c_; }
    __host__ __device__ bool next(int i, Unit& u) const {
        const long L = (long)i * G + c; if (L >= nwg) return false;
        int wgid = (int)L; { const int q = nwg / NXCD, r = nwg % NXCD, xcd = wgid % NXCD, off = wgid / NXCD; wgid = (xcd < r ? xcd * (q + 1) : r * (q + 1) + (xcd - r) * q) + off; }
        const int nig = WGM * nN, gid = wgid / nig, fm = gid * WGM, gsz = (nM - fm) < WGM ? (nM - fm) : WGM;
        u.pm = fm + ((wgid % nig) % gsz); u.pn = (wgid % nig) / gsz; return true;
    }
    __device__ __forceinline__ void a_ready(const Unit&) const {}
    __device__ __forceinline__ void done(const Unit&) const {}
};

template <class Epi, class Sched, bool ALIGN_EPI = false, bool SP2 = false>
__device__ __forceinline__ void gemm_phase(PG8_LAS unsigned char* lds, const Gemm g, const Sched& S, const Epi& E, int tid_in) {
    int tid_ = tid_in; asm volatile("" : "+v"(tid_)); const int tid = tid_, wid = __builtin_amdgcn_readfirstlane(tid >> 6), lane = tid & 63, wr = wid >> 2, wc = wid & 3, fr = lane & 15, fq = lane >> 4;
    const int K = g.K, nt = K / BK;
    unsigned voffA[2], voffB[2];
#pragma unroll
    for (int i = 0; i < 2; ++i) { int R, C; stage_rc(tid * 16 + i * 8192, R, C); const int Rb = Epi::PERM ? ((R & ~31) + perm32(R & 31)) : R;
        voffA[i] = (unsigned)(R * K + C) * 2u; voffB[i] = (unsigned)(Rb * K + C) * 2u; }
    const size_t kstep = (size_t)(BK * 2);
    const size_t hstep = (size_t)HALF * K * 2;
    const size_t tstep = 2 * hstep;
    const unsigned ldsw = (unsigned)wid * 1024u;
    const int aoff = lds_byte(wr * 64 + fr, fq * 8), boff = lds_byte(wc * 32 + fr, fq * 8);
#define PG8_SA(b, h) (((b) * 2 + (h)) * HTB)
#define PG8_SB(b, h) ((4 + (b) * 2 + (h)) * HTB)
#define PG8_STAGE(bufoff, gbase, voff) do { _Pragma("unroll") for (int _i = 0; _i < 2; ++_i) \
        __builtin_amdgcn_global_load_lds((const unsigned*)((const char*)(gbase) + (voff)[_i]), (PG8_LAS unsigned*)(lds + (bufoff) + ldsw + _i * 8192), 16, 0, 0); } while (0)
#define PG8_LDA(dst, b, h) do { _Pragma("unroll") for (int m = 0; m < 4; ++m) _Pragma("unroll") for (int k = 0; k < 2; ++k) dst[m][k] = *(const PG8_LAS bf16x8*)(lds + PG8_SA(b, h) + aoff + m * 2048 + k * 1024); } while (0)
#define PG8_LDB(dst, b, h) do { _Pragma("unroll") for (int n = 0; n < 2; ++n) _Pragma("unroll") for (int k = 0; k < 2; ++k) dst[n][k] = *(const PG8_LAS bf16x8*)(lds + PG8_SB(b, h) + boff + n * 2048 + k * 1024); } while (0)
#define PG8_MMA(ai, bj, At, Bt) do { __builtin_amdgcn_s_setprio(1); _Pragma("unroll") for (int m = 0; m < 4; ++m) _Pragma("unroll") for (int n = 0; n < 2; ++n) _Pragma("unroll") for (int k = 0; k < 2; ++k) \
        acc[ai][bj][m][n] = __builtin_amdgcn_mfma_f32_16x16x32_bf16(Bt[n][k], At[m][k], acc[ai][bj][m][n], 0, 0, 0); __builtin_amdgcn_s_setprio(0); } while (0)
#define PG8_WAIT_V(n) asm volatile("s_waitcnt vmcnt(" #n ")" ::: "memory")
#define PG8_WAIT_L(n) asm volatile("s_waitcnt lgkmcnt(" #n ")" ::: "memory")
#define PG8_BAR __builtin_amdgcn_s_barrier()
#define PG8_SCHED __builtin_amdgcn_sched_barrier(0)
    Unit cur, nxt; int ui = 0;
    if (!S.next(0, cur)) return;
    f32x4 acc[2][2][4][2];
#pragma unroll
    for (int a = 0; a < 2; ++a)
#pragma unroll
        for (int b = 0; b < 2; ++b)
#pragma unroll
            for (int m = 0; m < 4; ++m)
#pragma unroll
                for (int n = 0; n < 2; ++n) acc[a][b][m][n] = (f32x4){0.f, 0.f, 0.f, 0.f};
    bf16x8 At[4][2], B0[2][2], B1[2][2];
    const char* cA = (const char*)g.A + (size_t)cur.pm * tstep; const char* cB = (const char*)g.Bt + (size_t)cur.pn * tstep;
    S.a_ready(cur);
    if constexpr (SP2) {
        PG8_STAGE(PG8_SB(0, 0), cB, voffB); PG8_STAGE(PG8_SB(0, 1), cB + hstep, voffB); PG8_STAGE(PG8_SA(0, 0), cA, voffA); PG8_STAGE(PG8_SA(0, 1), cA + hstep, voffA);
        if (wr == 1) PG8_BAR;
        PG8_WAIT_V(2); PG8_BAR;
        PG8_STAGE(PG8_SB(1, 0), cB + kstep, voffB); PG8_STAGE(PG8_SA(1, 0), cA + kstep, voffA); PG8_STAGE(PG8_SB(1, 1), cB + hstep + kstep, voffB);
        PG8_WAIT_V(6); PG8_BAR;
    } else {
        PG8_STAGE(PG8_SB(0, 0), cB, voffB); PG8_STAGE(PG8_SA(0, 0), cA, voffA); PG8_STAGE(PG8_SB(0, 1), cB + hstep, voffB); PG8_STAGE(PG8_SA(0, 1), cA + hstep, voffA);
        if (wr == 1) PG8_BAR;
        PG8_WAIT_V(4); PG8_BAR;
        PG8_STAGE(PG8_SB(1, 0), cB + kstep, voffB); PG8_STAGE(PG8_SA(1, 0), cA + kstep, voffA); PG8_STAGE(PG8_SB(1, 1), cB + hstep + kstep, voffB);
        PG8_WAIT_V(6); PG8_BAR;
    }
    for (;;) {
        const bool has_next = S.next(ui + 1, nxt);
        const char* nA = has_next ? (const char*)g.A + (size_t)nxt.pm * tstep : cA; const char* nB = has_next ? (const char*)g.Bt + (size_t)nxt.pn * tstep : cB;
        for (int t = 0; t < nt; t += 2) {
            const bool last = (t == nt - 2);
            const char* a1 = cA + (size_t)(t + 1) * kstep;
            const char* a2 = last ? nA : cA + (size_t)(t + 2) * kstep; const char* b2 = last ? nB : cB + (size_t)(t + 2) * kstep;
            const char* a3 = a2 + kstep; const char* b3 = b2 + kstep;
            if (last && has_next) S.a_ready(nxt);
            if constexpr (SP2) {
            PG8_LDB(B0, 0, 0); PG8_LDB(B1, 0, 1); PG8_SCHED; PG8_LDA(At, 0, 0); PG8_STAGE(PG8_SA(1, 1), a1 + hstep, voffA);
            PG8_WAIT_V(8); PG8_WAIT_L(0); PG8_BAR; PG8_MMA(0, 0, At, B0); PG8_MMA(0, 1, At, B1); PG8_BAR; PG8_SCHED;
            PG8_LDA(At, 0, 1); PG8_STAGE(PG8_SB(0, 0), b2, voffB); PG8_STAGE(PG8_SB(0, 1), b2 + hstep, voffB); PG8_STAGE(PG8_SA(0, 0), a2, voffA);
            PG8_WAIT_V(8); PG8_WAIT_L(0); PG8_BAR; PG8_MMA(1, 0, At, B0); PG8_MMA(1, 1, At, B1); PG8_BAR; PG8_SCHED;
            PG8_LDB(B0, 1, 0); PG8_LDB(B1, 1, 1); PG8_SCHED; PG8_LDA(At, 1, 0); PG8_STAGE(PG8_SA(0, 1), a2 + hstep, voffA);
            PG8_WAIT_V(8); PG8_WAIT_L(0); PG8_BAR; PG8_MMA(0, 0, At, B0); PG8_MMA(0, 1, At, B1); PG8_BAR; PG8_SCHED;
            PG8_LDA(At, 1, 1); PG8_STAGE(PG8_SB(1, 0), b3, voffB); PG8_STAGE(PG8_SB(1, 1), b3 + hstep, voffB); PG8_STAGE(PG8_SA(1, 0), a3, voffA);
            PG8_WAIT_V(8); PG8_WAIT_L(0); PG8_BAR; PG8_MMA(1, 0, At, B0); PG8_MMA(1, 1, At, B1); PG8_BAR; PG8_SCHED;
            } else {
            PG8_LDB(B0, 0, 0); PG8_SCHED; PG8_LDA(At, 0, 0); PG8_STAGE(PG8_SA(1, 1), a1 + hstep, voffA);
            PG8_WAIT_L(8); PG8_BAR; PG8_WAIT_L(0); PG8_MMA(0, 0, At, B0); PG8_BAR; PG8_SCHED;
            PG8_LDB(B1, 0, 1); PG8_STAGE(PG8_SB(0, 0), b2, voffB);
            PG8_BAR; PG8_WAIT_L(0); PG8_MMA(0, 1, At, B1); PG8_BAR;
            PG8_LDA(At, 0, 1); PG8_STAGE(PG8_SA(0, 0), a2, voffA);
            PG8_BAR; PG8_WAIT_L(0); PG8_MMA(1, 0, At, B0); PG8_BAR; PG8_SCHED;
            PG8_STAGE(PG8_SB(0, 1), b2 + hstep, voffB);
            PG8_WAIT_V(6); PG8_BAR; PG8_MMA(1, 1, At, B1); PG8_BAR;
            PG8_LDB(B0, 1, 0); PG8_SCHED; PG8_LDA(At, 1, 0); PG8_STAGE(PG8_SA(0, 1), a2 + hstep, voffA);
            PG8_WAIT_L(8); PG8_BAR; PG8_WAIT_L(0); PG8_MMA(0, 0, At, B0); PG8_BAR; PG8_SCHED;
            PG8_LDB(B1, 1, 1); PG8_STAGE(PG8_SB(1, 0), b3, voffB);
            PG8_BAR; PG8_WAIT_L(0); PG8_MMA(0, 1, At, B1); PG8_BAR;
            PG8_LDA(At, 1, 1); PG8_STAGE(PG8_SA(1, 0), a3, voffA);
            PG8_BAR; PG8_WAIT_L(0); PG8_MMA(1, 0, At, B0); PG8_BAR; PG8_SCHED;
            PG8_STAGE(PG8_SB(1, 1), b3 + hstep, voffB);
            PG8_WAIT_V(6); PG8_BAR; PG8_MMA(1, 1, At, B1); PG8_BAR;
            }
        }
        if constexpr (ALIGN_EPI) { if (wr == 0) PG8_BAR; }
        if constexpr (!Epi::AFTER_DRAIN) { E(acc, cur, wr, wc, fr, fq); S.done(cur); }
        if (!has_next) break;
#pragma unroll
        for (int a = 0; a < 2; ++a)
#pragma unroll
            for (int b = 0; b < 2; ++b)
#pragma unroll
                for (int m = 0; m < 4; ++m)
#pragma unroll
                    for (int n = 0; n < 2; ++n) acc[a][b][m][n] = (f32x4){0.f, 0.f, 0.f, 0.f};
        cur = nxt; cA = nA; cB = nB; ++ui;
        if constexpr (ALIGN_EPI) { if (wr == 1) PG8_BAR; }
    }
    PG8_WAIT_V(0);
    if constexpr (!ALIGN_EPI) { if (wr == 0) PG8_BAR; }
    PG8_BAR;
    if constexpr (Epi::AFTER_DRAIN) { E.fused(acc, cur, wr, wc, fr, fq, lds, wid, lane); S.done(cur); }
#undef PG8_SA
#undef PG8_SB
#undef PG8_STAGE
#undef PG8_LDA
#undef PG8_LDB
#undef PG8_MMA
#undef PG8_WAIT_V
#undef PG8_WAIT_L
#undef PG8_BAR
#undef PG8_SCHED
}
}
using pg8::bf16_t; using pg8::bf16x8; using pg8::f32x4; using pg8::u32x4; using pg8::Unit; using pg8::Gemm; using pg8::StaticOrder;
typedef float f32x2 __attribute__((ext_vector_type(2)));
typedef unsigned u32x2 __attribute__((ext_vector_type(2)));
#define LAS __attribute__((address_space(3)))

#ifndef NAIVE_GEMM
#define NAIVE_GEMM 0
#endif
#ifndef R_PRO
#define R_PRO 1
#endif
#ifndef R_ATTN
#define R_ATTN 1
#endif
#ifndef R_CONV
#define R_CONV 1
#endif
#ifndef R_SYNC
#define R_SYNC 1
#endif
#ifndef R_UP
#define R_UP 1
#endif
#ifndef R_REST
#define R_REST 1
#endif
#ifndef R_POST
#define R_POST 1
#endif
#ifndef NAIVE_ATTN
#define NAIVE_ATTN 0
#endif
#ifndef NAIVE_CONV
#define NAIVE_CONV 0
#endif

constexpr int M = 16384, D = 1024, FF = 2816, SEQ = 2048, HC = 512, PLE = 256;
constexpr float EPS = 1e-6f;
constexpr size_t MiB = 1u << 20;
constexpr size_t WS_CTL = 0, WS_W = 1 * MiB, WS_FT = 45 * MiB, WS_PB = 53 * MiB, WS_XB = 69 * MiB, WS_R1 = 101 * MiB, WS_R2 = 197 * MiB, WS_END = 261 * MiB;
constexpr size_t W_GUA = 0, W_DA = 11 * MiB, W_IN = W_DA + 5767168, W_OUT = W_IN + 6 * MiB, W_GUB = W_OUT + 2 * MiB, W_DB = W_GUB + 11 * MiB, W_PG = W_DB + 5767168, W_PP = W_PG + 2 * MiB;
static_assert(W_PP + 512 * 1024 <= 44 * MiB, "weights");
constexpr int LDS_BYTES = 131072 + 4096;
constexpr size_t BAR_OFF = 640 * 1024;

struct KP { const float* in[30]; float* out; unsigned char* ws; };
typedef const __attribute__((address_space(4))) KP* KPC;
#define KPARAMS() ({ KPC q_ = (KPC)__builtin_amdgcn_kernarg_segment_ptr(); asm volatile("" : "+s"(q_)); q_; })

__device__ __forceinline__ unsigned cvt_pk_bf16(float lo, float hi) { unsigned r; asm volatile("v_cvt_pk_bf16_f32 %0, %1, %2" : "=v"(r) : "v"(lo), "v"(hi)); return r; }
__device__ __forceinline__ float bf_lo(unsigned w) { return __uint_as_float(w << 16); }
__device__ __forceinline__ float bf_hi(unsigned w) { return __uint_as_float(w & 0xffff0000u); }
__device__ __forceinline__ float bf2f(bf16_t b) { return __uint_as_float(((unsigned)b) << 16); }
__device__ __forceinline__ float wave_sum(float v) {
#pragma unroll
    for (int o = 1; o < 64; o <<= 1) v += __shfl_xor(v, o);
    return v;
}
__device__ __forceinline__ int fresh_tid(int wv) {
    int l; asm volatile("v_mbcnt_lo_u32_b32 %0, -1, 0\n\tv_mbcnt_hi_u32_b32 %0, -1, %0" : "=v"(l));
    return wv * 64 + l;
}
__device__ __forceinline__ int fresh_bx() { int b = blockIdx.x; asm volatile("" : "+s"(b)); return b; }
#define XB_TMO      128
#define XB_XCNT(j)  (256  + 64 * (j))
#define XB_XSUB(j)  (1280 + 64 * (j))
#define XB_XGEN(j)  (2304 + 64 * (j))
#define XB_TOP      3328
#define XB_TOPGEN   3392
#define XCD_BAR_WORDS 3456
#define XB_SPIN_CAP (1u << 18)

__device__ __forceinline__ unsigned xb_ld(unsigned* p)              { return __hip_atomic_load(p, __ATOMIC_RELAXED, __HIP_MEMORY_SCOPE_AGENT); }
__device__ __forceinline__ unsigned xb_add(unsigned* p, unsigned v) { return __hip_atomic_fetch_add(p, v, __ATOMIC_RELAXED, __HIP_MEMORY_SCOPE_AGENT); }
__device__ __forceinline__ unsigned xb_xcc_id() { return (unsigned)__builtin_amdgcn_s_getreg((3 << 11) | 20) & 0xFu; }
#define XB_SPIN(cond, bar) do { unsigned _sp = 0; while (cond) { __builtin_amdgcn_s_sleep(1); \
    if ((++_sp & 255u) == 0u) { if (xb_ld(&(bar)[XB_TMO])) break; if (_sp > XB_SPIN_CAP) { atomicAdd(&(bar)[XB_TMO], 1u); break; } } } } while (0)

struct XcdBarrier {
    unsigned* bar; unsigned x;
    volatile LAS unsigned* st;
};

__device__ __forceinline__ XcdBarrier xcd_barrier_post(unsigned* bar, volatile LAS unsigned* st, int wv) {
    XcdBarrier b; b.bar = bar; b.x = xb_xcc_id(); b.st = st;
    if (fresh_tid(wv) == 0) (void)xb_add(&bar[XB_XCNT(b.x)], 1u);
    return b;
}
__device__ __forceinline__ void xcd_barrier_complete(unsigned* bar, unsigned x, unsigned& nloc, unsigned& nx) {
    const unsigned G = gridDim.x * gridDim.y * gridDim.z;
    unsigned sum, cnt, mine, sp = 0u;
    for (;;) {
        sum = 0u; cnt = 0u; mine = 0u;
#pragma unroll
        for (unsigned j = 0; j < 16; ++j) { const unsigned c = xb_ld(&bar[XB_XCNT(j)]); sum += c; cnt += (c > 0u) ? 1u : 0u; mine = (j == x) ? c : mine; }
        if (sum == G) break;
        __builtin_amdgcn_s_sleep(1);
        if ((++sp & 255u) == 0u) { if (xb_ld(&bar[XB_TMO])) break; if (sp > XB_SPIN_CAP) { atomicAdd(&bar[XB_TMO], 1u); break; } }
    }
    nloc = mine > 0u ? mine : 1u; nx = cnt > 0u ? cnt : 1u;
}

__device__ __forceinline__ void xcd_barrier(const XcdBarrier& b, int wv) {
    asm volatile("s_waitcnt vmcnt(0)" ::: "memory");
    __syncthreads();
    if (fresh_tid(wv) == 0) {
        unsigned* bar = b.bar;
        __builtin_amdgcn_s_waitcnt(0);
        unsigned nloc = b.st[0], nx = b.st[1];
        if (nloc == 0u) { xcd_barrier_complete(bar, b.x, nloc, nx); b.st[0] = nloc; b.st[1] = nx; }
        const unsigned old = xb_add(&bar[XB_XSUB(b.x)], 1u);
        const unsigned gen = old / nloc;
        if (old + 1u == (gen + 1u) * nloc) {
            __builtin_amdgcn_fence(__ATOMIC_RELEASE, "agent");
            asm volatile("s_waitcnt vmcnt(0)" ::: "memory");
            const unsigned og = xb_add(&bar[XB_TOP], 1u);
            const unsigned tg = og / nx;
            if (og + 1u == (tg + 1u) * nx) xb_add(&bar[XB_TOPGEN], 1u);
            else XB_SPIN(xb_ld(&bar[XB_TOPGEN]) == tg, bar);
            __builtin_amdgcn_fence(__ATOMIC_ACQUIRE, "agent");
            xb_add(&bar[XB_XGEN(b.x)], 1u);
            asm volatile("s_waitcnt vmcnt(0)" ::: "memory");
        } else {
            XB_SPIN(xb_ld(&bar[XB_XGEN(b.x)]) == gen, bar);
            __builtin_amdgcn_fence(__ATOMIC_ACQUIRE, "agent");
            asm volatile("s_waitcnt vmcnt(0)" ::: "memory");
        }
    }
    __syncthreads();
}

__device__ __forceinline__ float rstd_of(float ss, float invn) { return rsqrtf(ss * invn + EPS); }

#ifndef NT_STORES
#define NT_STORES 0
#endif
#if NT_STORES
#define ST(ptr, val) __builtin_nontemporal_store((val), (ptr))
#else
#define ST(ptr, val) (*(ptr) = (val))
#endif
struct EpiSwiGLU {
    static constexpr bool PERM = true, AFTER_DRAIN = false;
    bf16_t* H; const float* ss;
    __device__ __forceinline__ void operator()(const f32x4 (&acc)[2][2][4][2], const Unit& u, int wr, int wc, int fr, int fq) const {
        const int row0 = u.pm * 256 + wr * 64 + fr, col0 = u.pn * 128 + wc * 32 + 8 * fq;
        float rsv[2][4];
#pragma unroll
        for (int ai = 0; ai < 2; ++ai)
#pragma unroll
            for (int m = 0; m < 4; ++m) rsv[ai][m] = ss[row0 + ai * 128 + m * 16];
#pragma unroll
        for (int ai = 0; ai < 2; ++ai)
#pragma unroll
            for (int m = 0; m < 4; ++m) {
                const int row = row0 + ai * 128 + m * 16;
                const float rs = rstd_of(rsv[ai][m], 1.0f / D);
                unsigned w[4];
#pragma unroll
                for (int n = 0; n < 2; ++n) {
                    float hv[4];
#pragma unroll
                    for (int e = 0; e < 4; ++e) {
                        const float g = acc[ai][0][m][n][e] * rs, uu = acc[ai][1][m][n][e] * rs;
                        hv[e] = g * __builtin_amdgcn_rcpf(1.0f + __expf(-g)) * uu;
                    }
                    w[2 * n] = cvt_pk_bf16(hv[0], hv[1]); w[2 * n + 1] = cvt_pk_bf16(hv[2], hv[3]);
                }
                ST((u32x4*)(H + (size_t)row * FF + col0), ((u32x4){w[0], w[1], w[2], w[3]}));
            }
    }
};
struct EpiResid {
    static constexpr bool PERM = false, AFTER_DRAIN = false;
    const float* base; float* X; bf16_t* xb; float* ssn; float alpha;
    __device__ __forceinline__ void operator()(const f32x4 (&acc)[2][2][4][2], const Unit& u, int wr, int wc, int fr, int fq) const {
        const int row0 = u.pm * 256 + wr * 64 + fr, col0 = u.pn * 256 + wc * 32 + 4 * fq;
        f32x4 buf[2][2][2][2];
#define ER_LOAD(c) do { _Pragma("unroll") for (int mm = 0; mm < 2; ++mm) _Pragma("unroll") for (int bj = 0; bj < 2; ++bj) _Pragma("unroll") for (int n = 0; n < 2; ++n) \
            buf[(c) & 1][mm][bj][n] = *(const f32x4*)(base + (size_t)(row0 + ((c) >> 1) * 128 + (((c) & 1) * 2 + mm) * 16) * D + col0 + bj * 128 + n * 16); } while (0)
        ER_LOAD(0);
#pragma unroll
        for (int c = 0; c < 4; ++c) {
            if (c < 3) ER_LOAD(c + 1);
#pragma unroll
            for (int mm = 0; mm < 2; ++mm) {
                const int ai = c >> 1, m = (c & 1) * 2 + mm, row = row0 + ai * 128 + m * 16; float sq = 0.f;
#pragma unroll
                for (int bj = 0; bj < 2; ++bj)
#pragma unroll
                    for (int n = 0; n < 2; ++n) {
                        const size_t off = (size_t)row * D + col0 + bj * 128 + n * 16;
                        const f32x4 o = buf[c & 1][mm][bj][n] + acc[ai][bj][m][n] * alpha;
                        ST((f32x4*)(X + off), o);
                        ST((u32x2*)(xb + off), ((u32x2){cvt_pk_bf16(o[0], o[1]), cvt_pk_bf16(o[2], o[3])}));
                        sq += (o[0] * o[0] + o[1] * o[1]) + (o[2] * o[2] + o[3] * o[3]);
                    }
                sq += __shfl_xor(sq, 16); sq += __shfl_xor(sq, 32);
                if (fq == 0) unsafeAtomicAdd(ssn + row, sq);
            }
            asm volatile("" ::: "memory");
        }
#undef ER_LOAD
    }
};
struct EpiPle {
    static constexpr bool PERM = false, AFTER_DRAIN = false;
    float* X; const bf16_t* PP; const float* ss; bf16_t* xb; float* ssn;
    __device__ __forceinline__ void operator()(const f32x4 (&acc)[2][2][4][2], const Unit& u, int wr, int wc, int fr, int fq) const {
        int l_; asm volatile("v_mbcnt_lo_u32_b32 %0, -1, 0\n\tv_mbcnt_hi_u32_b32 %0, -1, %0" : "=v"(l_)); const int fr_ = l_ & 15, fq_ = l_ >> 4;
        const int row0 = u.pm * 256 + wr * 64 + fr_, col0 = u.pn * 256 + wc * 32 + 4 * fq_;
        f32x4 bx_[2][2][2]; u32x2 bp_[2][2][2]; float rsn_[2];
#define EP_LOAD(c) do { rsn_[(c) & 1] = ss[row0 + ((c) >> 2) * 128 + ((c) & 3) * 16]; _Pragma("unroll") for (int bj = 0; bj < 2; ++bj) _Pragma("unroll") for (int n = 0; n < 2; ++n) { \
            const size_t off_ = (size_t)(row0 + ((c) >> 2) * 128 + ((c) & 3) * 16) * D + col0 + bj * 128 + n * 16; bx_[(c) & 1][bj][n] = *(const f32x4*)(X + off_); bp_[(c) & 1][bj][n] = *(const u32x2*)(PP + off_); } } while (0)
        EP_LOAD(0);
#pragma unroll
        for (int c = 0; c < 8; ++c) {
            if (c < 7) EP_LOAD(c + 1);
            const int ai = c >> 2, m = c & 3, row = row0 + ai * 128 + m * 16; float sq = 0.f;
            const float rs = rstd_of(rsn_[c & 1], 1.0f / D);
#pragma unroll
            for (int bj = 0; bj < 2; ++bj)
#pragma unroll
                for (int n = 0; n < 2; ++n) {
                    const size_t off = (size_t)row * D + col0 + bj * 128 + n * 16;
                    const f32x4 bs = bx_[c & 1][bj][n]; const u32x2 pw = bp_[c & 1][bj][n]; const f32x4 pp = (f32x4){bf_lo(pw.x), bf_hi(pw.x), bf_lo(pw.y), bf_hi(pw.y)};
                    f32x4 o;
#pragma unroll
                    for (int e = 0; e < 4; ++e) { const float a = acc[ai][bj][m][n][e] * rs; o[e] = bs[e] + __builtin_amdgcn_rcpf(1.0f + __expf(-a)) * pp[e]; }
                    ST((f32x4*)(X + off), o);
                    if (xb) ST((u32x2*)(xb + off), ((u32x2){cvt_pk_bf16(o[0], o[1]), cvt_pk_bf16(o[2], o[3])}));
                    sq += (o[0] * o[0] + o[1] * o[1]) + (o[2] * o[2] + o[3] * o[3]);
                }
            sq += __shfl_xor(sq, 16); sq += __shfl_xor(sq, 32);
            if (fq_ == 0) unsafeAtomicAdd(ssn + row, sq);
            asm volatile("" ::: "memory");
        }
#undef EP_LOAD
    }
};
struct EpiScaleRow {
    static constexpr bool PERM = true, AFTER_DRAIN = false;
    bf16_t* O; int ldc; const float* ss;
    __device__ __forceinline__ void operator()(const f32x4 (&acc)[2][2][4][2], const Unit& u, int wr, int wc, int fr, int fq) const {
        const int row0 = u.pm * 256 + wr * 64 + fr, col0 = u.pn * 256 + wc * 32 + 8 * fq;
        float rsv[2][4];
#pragma unroll
        for (int ai = 0; ai < 2; ++ai)
#pragma unroll
            for (int m = 0; m < 4; ++m) rsv[ai][m] = ss[row0 + ai * 128 + m * 16];
#pragma unroll
        for (int ai = 0; ai < 2; ++ai)
#pragma unroll
            for (int m = 0; m < 4; ++m) {
                const int row = row0 + ai * 128 + m * 16;
                const float rs = rstd_of(rsv[ai][m], 1.0f / D);
#pragma unroll
                for (int bj = 0; bj < 2; ++bj) {
                    const f32x4 v0 = acc[ai][bj][m][0] * rs, v1 = acc[ai][bj][m][1] * rs;
                    ST((u32x4*)(O + (size_t)row * ldc + col0 + bj * 128), ((u32x4){cvt_pk_bf16(v0[0], v0[1]), cvt_pk_bf16(v0[2], v0[3]), cvt_pk_bf16(v1[0], v1[1]), cvt_pk_bf16(v1[2], v1[3])}));
                }
            }
    }
};
struct EpiScaleCol {
    static constexpr bool PERM = true, AFTER_DRAIN = false;
    bf16_t* O; int ldc; const float* ss;
    __device__ __forceinline__ void operator()(const f32x4 (&acc)[2][2][4][2], const Unit& u, int wr, int wc, int fr, int fq) const {
        const int row0 = u.pm * 256 + wr * 64 + fr, col0 = u.pn * 256 + wc * 32 + 8 * fq;
        const f32x4 sa0 = *(const f32x4*)(ss + col0), sb0 = *(const f32x4*)(ss + col0 + 4), sa1 = *(const f32x4*)(ss + col0 + 128), sb1 = *(const f32x4*)(ss + col0 + 132);
#pragma unroll
        for (int bj = 0; bj < 2; ++bj) {
            float rs[8];
            {
                const f32x4 a = bj == 0 ? sa0 : sa1, b = bj == 0 ? sb0 : sb1;
#pragma unroll
                for (int e = 0; e < 4; ++e) { rs[e] = rstd_of(a[e], 1.0f / D); rs[4 + e] = rstd_of(b[e], 1.0f / D); }
            }
#pragma unroll
            for (int ai = 0; ai < 2; ++ai)
#pragma unroll
                for (int m = 0; m < 4; ++m) {
                    const int row = row0 + ai * 128 + m * 16;
                    const f32x4 v0 = acc[ai][bj][m][0], v1 = acc[ai][bj][m][1];
                    ST((u32x4*)(O + (size_t)row * ldc + col0 + bj * 128), ((u32x4){cvt_pk_bf16(v0[0] * rs[0], v0[1] * rs[1]), cvt_pk_bf16(v0[2] * rs[2], v0[3] * rs[3]),
                                                                                  cvt_pk_bf16(v1[0] * rs[4], v1[1] * rs[5]), cvt_pk_bf16(v1[2] * rs[6], v1[3] * rs[7])}));
                }
        }
    }
};
struct EpiStoreBf16 {
    static constexpr bool PERM = false, AFTER_DRAIN = false;
    bf16_t* O; int ldc;
    __device__ __forceinline__ void operator()(const f32x4 (&acc)[2][2][4][2], const Unit& u, int wr, int wc, int fr, int fq) const {
        int l_; asm volatile("v_mbcnt_lo_u32_b32 %0, -1, 0\n\tv_mbcnt_hi_u32_b32 %0, -1, %0" : "=v"(l_)); const int fr_ = l_ & 15, fq_ = l_ >> 4;
        const int row0 = u.pm * 256 + wr * 64 + fr_, col0 = u.pn * 256 + wc * 32 + 4 * fq_;
#pragma unroll
        for (int ai = 0; ai < 2; ++ai)
#pragma unroll
            for (int m = 0; m < 4; ++m)
#pragma unroll
                for (int bj = 0; bj < 2; ++bj)
#pragma unroll
                    for (int n = 0; n < 2; ++n) { const f32x4 v = acc[ai][bj][m][n]; ST((u32x2*)(O + (size_t)(row0 + ai * 128 + m * 16) * ldc + col0 + bj * 128 + n * 16), ((u32x2){cvt_pk_bf16(v[0], v[1]), cvt_pk_bf16(v[2], v[3])})); }
    }
};
struct EpiStoreF32 {
    static constexpr bool PERM = false, AFTER_DRAIN = false;
    float* O; int ldc;
    __device__ __forceinline__ void operator()(const f32x4 (&acc)[2][2][4][2], const Unit& u, int wr, int wc, int fr, int fq) const {
        const int row0 = u.pm * 256 + wr * 64 + fr, col0 = u.pn * 256 + wc * 32 + 4 * fq;
#pragma unroll
        for (int ai = 0; ai < 2; ++ai)
#pragma unroll
            for (int m = 0; m < 4; ++m)
#pragma unroll
                for (int bj = 0; bj < 2; ++bj)
#pragma unroll
                    for (int n = 0; n < 2; ++n) ST((f32x4*)(O + (size_t)(row0 + ai * 128 + m * 16) * ldc + col0 + bj * 128 + n * 16), acc[ai][bj][m][n]);
    }
};

struct EpiDry {
    static constexpr bool PERM = false, AFTER_DRAIN = false;
    __device__ __forceinline__ void operator()(const f32x4 (&acc)[2][2][4][2], const Unit& u, int wr, int wc, int fr, int fq) const {
#pragma unroll
        for (int ai = 0; ai < 2; ++ai)
#pragma unroll
            for (int bj = 0; bj < 2; ++bj)
#pragma unroll
                for (int m = 0; m < 4; ++m)
#pragma unroll
                    for (int n = 0; n < 2; ++n) asm volatile("" :: "v"(acc[ai][bj][m][n]));
    }
};
template <class Epi>
__device__ __forceinline__ void gemm_naive(int wv, const Gemm g, const StaticOrder& S, const Epi& E) {
    const int tid = fresh_tid(wv), wid = tid >> 6, lane = tid & 63, wr = wid >> 2, wc = wid & 3, fr = lane & 15, fq = lane >> 4;
    Unit u;
    for (int ui = 0; S.next(ui, u); ++ui) {
        f32x4 acc[2][2][4][2];
#pragma unroll
        for (int a = 0; a < 2; ++a)
#pragma unroll
            for (int b = 0; b < 2; ++b)
#pragma unroll
                for (int m = 0; m < 4; ++m)
#pragma unroll
                    for (int n = 0; n < 2; ++n) acc[a][b][m][n] = (f32x4){0.f, 0.f, 0.f, 0.f};
        for (int k0 = 0; k0 < g.K; k0 += 32) {
            bf16x8 Bf[2][2];
#pragma unroll
            for (int bj = 0; bj < 2; ++bj)
#pragma unroll
                for (int n = 0; n < 2; ++n) {
                    const int slot = 16 * n + fr; const int rr = Epi::PERM ? pg8::perm32(slot) : slot;
                    Bf[bj][n] = *(const bf16x8*)(g.Bt + (size_t)(u.pn * 256 + bj * 128 + wc * 32 + rr) * g.K + k0 + 8 * fq);
                }
#pragma unroll
            for (int ai = 0; ai < 2; ++ai)
#pragma unroll
                for (int m = 0; m < 4; ++m) {
                    const bf16x8 Af = *(const bf16x8*)(g.A + (size_t)(u.pm * 256 + ai * 128 + wr * 64 + m * 16 + fr) * g.K + k0 + 8 * fq);
#pragma unroll
                    for (int bj = 0; bj < 2; ++bj)
#pragma unroll
                        for (int n = 0; n < 2; ++n) acc[ai][bj][m][n] = __builtin_amdgcn_mfma_f32_16x16x32_bf16(Bf[bj][n], Af, acc[ai][bj][m][n], 0, 0, 0);
                }
        }
        E(acc, u, wr, wc, fr, fq);
    }
}
template <class Epi>
__device__ __forceinline__ void gemm_run(int wv, LAS unsigned char* lds, const bf16_t* A, const bf16_t* Bt, int Mm, int Nn, int Kk, const Epi& E, bool upper_half_only = false) {
    int bx_ = blockIdx.x; asm volatile("" : "+s"(bx_));
    int G_ = (int)gridDim.x;
    if (upper_half_only) { const int lo = G_ / 2; if (bx_ >= lo) { bx_ -= lo; G_ -= lo; } else bx_ = 1 << 28; }
    Gemm g{A, Bt, Mm, Nn, Kk}; StaticOrder S; S.init(Mm, Nn, G_, bx_);
#if NAIVE_GEMM
    gemm_naive<Epi>(wv, g, S, E);
    __syncthreads();
#else
    pg8::gemm_phase<Epi, StaticOrder, true, true>(lds, g, S, E, fresh_tid(wv));
#endif
}

__device__ __forceinline__ void transpose_item(const float* W, int K, int N, const float* gain, bf16_t* WT, int mode, int row_off, LAS float* scr, int item, int lane) {
    const int nblk = N / 32, kb = item / nblk, nb = item % nblk, k0 = 64 * kb, n0 = 32 * nb;
    f32x4 v[8];
#pragma unroll
    for (int i = 0; i < 8; ++i) v[i] = *(const f32x4*)(W + (size_t)(k0 + (lane >> 3) + 8 * i) * N + n0 + 4 * (lane & 7));
#pragma unroll
    for (int i = 0; i < 8; ++i) {
        const int kk = (lane >> 3) + 8 * i; const float gg = gain ? gain[k0 + kk] : 1.0f;
        LAS float* d = scr + kk * 33 + 4 * (lane & 7);
        d[0] = v[i][0] * gg; d[1] = v[i][1] * gg; d[2] = v[i][2] * gg; d[3] = v[i][3] * gg;
    }
    asm volatile("s_waitcnt lgkmcnt(0)" ::: "memory");
    const int c = lane & 7;
#pragma unroll
    for (int j = 0; j < 4; ++j) {
        const int n = (lane >> 3) + 8 * j, ncol = n0 + n; const LAS float* s = scr + (8 * c) * 33 + n;
        const int row = (mode == 1) ? (256 * (ncol >> 7) + (ncol & 127) + row_off) : (row_off + ncol);
        const float sc = (mode == 2 && ncol < 512) ? 0.125f : 1.0f;
        u32x4 o; o.x = cvt_pk_bf16(s[0 * 33] * sc, s[1 * 33] * sc); o.y = cvt_pk_bf16(s[2 * 33] * sc, s[3 * 33] * sc); o.z = cvt_pk_bf16(s[4 * 33] * sc, s[5 * 33] * sc); o.w = cvt_pk_bf16(s[6 * 33] * sc, s[7 * 33] * sc);
        *(u32x4*)(WT + (size_t)row * K + k0 + 8 * c) = o;
    }
    asm volatile("s_waitcnt lgkmcnt(0)" ::: "memory");
}

constexpr float MIN_DECAY = -3.0701134573253946f, MAX_DECAY = -15.350567286626973f;
__device__ __forceinline__ float rdl(float v, int k) { return __shfl(v, k); }
__device__ __forceinline__ void filter_item(KPC p, int layer, int item, int lane, float* FT) {
    const float* wf1 = p->in[11] + layer * 33 * 64; const float* bf1 = p->in[12] + layer * 64;
    const float* wf2 = p->in[13] + layer * 4096;    const float* bf2 = p->in[14] + layer * 64;
    const float* wf3 = p->in[15] + layer * 4096;    const float* bf3 = p->in[16] + layer * 64;
    const float* wf4 = p->in[17] + layer * 64 * 1024; const float fq = p->in[18][layer * 64 + lane];
    const int i0 = item * 2;
    float h[2], wc[64];
#pragma unroll
    for (int k = 0; k < 33; ++k) wc[k] = wf1[k * 64 + lane];
    const float bb1 = bf1[lane], bb2 = bf2[lane], bb3 = bf3[lane];
#pragma unroll
    for (int q = 0; q < 2; ++q) {
        const int i = i0 + q;
        const float t = (float)i * (1.0f / 2047.0f), w = 6.283185307179586f * (float)i / 2048.0f;
        const int j = (lane - 1) & 15; const float f = 1e-4f + (float)j * ((15.0f - 1e-4f) / 15.0f);
        const float a = f * w;
        float zf = 0.f;
        if (lane == 0) zf = t; else if (lane <= 16) zf = __cosf(a); else if (lane <= 32) zf = -__sinf(a);
        float s = bb1;
#pragma unroll
        for (int k = 0; k < 33; ++k) s += rdl(zf, k) * wc[k];
        h[q] = __sinf(fq * s);
    }
#pragma unroll
    for (int k = 0; k < 64; ++k) wc[k] = wf2[k * 64 + lane];
#pragma unroll
    for (int q = 0; q < 2; ++q) {
        float s = bb2;
#pragma unroll
        for (int k = 0; k < 64; ++k) s += rdl(h[q], k) * wc[k];
        h[q] = __sinf(fq * s);
    }
#pragma unroll
    for (int k = 0; k < 64; ++k) wc[k] = wf3[k * 64 + lane];
#pragma unroll
    for (int q = 0; q < 2; ++q) {
        float s = bb3;
#pragma unroll
        for (int k = 0; k < 64; ++k) s += rdl(h[q], k) * wc[k];
        h[q] = __sinf(fq * s);
    }
    float acc[2][16];
#pragma unroll
    for (int q = 0; q < 2; ++q)
#pragma unroll
        for (int jj = 0; jj < 16; ++jj) acc[q][jj] = 0.f;
    for (int k0 = 0; k0 < 64; k0 += 4) {
        float w[4][16];
#pragma unroll
        for (int kk = 0; kk < 4; ++kk)
#pragma unroll
            for (int jj = 0; jj < 16; ++jj) w[kk][jj] = wf4[(k0 + kk) * 1024 + lane + 64 * jj];
#pragma unroll
        for (int kk = 0; kk < 4; ++kk) {
            const float h0 = rdl(h[0], k0 + kk), h1 = rdl(h[1], k0 + kk);
#pragma unroll
            for (int jj = 0; jj < 16; ++jj) { acc[0][jj] += h0 * w[kk][jj]; acc[1][jj] += h1 * w[kk][jj]; }
        }
    }
#pragma unroll
    for (int jj = 0; jj < 16; ++jj) {
        const int cf = lane + 64 * jj, dir = cf >> 9, c = cf & 511;
        const float delta = fabsf(MIN_DECAY + (float)c * ((MAX_DECAY - MIN_DECAY) / 511.0f));
        f32x2 o;
#pragma unroll
        for (int q = 0; q < 2; ++q) { const float t = (float)(i0 + q) * (1.0f / 2047.0f); o[q] = acc[q][jj] * __expf(-t * delta); }
        *(f32x2*)(FT + ((size_t)(dir * 512 + c)) * SEQ + i0) = o;
    }
}

__device__ __forceinline__ void filter_block(KPC p, int layer, int item, int lane, int tid, LAS unsigned char* lds, float* FT) {
    const float* wf1 = p->in[11] + layer * 33 * 64; const float* bf1 = p->in[12] + layer * 64;
    const float* wf2 = p->in[13] + layer * 4096;    const float* bf2 = p->in[14] + layer * 64;
    const float* wf3 = p->in[15] + layer * 4096;    const float* bf3 = p->in[16] + layer * 64;
    const float* wf4 = p->in[17] + layer * 64 * 1024; const float fq = p->in[18][layer * 64 + lane];
    const int i0 = item * 2;
    float h[2], wc[64];
#pragma unroll
    for (int k = 0; k < 33; ++k) wc[k] = wf1[k * 64 + lane];
    const float bb1 = bf1[lane], bb2 = bf2[lane], bb3 = bf3[lane];
#pragma unroll
    for (int q = 0; q < 2; ++q) {
        const int i = i0 + q;
        const float t = (float)i * (1.0f / 2047.0f), w = 6.283185307179586f * (float)i / 2048.0f;
        const int j = (lane - 1) & 15; const float f = 1e-4f + (float)j * ((15.0f - 1e-4f) / 15.0f);
        const float a = f * w;
        float zf = 0.f;
        if (lane == 0) zf = t; else if (lane <= 16) zf = __cosf(a); else if (lane <= 32) zf = -__sinf(a);
        float s = bb1;
#pragma unroll
        for (int k = 0; k < 33; ++k) s += rdl(zf, k) * wc[k];
        h[q] = __sinf(fq * s);
    }
#pragma unroll
    for (int k = 0; k < 64; ++k) wc[k] = wf2[k * 64 + lane];
#pragma unroll
    for (int q = 0; q < 2; ++q) {
        float s = bb2;
#pragma unroll
        for (int k = 0; k < 64; ++k) s += rdl(h[q], k) * wc[k];
        h[q] = __sinf(fq * s);
    }
#pragma unroll
    for (int k = 0; k < 64; ++k) wc[k] = wf3[k * 64 + lane];
#pragma unroll
    for (int q = 0; q < 2; ++q) {
        float s = bb3;
#pragma unroll
        for (int k = 0; k < 64; ++k) s += rdl(h[q], k) * wc[k];
        h[q] = __sinf(fq * s);
    }
    float acc[2][16];
#pragma unroll
    for (int q = 0; q < 2; ++q)
#pragma unroll
        for (int jj = 0; jj < 16; ++jj) acc[q][jj] = 0.f;
    LAS float* WL = (LAS float*)lds;
    for (int ck = 0; ck < 4; ++ck) {
        __syncthreads();
        f32x4 t[8];
#pragma unroll
        for (int u = 0; u < 8; ++u) t[u] = *(const f32x4*)(wf4 + (size_t)ck * 16384 + (size_t)(tid + 512 * u) * 4);
#pragma unroll
        for (int u = 0; u < 8; ++u) *(LAS f32x4*)(WL + (tid + 512 * u) * 4) = t[u];
        __syncthreads();
#pragma unroll 1
        for (int kk = 0; kk < 16; ++kk) {
            const float h0 = rdl(h[0], ck * 16 + kk), h1 = rdl(h[1], ck * 16 + kk);
#pragma unroll
            for (int jj = 0; jj < 16; ++jj) { const float w = WL[kk * 1024 + lane + 64 * jj]; acc[0][jj] += h0 * w; acc[1][jj] += h1 * w; }
        }
    }
    __syncthreads();
    LAS float* OUTL = (LAS float*)lds;
    const int wvq = (item & 7) * 2;
#pragma unroll
    for (int jj = 0; jj < 16; ++jj) {
        const int cf = lane + 64 * jj, c = cf & 511;
        const float delta = fabsf(MIN_DECAY + (float)c * ((MAX_DECAY - MIN_DECAY) / 511.0f));
#pragma unroll
        for (int q = 0; q < 2; ++q) { const float t = (float)(i0 + q) * (1.0f / 2047.0f); OUTL[(wvq + q) * 1024 + cf] = acc[q][jj] * __expf(-t * delta); }
    }
    __syncthreads();
    {
        const int ib = (item >> 3) * 16;
#pragma unroll
        for (int u = 0; u < 8; ++u) {
            const int id = tid + 512 * u, cf = id >> 2, part = id & 3;
            const f32x4 v = (f32x4){OUTL[(4 * part + 0) * 1024 + cf], OUTL[(4 * part + 1) * 1024 + cf], OUTL[(4 * part + 2) * 1024 + cf], OUTL[(4 * part + 3) * 1024 + cf]};
            *(f32x4*)(FT + (size_t)cf * SEQ + ib + 4 * part) = v;
        }
    }
    __syncthreads();
}

constexpr int TI_G = 16 * 88, TI_D = 44 * 32, TI_IN = 16 * 96, TI_O = 16 * 32, TI_PP = 4 * 32;
constexpr int TI_ALL = 6 * TI_G + TI_IN + 2 * TI_O + TI_PP, TI_EARLY = TI_ALL - 3072;
__device__ __forceinline__ void do_transpose(KPC p, size_t lf, unsigned char* Wb, LAS float* scr, int r, int lane) {
    constexpr int I_G = TI_G, I_D = TI_D, I_IN = TI_IN, I_O = TI_O;
    int wi, gi = -1, K = D, N = FF, mode = 1, row_off = 0; size_t wo = W_GUA, wstride = (size_t)D * FF;
    if (r < I_G) { wi = 3; gi = 2; }
    else if ((r -= I_G) < I_G) { wi = 4; gi = 2; row_off = 128; }
    else if ((r -= I_G) < I_D) { wi = 5; K = FF; N = D; mode = 0; wo = W_DA; }
    else if ((r -= I_D) < I_IN) { wi = 7; gi = 6; N = 3072; mode = 2; wo = W_IN; wstride = (size_t)D * 3072; }
    else if ((r -= I_IN) < I_O) { wi = 21; gi = 20; N = D; mode = 0; wo = W_OUT; wstride = (size_t)D * D; }
    else if ((r -= I_O) < I_G) { wi = 23; gi = 22; wo = W_GUB; }
    else if ((r -= I_G) < I_G) { wi = 24; gi = 22; row_off = 128; wo = W_GUB; }
    else if ((r -= I_G) < I_D) { wi = 25; K = FF; N = D; mode = 0; wo = W_DB; }
    else if ((r -= I_D) < I_O) { wi = 27; gi = 26; N = D; mode = 0; wo = W_PG; wstride = (size_t)D * D; }
    else { r -= I_O; wi = 28; K = PLE; N = D; mode = 0; wo = W_PP; wstride = (size_t)PLE * D; }
    const float* gain = gi >= 0 ? p->in[gi] + lf * D : nullptr;
    transpose_item(p->in[wi] + lf * wstride, K, N, gain, (bf16_t*)(Wb + wo), mode, row_off, scr, r, lane);
}
__device__ __forceinline__ void late_transposes(int wv, KPC p, int layer, LAS unsigned char* lds) {
    const int tid = fresh_tid(wv), bx = fresh_bx(), lane = tid & 63, G = gridDim.x;
    if (G * 8 != 2048 || bx < G / 2) return;
    LAS float* scr = (LAS float*)(lds + wv * 16384);
    unsigned char* Wb = p->ws + WS_W;
    const int gw = (bx - G / 2) * 8 + wv, NGW = (G - G / 2) * 8;
    const int tie = TI_ALL - (layer == 0 ? 3072 : 4096);
    for (int r = tie + gw; r < TI_ALL; r += NGW) do_transpose(p, (size_t)layer, Wb, scr, r, lane);
    if (layer == 0) {
        bf16_t* pb = (bf16_t*)(p->ws + WS_PB);
        const size_t n8 = (size_t)2 * M * PLE / 8;
        const size_t stride = (size_t)(G - G / 2) * 512;
        for (size_t i0 = (size_t)(bx - G / 2) * 512 + tid; i0 < n8; i0 += 4 * stride) {
            f32x4 a[4], b[4];
#pragma unroll
            for (int u = 0; u < 4; ++u) { const size_t i = i0 + u * stride < n8 ? i0 + u * stride : i0; a[u] = *(const f32x4*)(p->in[1] + i * 8); b[u] = *(const f32x4*)(p->in[1] + i * 8 + 4); }
#pragma unroll
            for (int u = 0; u < 4; ++u) { const size_t i = i0 + u * stride < n8 ? i0 + u * stride : i0; *(u32x4*)(pb + i * 8) = (u32x4){cvt_pk_bf16(a[u][0], a[u][1]), cvt_pk_bf16(a[u][2], a[u][3]), cvt_pk_bf16(b[u][0], b[u][1]), cvt_pk_bf16(b[u][2], b[u][3])}; }
        }
    }
}
__device__ __forceinline__ void layer_prologue(int wv, KPC p, int layer, LAS unsigned char* lds) {
    const int tid = fresh_tid(wv), bx = fresh_bx(), lane = tid & 63, wave = wv;
    LAS float* scr = (LAS float*)(lds + wave * 16384);
    const int gw = bx * 8 + wave, NGW = gridDim.x * 8;
    unsigned char* Wb = p->ws + WS_W;
    const size_t lf = (size_t)layer;
    constexpr int I_G = 16 * 88, I_D = 44 * 32, I_IN = 16 * 96, I_O = 16 * 32, I_PP = 4 * 32;
    constexpr int NITEMS = 6 * I_G + I_IN + 2 * I_O + I_PP;
    static_assert(I_G == I_D, "items");
    const int tie = TI_ALL - (layer == 0 ? 3072 : 4096);
    const bool std_grid = (NGW == 2048), fw = gw < 1024;
    const int per = fw ? 1 : 3, base = fw ? gw : 1024 + 3 * (gw - 1024);
    for (int k = 0; ; ++k) {
        int r;
        if (std_grid) {
            if (fw && k == 0) { filter_block(p, layer, gw, lane, tid, lds, (float*)(p->ws + WS_FT)); continue; }
            const int kk = fw ? k - 1 : k, rd = kk / per, sub = kk % per; r = rd * 4096 + base + sub; if (rd * 4096 >= tie) break; if (r >= tie) continue;
        } else break;
        do_transpose(p, lf, Wb, scr, r, lane);
    }
    if (layer == 0) {
        bf16_t* xb = (bf16_t*)(p->ws + WS_XB); float* ss0 = (float*)(p->ws + WS_CTL);
        for (int m = gw; m < M; m += NGW) {
            const f32x4* xr = (const f32x4*)(p->in[0] + (size_t)m * D) + lane;
            f32x4 v[4]; float s = 0.f;
#pragma unroll
            for (int j = 0; j < 4; ++j) { v[j] = xr[64 * j]; s += (v[j][0] * v[j][0] + v[j][1] * v[j][1]) + (v[j][2] * v[j][2] + v[j][3] * v[j][3]); }
            s = wave_sum(s);
            if (lane == 0) ss0[m] = s;
            u32x2* o8 = (u32x2*)(xb + (size_t)m * D) + lane;
#pragma unroll
            for (int j = 0; j < 4; ++j) o8[64 * j] = (u32x2){cvt_pk_bf16(v[j][0], v[j][1]), cvt_pk_bf16(v[j][2], v[j][3])};
        }
    }
}

__device__ __forceinline__ void attn_naive(int wv, KPC p, int layer, const bf16_t* QK, const bf16_t* UT, bf16_t* yna) {
    const float* rpb = p->in[8] + layer * 8 * 15 * 31;
    const int tid = fresh_tid(wv), bx = fresh_bx();
    for (int it = bx * 512 + tid; it < M * 8; it += gridDim.x * 512) {
        const int h = it / M, tok = it % M;
        const int b = tok >> 11, l = tok & 2047, r = l >> 6, qc = l & 63;
        const int rs = min(max(r - 4, 0), 24), qcs = min(max(qc - 8, 0), 48);
        float o[64]; u32x4 qp[8];
#pragma unroll
        for (int j = 0; j < 8; ++j) qp[j] = *(const u32x4*)(QK + (size_t)tok * 1024 + 64 * h + 8 * j);
#pragma unroll
        for (int d = 0; d < 64; ++d) o[d] = 0.f;
        float mx = -3.0e38f, ls = 0.f;
        for (int kr = 0; kr < 8; ++kr)
            for (int kx = 0; kx < 16; ++kx) {
                const int krow = rs + kr, kc = qcs + kx; const size_t ktok = (size_t)b * 2048 + krow * 64 + kc;
                float s = 0.f;
#pragma unroll
                for (int j = 0; j < 8; ++j) {
                    const u32x4 v = *(const u32x4*)(QK + ktok * 1024 + 512 + 64 * h + 8 * j);
                    const u32x4 qq = qp[j];
                    s += bf_lo(qq.x) * bf_lo(v.x) + bf_hi(qq.x) * bf_hi(v.x) + bf_lo(qq.y) * bf_lo(v.y) + bf_hi(qq.y) * bf_hi(v.y)
                       + bf_lo(qq.z) * bf_lo(v.z) + bf_hi(qq.z) * bf_hi(v.z) + bf_lo(qq.w) * bf_lo(v.w) + bf_hi(qq.w) * bf_hi(v.w);
                }
                s += rpb[(h * 15 + (krow - r + 7)) * 31 + (kc - qc + 15)];
                const float mn = fmaxf(mx, s), corr = __expf(mx - mn), pe = __expf(s - mn);
                ls = ls * corr + pe; mx = mn;
#pragma unroll
                for (int d = 0; d < 64; ++d) o[d] = o[d] * corr + pe * bf2f(UT[(size_t)(64 * h + d) * M + ktok]);
            }
        const float inv = 1.0f / ls;
#pragma unroll
        for (int j = 0; j < 8; ++j)
            *(u32x4*)(yna + (size_t)tok * 512 + 64 * h + 8 * j) = (u32x4){cvt_pk_bf16(o[8 * j] * inv, o[8 * j + 1] * inv), cvt_pk_bf16(o[8 * j + 2] * inv, o[8 * j + 3] * inv),
                                                                         cvt_pk_bf16(o[8 * j + 4] * inv, o[8 * j + 5] * inv), cvt_pk_bf16(o[8 * j + 6] * inv, o[8 * j + 7] * inv)};
    }
}

__device__ __forceinline__ float sconv(const bf16_t* row, int t, float w0, float w1, float w2, float bb) {
    const float a = t > 0 ? bf2f(row[t - 1]) : 0.f, b = bf2f(row[t]), c = t < SEQ - 1 ? bf2f(row[t + 1]) : 0.f;
    return a * w0 + b * w1 + c * w2 + bb;
}
__device__ __forceinline__ void conv_naive(int wv, KPC p, int layer, LAS unsigned char* lds, const bf16_t* UT, const float* FT, bf16_t* yhyT) {
    LAS float* karr = (LAS float*)lds; LAS float* zf = karr + 4096; LAS float* x0f = zf + 2048; LAS float* red = x0f + 2048;
    const float* wsc = p->in[9] + layer * 3 * 1536; const float* bsc = p->in[10] + layer * 1536; const float* hyb = p->in[19] + layer * 512;
    const int tid = fresh_tid(wv), bx = fresh_bx(), lane = tid & 63, wave = wv;
    for (int it = bx; it < 512 * 8; it += gridDim.x) {
        const int c = it >> 3, b = it & 7;
        __syncthreads();
        float asum = 0.f;
        for (int d = tid; d < 4096; d += 512) {
            const int dd = d - 2048; float v;
            if (dd == -2048) v = 0.f; else if (dd == 0) v = FT[(size_t)c * SEQ] + FT[(size_t)(512 + c) * SEQ]; else if (dd > 0) v = FT[(size_t)c * SEQ + dd]; else v = FT[(size_t)(512 + c) * SEQ - dd];
            karr[d] = v; asum += fabsf(v);
        }
        {
            const bf16_t* r0 = UT + (size_t)(512 + c) * M + b * 2048; const bf16_t* r1 = UT + (size_t)(1024 + c) * M + b * 2048; const bf16_t* r2 = UT + (size_t)(1536 + c) * M + b * 2048;
            const float a0 = wsc[c], a1 = wsc[1536 + c], a2 = wsc[3072 + c], ab = bsc[c];
            const float b0 = wsc[512 + c], b1 = wsc[1536 + 512 + c], b2 = wsc[3072 + 512 + c], bb = bsc[512 + c];
            const float c0 = wsc[1024 + c], c1 = wsc[1536 + 1024 + c], c2 = wsc[3072 + 1024 + c], cb = bsc[1024 + c];
            for (int t = tid; t < 2048; t += 512) {
                x0f[t] = sconv(r0, t, a0, a1, a2, ab);
                zf[t] = sconv(r1, t, b0, b1, b2, bb) * sconv(r2, t, c0, c1, c2, cb);
            }
        }
        asum = wave_sum(asum);
        if (lane == 0) red[wave] = asum;
        __syncthreads();
        float kn = 0.f;
#pragma unroll
        for (int w = 0; w < 8; ++w) kn += red[w];
        const float ikn = 1.0f / kn, hb = hyb[c];
#pragma unroll
        for (int e = 0; e < 4; ++e) {
            const int t = tid + 512 * e; float acc = 0.f;
            for (int s = 0; s < 2048; ++s) acc += karr[t - s + 2048] * zf[s];
            const float y = x0f[t] * (acc * ikn + zf[t] * hb);
            yhyT[(size_t)c * M + b * 2048 + t] = (bf16_t)(cvt_pk_bf16(y, 0.f) & 0xffffu);
        }
    }
}


__device__ __forceinline__ void attn_mfma(int wv, KPC p, int layer, const bf16_t* QK, const bf16_t* UT, bf16_t* yna) {
    const float* rpb = p->in[8] + layer * 8 * 15 * 31;
    const int tid = fresh_tid(wv), bx = fresh_bx(), lane = tid & 63, qi = lane & 15, g = lane >> 4;
    for (int it = bx * 8 + wv; it < 8192; it += gridDim.x * 8) {
        const int h = it & 7, j = (it >> 3) & 3, r = (it >> 5) & 31, b = it >> 10;
        const int rs = min(max(r - 4, 0), 24), bc0 = min(max(16 * j - 8, 0), 32);
        const int qc = 16 * j + qi, qcs = min(max(qc - 8, 0), 48);
        const size_t qtok = (size_t)b * 2048 + r * 64 + qc;
        const bf16x8 qf0 = *(const bf16x8*)(QK + qtok * 1024 + 64 * h + 8 * g), qf1 = *(const bf16x8*)(QK + qtok * 1024 + 64 * h + 32 + 8 * g);
        f32x4 s[16];
#pragma unroll
        for (int T = 0; T < 16; ++T) {
            const size_t ktok = (size_t)b * 2048 + (rs + (T >> 1)) * 64 + bc0 + 8 * (qi >> 2) + 4 * (T & 1) + (qi & 3);
            const bf16x8 k0 = *(const bf16x8*)(QK + ktok * 1024 + 512 + 64 * h + 8 * g), k1 = *(const bf16x8*)(QK + ktok * 1024 + 512 + 64 * h + 32 + 8 * g);
            f32x4 z = (f32x4){0.f, 0.f, 0.f, 0.f};
            z = __builtin_amdgcn_mfma_f32_16x16x32_bf16(k0, qf0, z, 0, 0, 0);
            z = __builtin_amdgcn_mfma_f32_16x16x32_bf16(k1, qf1, z, 0, 0, 0);
            s[T] = z;
        }
        float mx = -3.0e38f;
#pragma unroll
        for (int T = 0; T < 16; ++T)
#pragma unroll
            for (int e = 0; e < 4; ++e) {
                const int kc = bc0 + 8 * g + 4 * (T & 1) + e, kr = rs + (T >> 1);
                const bool valid = (kc >= qcs) && (kc < qcs + 16);
                float v = -3.0e38f;
                if (valid) v = s[T][e] + rpb[(h * 15 + kr - r + 7) * 31 + kc - qc + 15];
                s[T][e] = v; mx = fmaxf(mx, v);
            }
        mx = fmaxf(mx, __shfl_xor(mx, 16)); mx = fmaxf(mx, __shfl_xor(mx, 32));
        float ls = 0.f;
#pragma unroll
        for (int T = 0; T < 16; ++T)
#pragma unroll
            for (int e = 0; e < 4; ++e) { const float pe = __expf(s[T][e] - mx); s[T][e] = pe; ls += pe; }
        ls += __shfl_xor(ls, 16); ls += __shfl_xor(ls, 32);
        f32x4 o[4];
#pragma unroll
        for (int dt = 0; dt < 4; ++dt) o[dt] = (f32x4){0.f, 0.f, 0.f, 0.f};
#pragma unroll
        for (int kr = 0; kr < 8; ++kr) {
            const u32x4 pw = (u32x4){cvt_pk_bf16(s[2 * kr][0], s[2 * kr][1]), cvt_pk_bf16(s[2 * kr][2], s[2 * kr][3]), cvt_pk_bf16(s[2 * kr + 1][0], s[2 * kr + 1][1]), cvt_pk_bf16(s[2 * kr + 1][2], s[2 * kr + 1][3])};
            const bf16x8 pf = __builtin_bit_cast(bf16x8, pw);
#pragma unroll
            for (int dt = 0; dt < 4; ++dt) {
                const bf16x8 vf = *(const bf16x8*)(UT + (size_t)(64 * h + 16 * dt + qi) * M + (size_t)b * 2048 + (rs + kr) * 64 + bc0 + 8 * g);
                o[dt] = __builtin_amdgcn_mfma_f32_16x16x32_bf16(vf, pf, o[dt], 0, 0, 0);
            }
        }
        const float inv = 1.0f / ls;
#pragma unroll
        for (int dt = 0; dt < 4; ++dt)
            *(u32x2*)(yna + qtok * 512 + 64 * h + 16 * dt + 4 * g) = (u32x2){cvt_pk_bf16(o[dt][0] * inv, o[dt][1] * inv), cvt_pk_bf16(o[dt][2] * inv, o[dt][3] * inv)};
    }
}


__device__ __forceinline__ void attn_lds(int wv, KPC p, int layer, LAS unsigned char* lds, const bf16_t* QK, const bf16_t* UT, bf16_t* yna) {
    constexpr int KTS = 144, VRS = 976;
    LAS unsigned char* KL = lds; LAS unsigned char* VL = lds + 480 * KTS; LAS float* BL = (LAS float*)(VL + 64 * VRS);
    const float* rpb = p->in[8] + layer * 8 * 15 * 31;
    const int tid = fresh_tid(wv), bx = fresh_bx(), lane = tid & 63, qi = lane & 15, g = lane >> 4;
    u32x4 kst[8], vst[8]; float bst = 0.f; bf16x8 qn0, qn1;
#define ATT_DECODE(bi_) const int rho = (bi_) & 3, j = ((bi_) >> 2) & 3, h = ((bi_) >> 4) & 7, b = (bi_) >> 7; \
        const int krow0 = min(max(8 * rho - 4, 0), 24), nrows = min(max(8 * rho + 3, 0), 24) + 8 - krow0; const int bc0 = min(max(16 * j - 8, 0), 32);
#define ATT_LOAD(bi_) do { ATT_DECODE(bi_);   \
        _Pragma("unroll") for (int k = 0; k < 8; ++k) { const int idx = min(tid + 512 * k, nrows * 256 - 1); const int tl = idx >> 3, ch = idx & 7; \
            kst[k] = *(const u32x4*)(QK + ((size_t)b * 2048 + (krow0 + (tl >> 5)) * 64 + bc0 + (tl & 31)) * 1024 + 512 + 64 * h + 8 * ch); } \
        _Pragma("unroll") for (int k = 0; k < 8; ++k) { const int e = min((tid & 7) + 8 * k, nrows * 4 - 1); const int lr = e >> 2, ch = e & 3; \
            vst[k] = *(const u32x4*)(UT + (size_t)(64 * h + (tid >> 3)) * M + (size_t)b * 2048 + (krow0 + lr) * 64 + bc0 + 8 * ch); } \
        bst = rpb[h * 465 + min(tid, 464)]; \
        { const size_t qt_ = (size_t)b * 2048 + (8 * rho + wv) * 64 + 16 * j + qi; qn0 = *(const bf16x8*)(QK + qt_ * 1024 + 64 * h + 8 * g); qn1 = *(const bf16x8*)(QK + qt_ * 1024 + 64 * h + 32 + 8 * g); } } while (0)
    const int G_ = gridDim.x, vb = (G_ % 8 == 0) ? (bx & 7) * (G_ >> 3) + (bx >> 3) : bx;
    if (vb < 1024) ATT_LOAD(vb);
    for (int bi = vb; bi < 1024; bi += G_) {
        ATT_DECODE(bi);
        __syncthreads();
#pragma unroll
        for (int k = 0; k < 8; ++k) { const int idx = min(tid + 512 * k, nrows * 256 - 1); *(LAS u32x4*)(KL + (idx >> 3) * KTS + 16 * (idx & 7)) = kst[k]; }
#pragma unroll
        for (int k = 0; k < 8; ++k) { const int e = min((tid & 7) + 8 * k, nrows * 4 - 1); *(LAS u32x4*)(VL + (tid >> 3) * VRS + ((e >> 2) * 32 + 8 * (e & 3)) * 2) = vst[k]; }
        if (tid < 465) BL[tid] = bst;
        const bf16x8 qf0 = qn0, qf1 = qn1;
        __syncthreads();
        if (bi + G_ < 1024) ATT_LOAD(bi + G_);
        const int r = 8 * rho + wv, rs = min(max(r - 4, 0), 24), lr0 = rs - krow0;
        const int qc = 16 * j + qi, qcs = min(max(qc - 8, 0), 48);
        const size_t qtok = (size_t)b * 2048 + r * 64 + qc;
        f32x4 s[16];
#pragma unroll
        for (int T = 0; T < 16; ++T) {
            const int tl = (lr0 + (T >> 1)) * 32 + 8 * (qi >> 2) + 4 * (T & 1) + (qi & 3);
            const bf16x8 k0 = *(const LAS bf16x8*)(KL + tl * KTS + 16 * g), k1 = *(const LAS bf16x8*)(KL + tl * KTS + 64 + 16 * g);
            f32x4 z = (f32x4){0.f, 0.f, 0.f, 0.f};
            z = __builtin_amdgcn_mfma_f32_16x16x32_bf16(k0, qf0, z, 0, 0, 0);
            z = __builtin_amdgcn_mfma_f32_16x16x32_bf16(k1, qf1, z, 0, 0, 0);
            s[T] = z;
        }
        float mx = -3.0e38f;
#pragma unroll
        for (int T = 0; T < 16; ++T)
#pragma unroll
            for (int e = 0; e < 4; ++e) {
                const int kc = bc0 + 8 * g + 4 * (T & 1) + e, kr = rs + (T >> 1);
                const bool valid = (kc >= qcs) && (kc < qcs + 16);
                float v = -3.0e38f;
                if (valid) v = s[T][e] + BL[(kr - r + 7) * 31 + kc - qc + 15];
                s[T][e] = v; mx = fmaxf(mx, v);
            }
        mx = fmaxf(mx, __shfl_xor(mx, 16)); mx = fmaxf(mx, __shfl_xor(mx, 32));
        float ls = 0.f;
#pragma unroll
        for (int T = 0; T < 16; ++T)
#pragma unroll
            for (int e = 0; e < 4; ++e) { const float pe = __expf(s[T][e] - mx); s[T][e] = pe; ls += pe; }
        ls += __shfl_xor(ls, 16); ls += __shfl_xor(ls, 32);
        f32x4 o[4];
#pragma unroll
        for (int dt = 0; dt < 4; ++dt) o[dt] = (f32x4){0.f, 0.f, 0.f, 0.f};
#pragma unroll
        for (int kr = 0; kr < 8; ++kr) {
            const u32x4 pw = (u32x4){cvt_pk_bf16(s[2 * kr][0], s[2 * kr][1]), cvt_pk_bf16(s[2 * kr][2], s[2 * kr][3]), cvt_pk_bf16(s[2 * kr + 1][0], s[2 * kr + 1][1]), cvt_pk_bf16(s[2 * kr + 1][2], s[2 * kr + 1][3])};
            const bf16x8 pf = __builtin_bit_cast(bf16x8, pw);
#pragma unroll
            for (int dt = 0; dt < 4; ++dt) {
                const bf16x8 vf = *(const LAS bf16x8*)(VL + (16 * dt + qi) * VRS + ((lr0 + kr) * 32 + 8 * g) * 2);
                o[dt] = __builtin_amdgcn_mfma_f32_16x16x32_bf16(vf, pf, o[dt], 0, 0, 0);
            }
        }
        const float inv = 1.0f / ls;
#pragma unroll
        for (int dt = 0; dt < 4; ++dt)
            *(u32x2*)(yna + qtok * 512 + 64 * h + 16 * dt + 4 * g) = (u32x2){cvt_pk_bf16(o[dt][0] * inv, o[dt][1] * inv), cvt_pk_bf16(o[dt][2] * inv, o[dt][3] * inv)};
    }
}

__device__ __forceinline__ void conv_mfma(int wv, KPC p, int layer, LAS unsigned char* lds, const bf16_t* UT, const float* FT, bf16_t* yhyT, unsigned long long* tloop = nullptr) {
    constexpr int CPS = 8224, ZRS = 4112;
    LAS unsigned char* FC = lds; LAS unsigned char* ZT = lds + 8 * CPS; LAS float* red = (LAS float*)(ZT + 16 * ZRS);
    const float* wsc = p->in[9] + layer * 3 * 1536; const float* bsc = p->in[10] + layer * 1536; const float* hyb = p->in[19] + layer * 512;
    const int tid = fresh_tid(wv), bx = fresh_bx(), lane = tid & 63, i = lane & 15, g = lane >> 4;
    const int rho = (8 - (i & 7)) & 7;
    const int abase = rho * CPS + 2 * (2048 - i + 8 * g - rho) - 512 * wv;
    const int bbase = i * ZRS + 16 * g;
    for (int c = bx; c < 512; c += gridDim.x) {
        __syncthreads();
        float asum = 0.f;
        {
            float fv[8]; const float hf0 = FT[(size_t)c * SEQ];
#pragma unroll
            for (int k = 0; k < 8; ++k) {
                const int m = tid + 512 * k;
                const size_t idx = (m < 2048) ? ((size_t)c * SEQ + (size_t)(2048 - max(m, 1))) : ((size_t)(512 + c) * SEQ + (size_t)(m - 2048));
                fv[k] = FT[idx];
            }
#pragma unroll
            for (int k = 0; k < 8; ++k) {
                const int m = tid + 512 * k;
                float v = fv[k]; v = (m == 0) ? 0.f : v; v = (m == 2048) ? v + hf0 : v;
                asum += fabsf(v);
                const bf16_t vb = (bf16_t)(cvt_pk_bf16(v, 0.f) & 0xffffu);
#pragma unroll
                for (int r8 = 0; r8 < 8; ++r8) if (m - r8 >= 0) *(LAS bf16_t*)(FC + r8 * CPS + 2 * (m - r8)) = vb;
            }
        }
        {
            const float a0 = wsc[c], a1 = wsc[1536 + c], a2 = wsc[3072 + c], ab = bsc[c];
            const float b0 = wsc[512 + c], b1 = wsc[1536 + 512 + c], b2 = wsc[3072 + 512 + c], bb = bsc[512 + c];
            const float c0 = wsc[1024 + c], c1 = wsc[1536 + 1024 + c], c2 = wsc[3072 + 1024 + c], cb = bsc[1024 + c];
#pragma unroll
            for (int k = 0; k < 4; ++k) {
                const int idx = tid + 512 * k, b = idx >> 8, t0 = (idx & 255) * 8;
                float x0v[8], zv[8];
#pragma unroll
                for (int rr = 0; rr < 3; ++rr) {
                    const bf16_t* row = UT + (size_t)(512 + 512 * rr + c) * M + (size_t)b * 2048;
                    const u32x4 w = *(const u32x4*)(row + t0);
                    float f[10];
                    { const float fl = bf2f(row[max(t0 - 1, 0)]), fr2 = bf2f(row[min(t0 + 8, SEQ - 1)]); f[0] = t0 > 0 ? fl : 0.f; f[9] = t0 + 8 < SEQ ? fr2 : 0.f; }
                    f[1] = bf_lo(w.x); f[2] = bf_hi(w.x); f[3] = bf_lo(w.y); f[4] = bf_hi(w.y); f[5] = bf_lo(w.z); f[6] = bf_hi(w.z); f[7] = bf_lo(w.w); f[8] = bf_hi(w.w);
                    const float w0 = rr == 0 ? a0 : (rr == 1 ? b0 : c0), w1 = rr == 0 ? a1 : (rr == 1 ? b1 : c1), w2 = rr == 0 ? a2 : (rr == 1 ? b2 : c2), wb = rr == 0 ? ab : (rr == 1 ? bb : cb);
#pragma unroll
                    for (int e = 0; e < 8; ++e) {
                        const float v = f[e] * w0 + f[e + 1] * w1 + f[e + 2] * w2 + wb;
                        if (rr == 0) x0v[e] = v; else if (rr == 1) zv[e] = v; else zv[e] *= v;
                    }
                }
                *(LAS u32x4*)(ZT + b * ZRS + 2 * t0) = (u32x4){cvt_pk_bf16(zv[0], zv[1]), cvt_pk_bf16(zv[2], zv[3]), cvt_pk_bf16(zv[4], zv[5]), cvt_pk_bf16(zv[6], zv[7])};
                *(LAS u32x4*)(ZT + (8 + b) * ZRS + 2 * t0) = (u32x4){cvt_pk_bf16(x0v[0], x0v[1]), cvt_pk_bf16(x0v[2], x0v[3]), cvt_pk_bf16(x0v[4], x0v[5]), cvt_pk_bf16(x0v[6], x0v[7])};
            }
        }
        asum = wave_sum(asum);
        if (lane == 0) red[wv] = asum;
        __syncthreads();
        float kn = 0.f;
#pragma unroll
        for (int w = 0; w < 8; ++w) kn += red[w];
        unsigned long long tl0_ = 0; if (tloop) tl0_ = __builtin_amdgcn_s_memrealtime();
        bf16x8 ring[16]; f32x4 acc[16];
#pragma unroll
        for (int tau = 0; tau < 16; ++tau) { ring[tau] = *(const LAS bf16x8*)(FC + abase - 32 * tau); acc[tau] = (f32x4){0.f, 0.f, 0.f, 0.f}; }
        bf16x8 bcur = *(const LAS bf16x8*)(ZT + bbase);
        for (int s8 = 0; s8 < 8; ++s8) {
#pragma unroll
            for (int sp = 0; sp < 8; ++sp) {
                const int sn = min(8 * s8 + sp + 1, 63);
                const bf16x8 bnext = *(const LAS bf16x8*)(ZT + bbase + 64 * sn);
                const bf16x8 n0 = *(const LAS bf16x8*)(FC + abase + 64 * sn), n1 = *(const LAS bf16x8*)(FC + abase + 64 * sn - 32);
#pragma unroll
                for (int tau = 0; tau < 16; ++tau) acc[tau] = __builtin_amdgcn_mfma_f32_16x16x32_bf16(ring[(tau - 2 * sp) & 15], bcur, acc[tau], 0, 0, 0);
                ring[(0 - 2 * (sp + 1)) & 15] = n0; ring[(1 - 2 * (sp + 1)) & 15] = n1;
                bcur = bnext;
            }
        }
        if (tloop) { asm volatile("" :: "v"(acc[0]), "v"(acc[15])); *tloop += __builtin_amdgcn_s_memrealtime() - tl0_; }
        if (i < 8) {
            const float ikn = 1.0f / kn, hb = hyb[c];
#pragma unroll
            for (int tau = 0; tau < 16; ++tau) {
                const int t = 256 * wv + 16 * tau + 4 * g;
                const u32x2 zz = *(const LAS u32x2*)(ZT + i * ZRS + 2 * t), xx = *(const LAS u32x2*)(ZT + (8 + i) * ZRS + 2 * t);
                const float y0 = bf_lo(xx.x) * (acc[tau][0] * ikn + bf_lo(zz.x) * hb), y1 = bf_hi(xx.x) * (acc[tau][1] * ikn + bf_hi(zz.x) * hb);
                const float y2 = bf_lo(xx.y) * (acc[tau][2] * ikn + bf_lo(zz.y) * hb), y3 = bf_hi(xx.y) * (acc[tau][3] * ikn + bf_hi(zz.y) * hb);
                *(u32x2*)(yhyT + (size_t)c * M + (size_t)i * 2048 + t) = (u32x2){cvt_pk_bf16(y0, y1), cvt_pk_bf16(y2, y3)};
            }
        }
    }
}

__device__ __forceinline__ void post_pass(int wv, LAS unsigned char* lds, const bf16_t* yna, const bf16_t* yhyT, bf16_t* yn) {
    LAS bf16_t* tile = (LAS bf16_t*)lds;
    const int tid = fresh_tid(wv), bx = fresh_bx(), lane = tid & 63, wave = wv;
    for (int it = bx; it < M / 64; it += gridDim.x) {
        const int tok0 = it * 64;
        u32x4 ynav[8];
#pragma unroll
        for (int q = 0; q < 8; ++q) ynav[q] = *(const u32x4*)(yna + ((size_t)tok0 + 8 * wave + q) * 512 + 8 * lane);
        __syncthreads();
        {
            const u32x4* src = (const u32x4*)(yhyT + (size_t)tid * M + tok0);
            u32x4 v[8];
#pragma unroll
            for (int j = 0; j < 8; ++j) v[j] = src[j];
#pragma unroll
            for (int j = 0; j < 8; ++j) {
                tile[(8 * j + 0) * 520 + tid] = (bf16_t)(v[j].x & 0xffffu); tile[(8 * j + 1) * 520 + tid] = (bf16_t)(v[j].x >> 16);
                tile[(8 * j + 2) * 520 + tid] = (bf16_t)(v[j].y & 0xffffu); tile[(8 * j + 3) * 520 + tid] = (bf16_t)(v[j].y >> 16);
                tile[(8 * j + 4) * 520 + tid] = (bf16_t)(v[j].z & 0xffffu); tile[(8 * j + 5) * 520 + tid] = (bf16_t)(v[j].z >> 16);
                tile[(8 * j + 6) * 520 + tid] = (bf16_t)(v[j].w & 0xffffu); tile[(8 * j + 7) * 520 + tid] = (bf16_t)(v[j].w >> 16);
            }
        }
        __syncthreads();
#pragma unroll
        for (int q = 0; q < 8; ++q) {
            const int tk = 8 * wave + q; const size_t tok = (size_t)tok0 + tk;
#pragma unroll
            for (int half = 0; half < 2; ++half) {
                u32x4 v;
                if (half == 0) v = ynav[q]; else v = *(const LAS u32x4*)(tile + tk * 520 + 8 * lane);
                float f[8] = {bf_lo(v.x), bf_hi(v.x), bf_lo(v.y), bf_hi(v.y), bf_lo(v.z), bf_hi(v.z), bf_lo(v.w), bf_hi(v.w)};
                float s = 0.f;
#pragma unroll
                for (int e = 0; e < 8; ++e) s += f[e] * f[e];
                s = wave_sum(s);
                const float rs = rstd_of(s, 1.0f / 512.0f);
                *(u32x4*)(yn + tok * 1024 + half * 512 + 8 * lane) = (u32x4){cvt_pk_bf16(f[0] * rs, f[1] * rs), cvt_pk_bf16(f[2] * rs, f[3] * rs), cvt_pk_bf16(f[4] * rs, f[5] * rs), cvt_pk_bf16(f[6] * rs, f[7] * rs)};
            }
        }
    }
}

__global__ void __launch_bounds__(512, 2) hybrid_fwd(KP kparams_unused) {
    extern __shared__ __attribute__((aligned(16))) unsigned char lds_raw[];
    LAS unsigned char* lds = (LAS unsigned char*)lds_raw;
    cg::grid_group grid = cg::this_grid();
    const int wv = __builtin_amdgcn_readfirstlane((int)(threadIdx.x >> 6));
#define WSV() KPC p = KPARAMS(); unsigned char* ws = p->ws; float* ss = (float*)(ws + WS_CTL) + (size_t)(4 * layer) * M;   \
    bf16_t* xb = (bf16_t*)(ws + WS_XB); bf16_t* xb2 = (bf16_t*)(ws + WS_R2 + 32 * MiB);   bf16_t* Hb = (bf16_t*)(ws + WS_R1); bf16_t* QK = (bf16_t*)(ws + WS_R1); bf16_t* UT = (bf16_t*)(ws + WS_R1 + 32 * MiB); \
    bf16_t* yna = (bf16_t*)(ws + WS_R2); bf16_t* yhyT = (bf16_t*)(ws + WS_R2 + 16 * MiB); bf16_t* yn = (bf16_t*)(ws + WS_R2 + 32 * MiB); bf16_t* PP = (bf16_t*)(ws + WS_R2); \
    bf16_t* pb = (bf16_t*)(ws + WS_PB); const float* FT = (const float*)(ws + WS_FT); unsigned char* Wb = ws + WS_W; float* X = p->out; \
    (void)ss; (void)xb; (void)xb2; (void)Hb; (void)QK; (void)UT; (void)yna; (void)yhyT; (void)yn; (void)PP; (void)pb; (void)FT; (void)Wb; (void)X;

    { const int t0_ = fresh_tid(wv); if (t0_ < 4) ((volatile LAS unsigned*)(lds + LDS_BYTES - 16))[t0_] = 0u; __syncthreads(); }
    XcdBarrier xbar;
    { KPC p = KPARAMS(); xbar = xcd_barrier_post((unsigned*)(p->ws + WS_CTL + BAR_OFF), (volatile LAS unsigned*)(lds + LDS_BYTES - 16), wv); }
#if defined(TPROBE) && TPROBE == 8
#define CONV_TL (&tacc_)
#else
#define CONV_TL nullptr
#endif
#ifdef TPROBE
    unsigned long long tacc_ = 0, tt0_ = 0;
#define TP(n, ...) do { if (TPROBE == (n)) tt0_ = __builtin_amdgcn_s_memrealtime(); __VA_ARGS__; if (TPROBE == (n)) tacc_ += __builtin_amdgcn_s_memrealtime() - tt0_; } while (0)
#else
#define TP(n, ...) do { __VA_ARGS__; } while (0)
#endif
#define GSYNC() TP(1, for (int rs_ = 0; rs_ < R_SYNC; ++rs_) xcd_barrier(xbar, wv))
    for (int layer = 0; layer < 2; ++layer) {
#ifndef NO_PRO
        TP(2, for (int rep_ = 0; rep_ < R_PRO; ++rep_) { WSV(); layer_prologue(wv, p, layer, lds); __syncthreads(); });
#endif
        if (layer == 0) TP(1, grid.sync()); else GSYNC();
        TP(7, for (int rep_ = 0; rep_ < R_UP; ++rep_) { WSV(); gemm_run(wv, lds, layer == 0 ? xb : xb2, (const bf16_t*)(Wb + W_GUA), M, 2 * FF, D, EpiSwiGLU{Hb, ss}); });
        { WSV(); late_transposes(wv, p, layer, lds); }
        GSYNC();
        TP(7, { WSV(); gemm_run(wv, lds, Hb, (const bf16_t*)(Wb + W_DA), M, D, FF, EpiResid{layer == 0 ? p->in[0] : X, X, xb, ss + M, 0.5f}); });
        for (int rep_ = 1; rep_ < R_REST; ++rep_) { WSV(); gemm_run(wv, lds, Hb, (const bf16_t*)(Wb + W_DA), M, D, FF, EpiDry{}); }
        GSYNC();
        TP(7, { WSV(); gemm_run(wv, lds, (const bf16_t*)(Wb + W_IN) + (size_t)1024 * D, xb, 2048, M, D, EpiScaleCol{UT, M, ss + M}); });
        for (int rep_ = 1; rep_ < R_REST; ++rep_) { WSV(); gemm_run(wv, lds, (const bf16_t*)(Wb + W_IN) + (size_t)1024 * D, xb, 2048, M, D, EpiScaleCol{UT, M, ss + M}); }
        TP(7, { WSV(); gemm_run(wv, lds, xb, (const bf16_t*)(Wb + W_IN), M, 1024, D, EpiScaleRow{QK, 1024, ss + M}); });
        for (int rep_ = 1; rep_ < R_REST; ++rep_) { WSV(); gemm_run(wv, lds, xb, (const bf16_t*)(Wb + W_IN), M, 1024, D, EpiScaleRow{QK, 1024, ss + M}); }
        GSYNC();
#ifndef NO_ATTN
#if NAIVE_ATTN
        { WSV(); attn_naive(wv, p, layer, QK, UT, yna); }
#else
        TP(3, for (int rep_ = 0; rep_ < R_ATTN; ++rep_) { WSV(); attn_lds(wv, p, layer, lds, QK, UT, yna); });
#endif
#endif
#ifndef NO_CONV
#if NAIVE_CONV
        { WSV(); conv_naive(wv, p, layer, lds, UT, FT, yhyT); }
#else
        TP(4, for (int rep_ = 0; rep_ < R_CONV; ++rep_) { WSV(); conv_mfma(wv, p, layer, lds, UT, FT, yhyT, CONV_TL); });
#endif
#endif
        GSYNC();
#ifndef NO_POST
        TP(5, for (int rep_ = 0; rep_ < R_POST; ++rep_) { WSV(); post_pass(wv, lds, yna, yhyT, yn); });
#endif
        GSYNC();
        TP(7, { WSV(); gemm_run(wv, lds, yn, (const bf16_t*)(Wb + W_OUT), M, D, D, EpiResid{X, X, xb, ss + 2 * M, 1.0f}); });
        for (int rep_ = 1; rep_ < R_REST; ++rep_) { WSV(); gemm_run(wv, lds, yn, (const bf16_t*)(Wb + W_OUT), M, D, D, EpiDry{}); }
        GSYNC();
        TP(7, { WSV(); gemm_run(wv, lds, pb + (size_t)layer * M * PLE, (const bf16_t*)(Wb + W_PP), M, D, PLE, EpiStoreBf16{PP, D}, true); });
        for (int rep_ = 1; rep_ < R_REST; ++rep_) { WSV(); gemm_run(wv, lds, pb + (size_t)layer * M * PLE, (const bf16_t*)(Wb + W_PP), M, D, PLE, EpiStoreBf16{PP, D}, true); }
        TP(7, { WSV(); gemm_run(wv, lds, xb, (const bf16_t*)(Wb + W_GUB), M, 2 * FF, D, EpiSwiGLU{Hb, ss + 2 * M}); });
        for (int rep_ = 1; rep_ < R_REST; ++rep_) { WSV(); gemm_run(wv, lds, xb, (const bf16_t*)(Wb + W_GUB), M, 2 * FF, D, EpiSwiGLU{Hb, ss + 2 * M}); }
        GSYNC();
        TP(7, { WSV(); gemm_run(wv, lds, Hb, (const bf16_t*)(Wb + W_DB), M, D, FF, EpiResid{X, X, xb, ss + 3 * M, 0.5f}); });
        for (int rep_ = 1; rep_ < R_REST; ++rep_) { WSV(); gemm_run(wv, lds, Hb, (const bf16_t*)(Wb + W_DB), M, D, FF, EpiDry{}); }
        GSYNC();
        TP(7, { WSV(); gemm_run(wv, lds, xb, (const bf16_t*)(Wb + W_PG), M, D, D, EpiPle{X, PP, ss + 3 * M, layer == 0 ? xb2 : (bf16_t*)nullptr, ss + 4 * M}); });
        for (int rep_ = 1; rep_ < R_REST; ++rep_) { WSV(); gemm_run(wv, lds, xb, (const bf16_t*)(Wb + W_PG), M, D, D, EpiDry{}); }
        if (layer == 1) GSYNC();
    }
#ifdef TPROBE
    if (TPROBE == 6) tt0_ = __builtin_amdgcn_s_memrealtime();
#endif
    {
        const int layer = 2; WSV();
        const int tid = fresh_tid(wv), bx = fresh_bx(), lane = tid & 63, wave = wv;
        const float* gf = p->in[29];
        const int NGWf = gridDim.x * 8;
        f32x4 gq[4];
#pragma unroll
        for (int j = 0; j < 4; ++j) gq[j] = ((const f32x4*)gf)[lane + 64 * j];
        for (int m = bx * 8 + wave; m < M; m += 2 * NGWf) {
            const int m2 = m + NGWf < M ? m + NGWf : m;
            const float rs = rstd_of(ss[m], 1.0f / D), rs2 = rstd_of(ss[m2], 1.0f / D);
            f32x4* xr = (f32x4*)(X + (size_t)m * D) + lane; f32x4* xr2 = (f32x4*)(X + (size_t)m2 * D) + lane;
            f32x4 v[4], w[4];
#pragma unroll
            for (int j = 0; j < 4; ++j) { v[j] = xr[64 * j]; w[j] = xr2[64 * j]; }
#pragma unroll
            for (int j = 0; j < 4; ++j) { v[j] = v[j] * rs * gq[j]; w[j] = w[j] * rs2 * gq[j]; }
#pragma unroll
            for (int j = 0; j < 4; ++j) xr[64 * j] = v[j];
            if (m2 != m) {
#pragma unroll
                for (int j = 0; j < 4; ++j) xr2[64 * j] = w[j];
            }
        }
    }
#ifdef TPROBE
    if (TPROBE == 6) tacc_ += __builtin_amdgcn_s_memrealtime() - tt0_;
    if (fresh_bx() == 0) { const unsigned long long te_ = __builtin_amdgcn_s_memrealtime(); while (__builtin_amdgcn_s_memrealtime() - te_ < (unsigned long long)TAMP * tacc_) __builtin_amdgcn_s_sleep(8); }
#endif
}

extern "C" void kernel_launch(void* const* d_in, const int* in_sizes, int n_in, void* d_out, int out_size, void* d_ws, size_t ws_size, hipStream_t stream) {
    static int grid = 0;
    if (grid == 0) {
        if (n_in != 30 || out_size != M * D || ws_size < WS_END) { fprintf(stderr, "kernel_launch: unexpected shapes: n_in %d out %d ws %zu (need %zu)\n", n_in, out_size, ws_size, (size_t)WS_END); grid = -1; return; }
        int dev = 0, cus = 0, per_cu = 0;
        hipGetDevice(&dev);
        hipDeviceGetAttribute(&cus, hipDeviceAttributeMultiprocessorCount, dev);
        if (hipFuncSetAttribute((const void*)hybrid_fwd, hipFuncAttributeMaxDynamicSharedMemorySize, LDS_BYTES) != hipSuccess) { fprintf(stderr, "kernel_launch: hipFuncSetAttribute failed\n"); }
        if (hipOccupancyMaxActiveBlocksPerMultiprocessor(&per_cu, (const void*)hybrid_fwd, 512, LDS_BYTES) != hipSuccess || per_cu < 1) { fprintf(stderr, "kernel_launch: occupancy query says %d\n", per_cu); per_cu = 1; }
        (void)hipGetLastError();
        grid = cus * per_cu;
        if (grid != 256) { fprintf(stderr, "kernel_launch: this build is laid out for 256 co-resident workgroups (256 CUs x 1); got %d x %d; nothing launched\n", cus, per_cu); grid = -1; return; }
        fprintf(stderr, "kernel_launch: grid %d (cus %d x %d)\n", grid, cus, per_cu);
    }
    if (grid < 0) return;
    static_assert(9 * (size_t)M * 4 <= BAR_OFF && BAR_OFF + XCD_BAR_WORDS * 4 <= 672 * 1024, "control words inside the zeroed range");
    (void)hipMemsetAsync((char*)d_ws + WS_CTL, 0, 672 * 1024, stream);
    KP hp{};
    for (int i = 0; i < 30; ++i) hp.in[i] = (const float*)d_in[i];
    hp.out = (float*)d_out; hp.ws = (unsigned char*)d_ws;
    void* args[] = {&hp};
    hipError_t e = hipLaunchCooperativeKernel((const void*)hybrid_fwd, dim3(grid), dim3(512), args, LDS_BYTES, stream);
    if (e != hipSuccess) fprintf(stderr, "kernel_launch: cooperative launch failed: %s (grid %d)\n", hipGetErrorString(e), grid);
}
```
